# Optimizing an MI355X kernel written in HIP

```python
import math
import jax, jax.numpy as jnp
from jax import lax
import numpy as np

D_MODEL = 4096
BATCH = 2
SEQ = 4096
DEPTH = 4

N_BRANCH = 3
BRANCH_WIDTH = D_MODEL // 4
DA_HEADS = 8
DA_SUB = BRANCH_WIDTH // (2 * DA_HEADS)
DA_HEAD = 2 * DA_SUB
DA_ROT = DA_SUB // 4
LRU_WIDTH = BRANCH_WIDTH
LRU_BLOCKS = 8
LRU_BW = LRU_WIDTH // LRU_BLOCKS
CONV_W = 4
LRU_C = 8.0
MLA_HEADS = 8
MLA_NOPE = 128
MLA_ROPE = 64
MLA_V = BRANCH_WIDTH // MLA_HEADS
MLA_QK = MLA_NOPE + MLA_ROPE
Q_LORA = 3 * D_MODEL // 16
KV_LORA = D_MODEL // 8
GATE_RANK = D_MODEL // 16
FFN_HIDDEN = -(-(8 * D_MODEL) // (3 * 256)) * 256
ROPE_THETA = 500000.0
Q_BLOCK = 128
EPS = 1e-6
IN_SIZES = (DA_HEADS * DA_HEAD, DA_HEADS * DA_HEAD, DA_HEADS * DA_HEAD,
            LRU_WIDTH, LRU_WIDTH, Q_LORA, KV_LORA, MLA_ROPE, GATE_RANK)
IN_COLS = 3 * DA_HEADS * DA_HEAD + 2 * LRU_WIDTH + Q_LORA + KV_LORA + MLA_ROPE + GATE_RANK

kernel_name = 'hybrid_diffattn_rglru_mla_encoder'


def _rms_norm(x, g, eps=EPS):
    xf = x.astype(jnp.float32)
    y = xf * lax.rsqrt(jnp.mean(xf * xf, axis=-1, keepdims=True) + eps)
    return (y * g.astype(jnp.float32)).astype(x.dtype)


def _rope_tables(positions, rot_dim):
    inv = ROPE_THETA ** (-jnp.arange(0, rot_dim, 2, dtype=jnp.float32) / rot_dim)
    ang = positions.astype(jnp.float32)[..., None] * inv
    return jnp.cos(ang), jnp.sin(ang)


def _apply_rope(x, cos, sin):
    half = cos.shape[-1]
    extra = x.ndim - 3
    shp = cos.shape[:2] + (1,) * extra + (half,)
    c = cos.reshape(shp).astype(x.dtype)
    s = sin.reshape(shp).astype(x.dtype)
    x1 = x[..., :half]
    x2 = x[..., half:2 * half]
    return jnp.concatenate([x1 * c - x2 * s, x2 * c + x1 * s, x[..., 2 * half:]], axis=-1)


def _over_query_blocks(fn, q):
    b, h, s = q.shape[:3]
    nb = s // Q_BLOCK
    qb = jnp.moveaxis(q.reshape((b, h, nb, Q_BLOCK) + q.shape[3:]), 2, 0)
    out = lax.map(fn, qb)
    out = jnp.moveaxis(out, 0, 2)
    return out.reshape(b, h, s, out.shape[-1])


def _split_last(h, sizes):
    outs = []
    start = 0
    for n in sizes:
        outs.append(h[..., start:start + n])
        start += n
    return outs


def _diff_attention(xq, xk, xv, cos, sin, q_g, k_g, lam_p, subln_g, lam_init):
    b, s = xq.shape[:2]
    q = xq.reshape(b, s, DA_HEADS, 2, DA_SUB)
    k = xk.reshape(b, s, DA_HEADS, 2, DA_SUB)
    v = xv.reshape(b, s, DA_HEADS, DA_HEAD).transpose(0, 2, 1, 3)
    q = _apply_rope(_rms_norm(q, q_g), cos, sin).transpose(0, 2, 1, 3, 4)
    k = _apply_rope(_rms_norm(k, k_g), cos, sin).transpose(0, 2, 1, 3, 4)
    lp = lam_p.astype(jnp.float32)
    lam = jnp.exp(jnp.sum(lp[0] * lp[1])) - jnp.exp(jnp.sum(lp[2] * lp[3])) + lam_init
    scale = DA_SUB ** -0.5

    def blk(qb):
        sc = jnp.einsum('bhqnd,bhknd->bhnqk', qb, k).astype(jnp.float32) * scale
        p = jax.nn.softmax(sc, axis=-1)
        pd = p[:, :, 0] - lam * p[:, :, 1]
        return jnp.einsum('bhqk,bhkd->bhqd', pd.astype(v.dtype), v)

    o = _over_query_blocks(blk, q)
    o = _rms_norm(o, subln_g) * (1.0 - lam_init)
    return o.transpose(0, 2, 1, 3).reshape(b, s, DA_HEADS * DA_HEAD)


def _linear_scan(a, bx, reverse):
    def comb(left, right):
        a1, b1 = left
        a2, b2 = right
        return a1 * a2, a2 * b1 + b2
    _, h = lax.associative_scan(comb, (a, bx), axis=1, reverse=reverse)
    return h


def _rglru_bidir(u, conv_w, conv_b, gate_w, gate_b, lam_L):
    b, s = u.shape[:2]
    pad_l = CONV_W // 2
    uc = lax.conv_general_dilated(
        u, conv_w[:, None, :].astype(u.dtype), window_strides=(1,),
        padding=[(pad_l, CONV_W - 1 - pad_l)],
        dimension_numbers=('NWC', 'WIO', 'NWC'),
        feature_group_count=LRU_WIDTH) + conv_b
    ub = uc.reshape(b, s, LRU_BLOCKS, LRU_BW)
    g = jnp.einsum('bsnc,zgncd->zgbsnd', ub, gate_w).reshape(2, 2, b, s, LRU_WIDTH)
    g = jax.nn.sigmoid((g + gate_b[:, :, None, None, :]).astype(jnp.float32))
    r, i = g[:, 0], g[:, 1]
    log_a = -LRU_C * r * jax.nn.softplus(-lam_L.astype(jnp.float32))[:, None, None, :]
    a = jnp.exp(log_a)
    mult = jnp.sqrt(-jnp.expm1(2.0 * log_a))
    bx = mult * i * uc.astype(jnp.float32)[None]
    h_f = _linear_scan(a[0], bx[0], reverse=False)
    h_b = _linear_scan(a[1], bx[1], reverse=True)
    return (h_f + h_b).astype(u.dtype)


def _mla(c_q, c_kv, k_pe, cos, sin, q_a_g, w_uq, kv_a_g, w_ukv, q_g, k_g):
    b, s = c_q.shape[:2]
    q = (_rms_norm(c_q, q_a_g) @ w_uq).reshape(b, s, MLA_HEADS, MLA_QK)
    kv = (_rms_norm(c_kv, kv_a_g) @ w_ukv).reshape(b, s, MLA_HEADS, MLA_NOPE + MLA_V)
    k_nope, v = kv[..., :MLA_NOPE], kv[..., MLA_NOPE:]
    k_pe_h = jnp.broadcast_to(k_pe[:, :, None, :], (b, s, MLA_HEADS, MLA_ROPE))
    k = jnp.concatenate([k_pe_h, k_nope], axis=-1)
    q = _apply_rope(_rms_norm(q, q_g), cos, sin).transpose(0, 2, 1, 3)
    k = _apply_rope(_rms_norm(k, k_g), cos, sin).transpose(0, 2, 1, 3)
    v = v.transpose(0, 2, 1, 3)
    scale = MLA_QK ** -0.5

    def blk(qb):
        sc = jnp.einsum('bhqd,bhkd->bhqk', qb, k).astype(jnp.float32) * scale
        p = jax.nn.softmax(sc, axis=-1)
        return jnp.einsum('bhqk,bhkd->bhqd', p.astype(v.dtype), v)

    o = _over_query_blocks(blk, q)
    return o.transpose(0, 2, 1, 3).reshape(b, s, MLA_HEADS * MLA_V)


def setup_inputs(seed: int = 0) -> dict:
    key = jax.random.key(seed)
    ks = jax.random.split(key, 32)

    def nrm(k, shape, fan_in):
        return jax.random.normal(k, shape, jnp.float32) * (fan_in ** -0.5)

    def gain(k, shape):
        return 1.0 + 0.02 * jax.random.normal(k, shape, jnp.float32)

    def bias(k, shape, sc=0.02):
        return sc * jax.random.normal(k, shape, jnp.float32)

    L = DEPTH
    x = jax.random.normal(ks[0], (BATCH, SEQ, D_MODEL), jnp.float32)
    positions = (jnp.arange(SEQ, dtype=jnp.int32)[None, :]
                 + jax.random.randint(ks[1], (BATCH, 1), 0, 1024, dtype=jnp.int32))
    a8 = jax.random.uniform(ks[12], (L, 2, LRU_WIDTH), jnp.float32, 0.9, 0.999)
    a_base = a8 ** (1.0 / LRU_C)
    lru_L = jnp.log(a_base) - jnp.log1p(-a_base)
    return {
        'x': x,
        'positions': positions,
        'mixer_norm_g': gain(ks[2], (L, D_MODEL)),
        'w_in': nrm(ks[3], (L, D_MODEL, IN_COLS), D_MODEL),
        'da_q_norm_g': gain(ks[4], (L, DA_SUB)),
        'da_k_norm_g': gain(ks[5], (L, DA_SUB)),
        'da_lambda': 0.1 * jax.random.normal(ks[6], (L, 4, DA_SUB), jnp.float32),
        'da_subln_g': gain(ks[7], (L, DA_HEAD)),
        'lru_conv_w': nrm(ks[8], (L, CONV_W, LRU_WIDTH), CONV_W),
        'lru_conv_b': bias(ks[9], (L, LRU_WIDTH)),
        'lru_gate_w': nrm(ks[10], (L, 2, 2, LRU_BLOCKS, LRU_BW, LRU_BW), LRU_BW),
        'lru_gate_b': bias(ks[11], (L, 2, 2, LRU_WIDTH)),
        'lru_L': lru_L,
        'mla_q_a_norm_g': gain(ks[13], (L, Q_LORA)),
        'mla_w_uq': nrm(ks[14], (L, Q_LORA, MLA_HEADS * MLA_QK), Q_LORA),
        'mla_kv_a_norm_g': gain(ks[15], (L, KV_LORA)),
        'mla_w_ukv': nrm(ks[16], (L, KV_LORA, MLA_HEADS * (MLA_NOPE + MLA_V)), KV_LORA),
        'mla_q_norm_g': gain(ks[17], (L, MLA_QK)),
        'mla_k_norm_g': gain(ks[18], (L, MLA_QK)),
        'w_gate_up': nrm(ks[19], (L, GATE_RANK, N_BRANCH * D_MODEL), GATE_RANK),
        'b_gate': bias(ks[20], (L, N_BRANCH, D_MODEL)),
        'w_branch_out': nrm(ks[21], (L, N_BRANCH, BRANCH_WIDTH, D_MODEL), BRANCH_WIDTH),
        'w_out': nrm(ks[22], (L, D_MODEL, D_MODEL), D_MODEL),
        'ffn_norm_g': gain(ks[23], (L, D_MODEL)),
        'w_ffn_gate': nrm(ks[24], (L, D_MODEL, FFN_HIDDEN), D_MODEL),
        'w_ffn_up': nrm(ks[25], (L, D_MODEL, FFN_HIDDEN), D_MODEL),
        'w_ffn_down': nrm(ks[26], (L, FFN_HIDDEN, D_MODEL), FFN_HIDDEN),
    }


def reference(x, positions, mixer_norm_g, w_in, da_q_norm_g, da_k_norm_g, da_lambda, da_subln_g,
              lru_conv_w, lru_conv_b, lru_gate_w, lru_gate_b, lru_L,
              mla_q_a_norm_g, mla_w_uq, mla_kv_a_norm_g, mla_w_ukv, mla_q_norm_g, mla_k_norm_g,
              w_gate_up, b_gate, w_branch_out, w_out,
              ffn_norm_g, w_ffn_gate, w_ffn_up, w_ffn_down):
    b, s = x.shape[:2]
    cos_a, sin_a = _rope_tables(positions, DA_ROT)
    cos_c, sin_c = _rope_tables(positions, MLA_ROPE)
    for l in range(DEPTH):
        lam_init = 0.8 - 0.6 * math.exp(-0.3 * l)
        xn = _rms_norm(x, mixer_norm_g[l])
        h = xn @ w_in[l]
        a_q, a_k, a_v, b_gate_in, b_x, c_qa, c_kva, c_kpe, g_lr = _split_last(h, IN_SIZES)
        o_a = _diff_attention(a_q, a_k, a_v, cos_a, sin_a, da_q_norm_g[l], da_k_norm_g[l],
                              da_lambda[l], da_subln_g[l], lam_init)
        o_b = _rglru_bidir(b_x, lru_conv_w[l], lru_conv_b[l], lru_gate_w[l], lru_gate_b[l],
                           lru_L[l]) * jax.nn.gelu(b_gate_in)
        o_c = _mla(c_qa, c_kva, c_kpe, cos_c, sin_c, mla_q_a_norm_g[l], mla_w_uq[l],
                   mla_kv_a_norm_g[l], mla_w_ukv[l], mla_q_norm_g[l], mla_k_norm_g[l])
        gates = jax.nn.sigmoid((g_lr @ w_gate_up[l]).reshape(b, s, N_BRANCH, D_MODEL) + b_gate[l])
        branches = jnp.stack([o_a, o_b, o_c], axis=0)
        y_br = jnp.einsum('nbsc,ncd->bsnd', branches, w_branch_out[l])
        x = x + jnp.sum(gates * y_br, axis=2) @ w_out[l]
        xn2 = _rms_norm(x, ffn_norm_g[l])
        x = x + (jax.nn.silu(xn2 @ w_ffn_gate[l]) * (xn2 @ w_ffn_up[l])) @ w_ffn_down[l]
    return x
```

```cpp
#include <hip/hip_runtime.h>
#include <cstdio>
#include <cstdint>

#ifndef P3_LRU_A
#define P3_LRU_A 1
#endif
#ifndef P3_GATE_A
#define P3_GATE_A 7
#endif
#ifndef P5DUP
#define P5DUP 0
#endif
#ifndef F8_LAYERS
#define F8_LAYERS 0xC
#endif
#define F8L(l) ((((F8_LAYERS) >> (l)) & 1) != 0)
#ifndef F8UP_LAYERS
#define F8UP_LAYERS 0x8
#endif
#ifndef I8UP_LAYERS
#define I8UP_LAYERS 0xF
#endif
#define I8U(l) ((((I8UP_LAYERS) >> (l)) & 1) != 0)
#define F8U(l) ((((F8UP_LAYERS) & (F8_LAYERS) & ~(I8UP_LAYERS)) >> (l)) & 1)
#ifndef F8OUT_LAYERS
#define F8OUT_LAYERS 0x0
#endif
#define F8O(l) ((((F8OUT_LAYERS) >> (l)) & 1) != 0)
#ifndef MK_ONE_LAUNCH
#define MK_ONE_LAUNCH 1
#endif

#define LAS __attribute__((address_space(3)))
#define GAS __attribute__((address_space(1)))
typedef unsigned short bf16_t;
typedef short bf16x8 __attribute__((ext_vector_type(8)));
typedef short s16x4 __attribute__((ext_vector_type(4)));
typedef float f32x2 __attribute__((ext_vector_type(2)));
typedef float f32x4 __attribute__((ext_vector_type(4)));
typedef float f32x16 __attribute__((ext_vector_type(16)));
typedef unsigned u32x2 __attribute__((ext_vector_type(2)));
typedef unsigned u32x4 __attribute__((ext_vector_type(4)));
typedef GAS unsigned gu32;

constexpr int DM = 4096, BATCH = 2, SEQ = 4096, MT = BATCH * SEQ, DEPTH = 4;
constexpr int NIN = 6720, NINP = 6912, FFH = 11008;
constexpr int C_AQ = 0, C_AK = 1024, C_AV = 2048, C_BG = 3072, C_BX = 4096, C_CQ = 5120, C_CKV = 5888, C_KPE = 6400, C_GLR = 6464;
constexpr float EPS = 1e-6f;
constexpr float LOG2E = 1.4426950408889634f;
constexpr float CA = 0.125f * LOG2E;
constexpr float CM = 0.07216878364870323f * LOG2E;
constexpr int NSTEP = 1 + 12 * DEPTH;

constexpr size_t WS_CTL = 0, CTL_BYTES = 1u << 20;
constexpr size_t WS_COSA = CTL_BYTES;
constexpr size_t WS_SINA = WS_COSA + (size_t)MT * 8 * 4;
constexpr size_t WS_COSC = WS_SINA + (size_t)MT * 8 * 4;
constexpr size_t WS_SINC = WS_COSC + (size_t)MT * 32 * 4;
constexpr size_t WS_SPT  = WS_SINC + (size_t)MT * 32 * 4;
constexpr size_t WS_XS   = WS_SPT  + (size_t)DEPTH * 2048 * 4;
constexpr size_t WS_WSC  = WS_XS   + (size_t)MT * 4;
constexpr size_t WS_XN   = WS_WSC  + 256;
constexpr size_t WS_H    = WS_XN   + (size_t)MT * DM * 2;
constexpr size_t WS_UC   = WS_H    + (size_t)MT * NINP * 2;
constexpr size_t WS_QM   = WS_UC   + (size_t)MT * 1024 * 2;
constexpr size_t WS_KV   = WS_QM   + (size_t)MT * 1536 * 2;
constexpr size_t WS_KM   = WS_KV   + (size_t)MT * 2048 * 2;
constexpr size_t WS_LAB  = WS_KM   + (size_t)MT * 1536 * 2;
constexpr size_t WS_AGP  = WS_LAB  + (size_t)2 * MT * 1024 * 4;
constexpr size_t WS_AGH  = WS_AGP  + (size_t)2 * 2 * 128 * 1024 * 4;
constexpr size_t WS_GATES= WS_AGH  + (size_t)2 * 2 * 128 * 1024 * 4;
constexpr size_t WS_DBUF = WS_GATES+ (size_t)MT * 12288 * 2;
constexpr size_t WS_OCAT = WS_DBUF + (size_t)MT * 1024 * 4;
constexpr size_t WS_TMP  = WS_OCAT + (size_t)MT * 3072 * 2;
constexpr size_t WS_YSUM = WS_TMP  + (size_t)MT * DM * 4;
constexpr size_t WS_HID  = WS_YSUM + (size_t)MT * DM * 2;
constexpr size_t WS_W    = WS_HID  + (size_t)MT * FFH * 2;
constexpr size_t WL_IN = 0;
constexpr size_t WL_UQ = WL_IN + (size_t)NINP * DM * 2;
constexpr size_t WL_UKV= WL_UQ + (size_t)1536 * 768 * 2;
constexpr size_t WL_LRU= WL_UKV+ (size_t)2048 * 512 * 2;
constexpr size_t WL_G  = WL_LRU+ (size_t)4096 * 256 * 2;
constexpr size_t WL_BO = WL_G  + (size_t)12288 * 256 * 2;
constexpr size_t WL_OUT= WL_BO + (size_t)4096 * 3072 * 2;
constexpr size_t WL_GU = WL_OUT+ (size_t)4096 * 4096 * 2;
constexpr size_t WL_DN = WL_GU + (size_t)22016 * 4096 * 2;
constexpr size_t WL_SIZE = WL_DN + (size_t)4096 * FFH * 2;
constexpr size_t WS_END = WS_W + DEPTH * WL_SIZE;
static_assert(WS_XN % 256 == 0 && WS_W % 256 == 0 && WL_SIZE % 256 == 0, "alignment");

constexpr int CW_TMO = 0, CW_BAR = 4096;

constexpr int RING_BYTES = 131072, ATT_BYTES = 141312  , LDSCTL_OFF = ATT_BYTES, MISC_OFF = LDSCTL_OFF + 320, LDS_BYTES = 147456;
constexpr int NWAVES = 8;

__device__ __forceinline__ unsigned f2bf(float f) { unsigned u = __builtin_bit_cast(unsigned, f); return (u + 0x7fffu + ((u >> 16) & 1u)) >> 16; }
__device__ __forceinline__ unsigned pk2(float lo, float hi) { return f2bf(lo) | (f2bf(hi) << 16); }
typedef __bf16 bf16x2_t __attribute__((ext_vector_type(2)));
__device__ __forceinline__ unsigned cvt_pk_bf16(float lo, float hi) { f32x2 v = {lo, hi}; bf16x2_t b = __builtin_convertvector(v, bf16x2_t); return __builtin_bit_cast(unsigned, b); }
__device__ __forceinline__ float bf_lo(unsigned w) { return __builtin_bit_cast(float, w << 16); }
__device__ __forceinline__ float bf_hi(unsigned w) { return __builtin_bit_cast(float, w & 0xffff0000u); }
__device__ __forceinline__ float bf2f(bf16_t b) { return __builtin_bit_cast(float, (unsigned)b << 16); }
__device__ __forceinline__ void unpack8(u32x4 w, float* v) { v[0] = bf_lo(w.x); v[1] = bf_hi(w.x); v[2] = bf_lo(w.y); v[3] = bf_hi(w.y); v[4] = bf_lo(w.z); v[5] = bf_hi(w.z); v[6] = bf_lo(w.w); v[7] = bf_hi(w.w); }
__device__ __forceinline__ u32x4 pack8(const float* v) { u32x4 w; w.x = pk2(v[0], v[1]); w.y = pk2(v[2], v[3]); w.z = pk2(v[4], v[5]); w.w = pk2(v[6], v[7]); return w; }
__device__ __forceinline__ float wave_sum(float v) {
#pragma unroll
    for (int o = 1; o < 64; o <<= 1) v += __shfl_xor(v, o);
    return v;
}
__device__ __forceinline__ float wave_max(float v) {
#pragma unroll
    for (int o = 1; o < 64; o <<= 1) v = fmaxf(v, __shfl_xor(v, o));
    return v;
}
__device__ __forceinline__ float sigmoidf_(float x) { return __builtin_amdgcn_rcpf(1.f + __builtin_amdgcn_exp2f(-1.4426950408889634f * x)); }
__device__ __forceinline__ float gelu_tanh(float x) { const float y = 0.7978845608028654f * (x + 0.044715f * x * x * x); const float t = 1.f - 2.f / (__expf(2.f * y) + 1.f); return 0.5f * x * (1.f + t); }
__device__ __forceinline__ int opq(int x) { asm volatile("" : "+v"(x)); return x; }
__device__ __forceinline__ int opqs(int x) { asm volatile("" : "+s"(x)); return x; }
__device__ __forceinline__ float clamp_f8(float x) { return __builtin_amdgcn_fmed3f(x, -448.f, 448.f); }
__device__ __forceinline__ unsigned pk_fp8x4(float a, float b, float c, float d) { int w = 0; w = __builtin_amdgcn_cvt_pk_fp8_f32(clamp_f8(a), clamp_f8(b), w, false); w = __builtin_amdgcn_cvt_pk_fp8_f32(clamp_f8(c), clamp_f8(d), w, true); return (unsigned)w; }
__device__ __forceinline__ unsigned q8(float x) { return (unsigned)(int)__builtin_amdgcn_fmed3f(__builtin_rintf(x), -127.f, 127.f) & 0xffu; }
__device__ __forceinline__ unsigned pk_i8x4(float a, float b, float c, float d) { return q8(a) | (q8(b) << 8) | (q8(c) << 16) | (q8(d) << 24); }
constexpr float W8_SCALE = 64.f, W8_INV = 1.f / 64.f;
#define LDS_WAIT() asm volatile("s_waitcnt lgkmcnt(0)" ::: "memory")

namespace pg8 {
constexpr int BM = 256, BK = 64, HALF = 128, HTB = HALF * BK * 2, NXCD = 8, WGM = 8;
__host__ __device__ __forceinline__ int lds_byte(int r, int c) { const int st = (r >> 4) * 2 + (c >> 5), rr = r & 15, cc = c & 31, ob = rr * 64 + cc * 2; return st * 1024 + (ob ^ (((ob >> 9) & 1) << 5)); }
__host__ __device__ __forceinline__ void stage_rc(int b, int& R, int& C) { const int st = b / 1024, sb = b % 1024, swz = sb ^ (((sb >> 9) & 1) << 5); R = (st >> 1) * 16 + swz / 64; C = (st & 1) * 32 + (swz % 64) / 2; }
__host__ __device__ __forceinline__ int perm32(int rho) { const int n = rho >> 4, i = rho & 15; return 8 * (i >> 2) + 4 * n + (i & 3); }

struct Unit { int pm, pn, ka, kb, aux; };
struct Gemm { const bf16_t* A; const bf16_t* Bt; int lda, ldb, K; };

struct TileOrder {
    int nM, nN, nwg;
    __device__ __forceinline__ void init(int nM_, int nN_) { nM = nM_; nN = nN_; nwg = nM * nN; }
    __device__ __forceinline__ void tile(int L, int& pm, int& pn) const {
        int wgid = L; { const int q = nwg / NXCD, r = nwg % NXCD, xcd = wgid % NXCD, off = wgid / NXCD; wgid = (xcd < r ? xcd * (q + 1) : r * (q + 1) + (xcd - r) * q) + off; }
        const int nig = WGM * nN, gid = wgid / nig, fm = gid * WGM, gsz = (nM - fm) < WGM ? (nM - fm) : WGM;
        pm = fm + ((wgid % nig) % gsz); pn = (wgid % nig) / gsz;
    }
};
struct SchedPlain {
    TileOrder T; int G, c, sk0, skn;
    __device__ __forceinline__ void init(int nM, int nN, int G_, int c_, int sk0_ = 1 << 30, int skn_ = 0) { T.init(nM, nN); G = G_; c = c_; sk0 = sk0_; skn = skn_; }
    __device__ __forceinline__ bool next(int i, Unit& u) const { if (c < 0) return false; const long L = (long)i * G + c; if (L >= T.nwg) return false; T.tile((int)L, u.pm, u.pn); if (u.pn >= sk0) u.pn += skn; u.ka = 0; u.kb = 0; u.aux = 0; return true; }
};
struct SchedSplit {
    TileOrder T; int GA, GB, c, n0, lru;
    __device__ __forceinline__ void init(int nM, int nN, int GA_, int GB_, int c_, int n0_, int lru_ = 0) { T.init(nM, nN); GA = GA_; GB = GB_; c = c_; n0 = n0_; lru = lru_; }
    __device__ __forceinline__ bool next(int i, Unit& u) const { const bool a = c < GA; const long L = a ? (long)i * GA + c : (long)n0 + (long)i * GB + (c - GA); if (L >= (a ? n0 : T.nwg)) return false;
        T.tile((int)L, u.pm, u.pn); u.ka = lru ? 256 * (u.pn >> 2) : 0; u.kb = 0; u.aux = 0; return true; }
};
struct SchedLru {
    TileOrder T; int G, c;
    __device__ __forceinline__ void init(int nM, int nN, int G_, int c_) { T.init(nM, nN); G = G_; c = c_; }
    __device__ __forceinline__ bool next(int i, Unit& u) const { if (c < 0) return false; const long L = (long)i * G + c; if (L >= T.nwg) return false; T.tile((int)L, u.pm, u.pn); u.ka = 256 * (u.pn >> 2); u.kb = 0; u.aux = 0; return true; }
};
struct SchedBo {
    TileOrder T; int G, c;
    __device__ __forceinline__ void init(int nM, int nN, int G_, int c_) { T.init(nM, nN); G = G_; c = c_; }
    __device__ __forceinline__ bool next(int i, Unit& u) const { const int it = i / 3, n = i - 3 * it; const long L = (long)it * G + c; if (L >= T.nwg) return false; T.tile((int)L, u.pm, u.pn); u.ka = 1024 * n; u.kb = 1024 * n; u.aux = n; return true; }
};

typedef f32x4 Acc[2][2][4][2];

struct EpiBf16 {
    bf16_t* O; int ldc;
    static __device__ __forceinline__ bool keep(const Unit&) { return false; }
    __device__ __forceinline__ void operator()(const Acc& acc, const Unit& u, int wr, int wc, int fr_, int fq_) const {
        const int fr = opq(fr_), fq = opq(fq_);
        const int row0 = u.pm * BM + wr * 64 + fr, col0 = u.pn * BM + wc * 32 + 8 * fq;
#pragma unroll
        for (int ai = 0; ai < 2; ++ai)
#pragma unroll
            for (int m = 0; m < 4; ++m) { bf16_t* rowp = O + (size_t)(row0 + ai * HALF + m * 16) * ldc + col0;
#pragma unroll
                for (int bj = 0; bj < 2; ++bj) { const f32x4 v0 = acc[ai][bj][m][0], v1 = acc[ai][bj][m][1];
                    u32x4 w; w.x = cvt_pk_bf16(v0[0], v0[1]); w.y = cvt_pk_bf16(v0[2], v0[3]); w.z = cvt_pk_bf16(v1[0], v1[1]); w.w = cvt_pk_bf16(v1[2], v1[3]);
                    *(u32x4*)(rowp + bj * HALF) = w; } }
    }
};
struct EpiSig {
    bf16_t* O; int ldc; const float* bias;
    static __device__ __forceinline__ bool keep(const Unit&) { return false; }
    __device__ __forceinline__ void operator()(const Acc& acc, const Unit& u, int wr, int wc, int fr_, int fq_) const {
        const int fr = opq(fr_), fq = opq(fq_);
        const int row0 = u.pm * BM + wr * 64 + fr, col0 = u.pn * BM + wc * 32 + 8 * fq;
#pragma unroll
        for (int bj = 0; bj < 2; ++bj) {
            const f32x4 bv0 = *(const f32x4*)(bias + col0 + bj * HALF), bv1 = *(const f32x4*)(bias + col0 + bj * HALF + 4);
#pragma unroll
            for (int ai = 0; ai < 2; ++ai)
#pragma unroll
                for (int m = 0; m < 4; ++m) { bf16_t* rowp = O + (size_t)(row0 + ai * HALF + m * 16) * ldc + col0 + bj * HALF;
                    f32x4 v0 = acc[ai][bj][m][0] + bv0, v1 = acc[ai][bj][m][1] + bv1;
#pragma unroll
                    for (int i = 0; i < 4; ++i) { v0[i] = sigmoidf_(v0[i]); v1[i] = sigmoidf_(v1[i]); }
                    u32x4 w; w.x = cvt_pk_bf16(v0[0], v0[1]); w.y = cvt_pk_bf16(v0[2], v0[3]); w.z = cvt_pk_bf16(v1[0], v1[1]); w.w = cvt_pk_bf16(v1[2], v1[3]);
                    *(u32x4*)rowp = w; __builtin_amdgcn_sched_barrier(0); } }
    }
};
struct EpiRes {
    const float* Xin; float* Out; float sc;
    static __device__ __forceinline__ bool keep(const Unit&) { return false; }
    __device__ __forceinline__ void operator()(const Acc& acc, const Unit& u, int wr, int wc, int fr_, int fq_) const {
        const int fr = opq(fr_), fq = opq(fq_);
        const int row0 = u.pm * BM + wr * 64 + fr, col0 = u.pn * BM + wc * 32 + 8 * fq;
#pragma unroll
        for (int ai = 0; ai < 2; ++ai)
#pragma unroll
            for (int m = 0; m < 4; ++m) { const size_t off = (size_t)(row0 + ai * HALF + m * 16) * DM + col0;
#pragma unroll
                for (int bj = 0; bj < 2; ++bj) {
                    const f32x4 x0 = *(const f32x4*)(Xin + off + bj * HALF), x1 = *(const f32x4*)(Xin + off + bj * HALF + 4);
                    *(f32x4*)(Out + off + bj * HALF) = x0 + acc[ai][bj][m][0] * sc; *(f32x4*)(Out + off + bj * HALF + 4) = x1 + acc[ai][bj][m][1] * sc; } }
    }
};
template <bool F8OUT> struct EpiSwiglu {
    void* Ov; float sc;
    static __device__ __forceinline__ bool keep(const Unit&) { return false; }
    __device__ __forceinline__ void operator()(const Acc& acc, const Unit& u, int wr, int wc, int fr_, int fq_) const {
        const int fr = opq(fr_), fq = opq(fq_);
        const int row0 = u.pm * BM + wr * 64 + fr, col0 = u.pn * HALF + wc * 32 + 8 * fq;
#pragma unroll
        for (int ai = 0; ai < 2; ++ai)
#pragma unroll
            for (int m = 0; m < 4; ++m) { const size_t eo = (size_t)(row0 + ai * HALF + m * 16) * FFH + col0;
                f32x4 r0, r1;
#pragma unroll
                for (int i = 0; i < 4; ++i) { const float g0 = acc[ai][0][m][0][i] * sc, g1 = acc[ai][0][m][1][i] * sc;
                    r0[i] = g0 * sigmoidf_(g0) * (acc[ai][1][m][0][i] * sc); r1[i] = g1 * sigmoidf_(g1) * (acc[ai][1][m][1][i] * sc); }
                if constexpr (F8OUT) { u32x2 w; w.x = pk_fp8x4(r0[0], r0[1], r0[2], r0[3]); w.y = pk_fp8x4(r1[0], r1[1], r1[2], r1[3]); *(u32x2*)((unsigned char*)Ov + eo) = w; }
                else { u32x4 w; w.x = cvt_pk_bf16(r0[0], r0[1]); w.y = cvt_pk_bf16(r0[2], r0[3]); w.z = cvt_pk_bf16(r1[0], r1[1]); w.w = cvt_pk_bf16(r1[2], r1[3]); *(u32x4*)((bf16_t*)Ov + eo) = w; } }
    }
};
__device__ __forceinline__ float i2f_acc(float bits) { return (float)__builtin_bit_cast(int, bits); }
struct EpiSwigluI8 {
    void* Ov; const float* xs; const float* wsc; int f8out;
    static __device__ __forceinline__ bool keep(const Unit&) { return false; }
    __device__ __forceinline__ void operator()(const Acc& acc, const Unit& u, int wr, int wc, int fr_, int fq_) const {
        const int fr = opq(fr_), fq = opq(fq_);
        const int row0 = u.pm * BM + wr * 64 + fr, col0 = u.pn * HALF + wc * 32 + 8 * fq;
        const float sg = wsc[0], su = wsc[1];
        float rsv[2][4];
#pragma unroll
        for (int ai = 0; ai < 2; ++ai)
#pragma unroll
            for (int m = 0; m < 4; ++m) rsv[ai][m] = xs[row0 + ai * HALF + m * 16];
#pragma unroll
        for (int ai = 0; ai < 2; ++ai)
#pragma unroll
            for (int m = 0; m < 4; ++m) { const int row = row0 + ai * HALF + m * 16; const size_t eo = (size_t)row * FFH + col0; const float rsA = rsv[ai][m], cg = rsA * sg, cu = rsA * su;
                f32x4 r0, r1;
#pragma unroll
                for (int i = 0; i < 4; ++i) { const float g0 = i2f_acc(acc[ai][0][m][0][i]) * cg, g1 = i2f_acc(acc[ai][0][m][1][i]) * cg;
                    r0[i] = g0 * sigmoidf_(g0) * (i2f_acc(acc[ai][1][m][0][i]) * cu); r1[i] = g1 * sigmoidf_(g1) * (i2f_acc(acc[ai][1][m][1][i]) * cu); }
                if (f8out) { u32x2 w; w.x = pk_fp8x4(r0[0], r0[1], r0[2], r0[3]); w.y = pk_fp8x4(r1[0], r1[1], r1[2], r1[3]); *(u32x2*)((unsigned char*)Ov + eo) = w; }
                else { u32x4 w; w.x = cvt_pk_bf16(r0[0], r0[1]); w.y = cvt_pk_bf16(r0[2], r0[3]); w.z = cvt_pk_bf16(r1[0], r1[1]); w.w = cvt_pk_bf16(r1[2], r1[3]); *(u32x4*)((bf16_t*)Ov + eo) = w; } }
    }
};
struct EpiBo {
    const bf16_t* gates; bf16_t* ysum; int f8;
    static __device__ __forceinline__ bool keep(const Unit& u) { return u.aux < 2; }
    __device__ __forceinline__ void operator()(Acc& acc, const Unit& u, int wr, int wc, int fr_, int fq_) const {
        const int fr = opq(fr_), fq = opq(fq_);
        const int row0 = u.pm * BM + wr * 64 + fr, col0 = u.pn * BM + wc * 32 + 8 * fq, n = u.aux;
#pragma unroll
        for (int ai = 0; ai < 2; ++ai)
#pragma unroll
            for (int m = 0; m < 4; ++m) { const size_t row = (size_t)(row0 + ai * HALF + m * 16);
#pragma unroll
                for (int bj = 0; bj < 2; ++bj) { const int col = col0 + bj * HALF;
                    const bf16_t* gp = gates + row * 12288 + (size_t)n * 4096 + col;
                    float gn[8]; unpack8(*(const u32x4*)gp, gn);
#pragma unroll
                    for (int i = 0; i < 8; ++i) gn[i] = fmaxf(gn[i], 1e-18f);
                    if (n < 2) { float gd[8]; unpack8(*(const u32x4*)(gp + 4096), gd);
#pragma unroll
                        for (int i = 0; i < 8; ++i) gn[i] *= __builtin_amdgcn_rcpf(fmaxf(gd[i], 1e-18f)); }
                    f32x4 v0 = acc[ai][bj][m][0], v1 = acc[ai][bj][m][1];
#pragma unroll
                    for (int i = 0; i < 4; ++i) { v0[i] *= gn[i]; v1[i] *= gn[4 + i]; }
                    if (n < 2) { acc[ai][bj][m][0] = v0; acc[ai][bj][m][1] = v1; }
                    else { u32x4 w; w.x = cvt_pk_bf16(v0[0], v0[1]); w.y = cvt_pk_bf16(v0[2], v0[3]); w.z = cvt_pk_bf16(v1[0], v1[1]); w.w = cvt_pk_bf16(v1[2], v1[3]);
                        if (f8) { u32x2 w8; w8.x = pk_fp8x4(v0[0], v0[1], v0[2], v0[3]); w8.y = pk_fp8x4(v1[0], v1[1], v1[2], v1[3]); *(u32x2*)((unsigned char*)ysum + row * DM + col) = w8; }
                        else *(u32x4*)(ysum + row * DM + col) = w; } } }
    }
};
struct EpiLru {
    const bf16_t* uc; const float* gb; const float* Lp; unsigned* LAB;
    static __device__ __forceinline__ bool keep(const Unit&) { return false; }
    __device__ __forceinline__ void operator()(const Acc& acc, const Unit& u, int wr, int wc, int fr_, int fq_) const {
        const int fr = opq(fr_), fq = opq(fq_);
        const int row0 = u.pm * BM + wr * 64 + fr;
        const int z = u.pn & 1, nb = u.pn >> 1, ch0 = 128 * nb + 32 * wc + 8 * fq;
#pragma unroll
        for (int n = 0; n < 2; ++n) { const int ch = ch0 + 4 * n;
            const f32x4 br = *(const f32x4*)(gb + (z * 2 + 0) * 1024 + ch), bi = *(const f32x4*)(gb + (z * 2 + 1) * 1024 + ch);
            const f32x4 sp = *(const f32x4*)(Lp + z * 1024 + ch);
            __builtin_amdgcn_sched_barrier(0);
#pragma unroll
            for (int ai = 0; ai < 2; ++ai)
#pragma unroll
                for (int m = 0; m < 4; ++m) { const size_t row = (size_t)(row0 + ai * HALF + m * 16);
                    const u32x2 uw = *(const u32x2*)(uc + row * 1024 + ch);
                    const float uv[4] = {bf_lo(uw.x), bf_hi(uw.x), bf_lo(uw.y), bf_hi(uw.y)};
                    u32x4 w;
#pragma unroll
                    for (int i = 0; i < 4; ++i) { const float r = sigmoidf_(acc[ai][0][m][n][i] + br[i]), ig = sigmoidf_(acc[ai][1][m][n][i] + bi[i]);
                        const float la = r * sp[i], av = __builtin_amdgcn_exp2f(1.4426950408889634f * la);
                        const float t = -la;
                        const float ser = t * (1.f - t * 0.5f * (1.f - t * (1.f / 3.f) * (1.f - t * 0.25f * (1.f - t * 0.2f * (1.f - t * (1.f / 6.f) * (1.f - t * (1.f / 7.f)))))));
                        const float oma = (t < 0.25f) ? ser : (1.f - av);
                        const float bx = __builtin_amdgcn_sqrtf(oma * (1.f + av)) * ig * uv[i];
                        w[i] = cvt_pk_bf16(oma, bx); }
                    *(u32x4*)(LAB + ((size_t)z * MT + row) * 1024 + ch) = w; __builtin_amdgcn_sched_barrier(0); } }
    }
};

typedef int i32x8 __attribute__((ext_vector_type(8)));
typedef int i32x4_ __attribute__((ext_vector_type(4)));
template <class Epi, class Sched, int MODE = 0>
__device__ __forceinline__ void gemm_phase(LAS unsigned char* lds, const Gemm g, const Sched& S, const Epi& E) {
    constexpr bool F8 = (MODE == 1), I8 = (MODE == 2);
    const int tid = opq(threadIdx.x), wid = __builtin_amdgcn_readfirstlane(tid >> 6), lane = tid & 63, wr = wid >> 2, wc = wid & 3, fr = lane & 15, fq = lane >> 4;
    constexpr int EB = (MODE == 0) ? 2 : 1;
    const int K = g.K, nt = K * EB / (BK * 2);
    unsigned voffA[2], voffB[2];
#pragma unroll
    for (int i = 0; i < 2; ++i) { int R, C; stage_rc(tid * 16 + i * 8192, R, C); const int Rb = (R & ~31) + perm32(R & 31);
        voffA[i] = (unsigned)(R * g.lda * EB + C * 2); voffB[i] = (unsigned)(Rb * g.ldb * EB + C * 2); }
    const size_t kstep = (size_t)(BK * 2);
    const size_t hstepA = (size_t)HALF * g.lda * EB, hstepB = (size_t)HALF * g.ldb * EB;
    const unsigned ldsw = (unsigned)wid * 1024u;
    const int aoff = lds_byte(wr * 64 + fr, fq * 8), boff = lds_byte(wc * 32 + fr, fq * 8);
#define PG8_SA(b, h) (((b) * 2 + (h)) * HTB)
#define PG8_SB(b, h) ((4 + (b) * 2 + (h)) * HTB)
#define PG8_STAGE(bufoff, gbase, voff) do { _Pragma("unroll") for (int _i = 0; _i < 2; ++_i) \
        __builtin_amdgcn_global_load_lds((const unsigned*)((const char*)(gbase) + (voff)[_i]), (LAS unsigned*)(lds + (bufoff) + ldsw + _i * 8192), 16, 0, 0); } while (0)
#define PG8_LDA(dst, b, h) do { if constexpr (F8) { _Pragma("unroll") for (int m = 0; m < 4; ++m) { dst##8[m].lo = *(const LAS i32x4_*)(lds + PG8_SA(b, h) + aoff + m * 2048); dst##8[m].hi = *(const LAS i32x4_*)(lds + PG8_SA(b, h) + aoff + m * 2048 + 1024); } } \
    else { _Pragma("unroll") for (int m = 0; m < 4; ++m) _Pragma("unroll") for (int k = 0; k < 2; ++k) dst[m][k] = *(const LAS bf16x8*)(lds + PG8_SA(b, h) + aoff + m * 2048 + k * 1024); } } while (0)
#define PG8_LDB(dst, b, h) do { if constexpr (F8) { _Pragma("unroll") for (int n = 0; n < 2; ++n) { dst##8[n].lo = *(const LAS i32x4_*)(lds + PG8_SB(b, h) + boff + n * 2048); dst##8[n].hi = *(const LAS i32x4_*)(lds + PG8_SB(b, h) + boff + n * 2048 + 1024); } } \
    else { _Pragma("unroll") for (int n = 0; n < 2; ++n) _Pragma("unroll") for (int k = 0; k < 2; ++k) dst[n][k] = *(const LAS bf16x8*)(lds + PG8_SB(b, h) + boff + n * 2048 + k * 1024); } } while (0)
#define PG8_MMA(ai, bj, At, Bt) do { __builtin_amdgcn_s_setprio(1); \
        if constexpr (F8) { _Pragma("unroll") for (int m = 0; m < 4; ++m) _Pragma("unroll") for (int n = 0; n < 2; ++n) \
            asm volatile("v_mfma_f32_16x16x128_f8f6f4 %0, %1, %2, %0" : "+v"(acc[ai][bj][m][n]) : "v"(Bt##8[n]), "v"(At##8[m])); } \
        else if constexpr (I8) { _Pragma("unroll") for (int m = 0; m < 4; ++m) _Pragma("unroll") for (int n = 0; n < 2; ++n) _Pragma("unroll") for (int k = 0; k < 2; ++k) \
            acc[ai][bj][m][n] = __builtin_bit_cast(f32x4, __builtin_amdgcn_mfma_i32_16x16x64_i8(__builtin_bit_cast(i32x4_, Bt[n][k]), __builtin_bit_cast(i32x4_, At[m][k]), __builtin_bit_cast(i32x4_, acc[ai][bj][m][n]), 0, 0, 0)); } \
        else { _Pragma("unroll") for (int m = 0; m < 4; ++m) _Pragma("unroll") for (int n = 0; n < 2; ++n) _Pragma("unroll") for (int k = 0; k < 2; ++k) \
            acc[ai][bj][m][n] = __builtin_amdgcn_mfma_f32_16x16x32_bf16(Bt[n][k], At[m][k], acc[ai][bj][m][n], 0, 0, 0); } \
        __builtin_amdgcn_s_setprio(0); } while (0)
#define PG8_WAIT_V(n) asm volatile("s_waitcnt vmcnt(" #n ")" ::: "memory")
#define PG8_WAIT_L(n) asm volatile("s_waitcnt lgkmcnt(" #n ")" ::: "memory")
#define PG8_BAR __builtin_amdgcn_s_barrier()
#define PG8_SCHED __builtin_amdgcn_sched_barrier(0)
#define PG8_UA(u) ((const char*)g.A + (size_t)(u).pm * 2 * hstepA + (size_t)(u).ka * EB)
#define PG8_UB(u) ((const char*)g.Bt + (size_t)(u).pn * 2 * hstepB + (size_t)(u).kb * EB)
    Unit cur, nxt; int ui = 0;
    if (!S.next(0, cur)) return;
    Acc acc;
#pragma unroll
    for (int a = 0; a < 2; ++a)
#pragma unroll
        for (int b = 0; b < 2; ++b)
#pragma unroll
            for (int m = 0; m < 4; ++m)
#pragma unroll
                for (int n = 0; n < 2; ++n) acc[a][b][m][n] = (f32x4){0.f, 0.f, 0.f, 0.f};
    bf16x8 At[4][2], B0[2][2], B1[2][2];
    i32x8 At8[4], B08[2], B18[2];
    const char* cA = PG8_UA(cur); const char* cB = PG8_UB(cur);
    PG8_STAGE(PG8_SB(0, 0), cB, voffB); PG8_STAGE(PG8_SB(0, 1), cB + hstepB, voffB); PG8_STAGE(PG8_SA(0, 0), cA, voffA); PG8_STAGE(PG8_SA(0, 1), cA + hstepA, voffA);
    if (wr == 1) PG8_BAR;
    PG8_WAIT_V(2); PG8_BAR;
    PG8_STAGE(PG8_SB(1, 0), cB + kstep, voffB); PG8_STAGE(PG8_SA(1, 0), cA + kstep, voffA); PG8_STAGE(PG8_SB(1, 1), cB + hstepB + kstep, voffB);
    PG8_WAIT_V(6); PG8_BAR;
    for (;;) {
        const bool has_next = S.next(ui + 1, nxt);
        const char* nA = has_next ? PG8_UA(nxt) : cA; const char* nB = has_next ? PG8_UB(nxt) : cB;
#pragma nounroll
        for (int t = 0; t < nt; t += 2) {
            const bool last = (t == nt - 2);
            const char* a1 = cA + (size_t)(t + 1) * kstep;
            const char* a2 = last ? nA : cA + (size_t)(t + 2) * kstep; const char* b2 = last ? nB : cB + (size_t)(t + 2) * kstep;
            const char* a3 = a2 + kstep; const char* b3 = b2 + kstep;
            PG8_LDB(B0, 0, 0); PG8_LDB(B1, 0, 1); PG8_SCHED; PG8_LDA(At, 0, 0); PG8_STAGE(PG8_SA(1, 1), a1 + hstepA, voffA);
            PG8_WAIT_V(8); PG8_WAIT_L(0); PG8_BAR; PG8_MMA(0, 0, At, B0); PG8_MMA(0, 1, At, B1); PG8_BAR; PG8_SCHED;
            PG8_LDA(At, 0, 1); PG8_STAGE(PG8_SB(0, 0), b2, voffB); PG8_STAGE(PG8_SB(0, 1), b2 + hstepB, voffB); PG8_STAGE(PG8_SA(0, 0), a2, voffA);
            PG8_WAIT_V(8); PG8_WAIT_L(0); PG8_BAR; PG8_MMA(1, 0, At, B0); PG8_MMA(1, 1, At, B1); PG8_BAR; PG8_SCHED;
            PG8_LDB(B0, 1, 0); PG8_LDB(B1, 1, 1); PG8_SCHED; PG8_LDA(At, 1, 0); PG8_STAGE(PG8_SA(0, 1), a2 + hstepA, voffA);
            PG8_WAIT_V(8); PG8_WAIT_L(0); PG8_BAR; PG8_MMA(0, 0, At, B0); PG8_MMA(0, 1, At, B1); PG8_BAR; PG8_SCHED;
            PG8_LDA(At, 1, 1); PG8_STAGE(PG8_SB(1, 0), b3, voffB); PG8_STAGE(PG8_SB(1, 1), b3 + hstepB, voffB); PG8_STAGE(PG8_SA(1, 0), a3, voffA);
            PG8_WAIT_V(8); PG8_WAIT_L(0); PG8_BAR; PG8_MMA(1, 0, At, B0); PG8_MMA(1, 1, At, B1); PG8_BAR; PG8_SCHED;
        }
        if (wr == 0) PG8_BAR;
        if constexpr (F8) asm volatile("s_nop 15\n\ts_nop 15" ::: "memory");
        E(acc, cur, wr, wc, fr, fq);
        if (!has_next) break;
        if (!Epi::keep(cur)) {
#pragma unroll
        for (int a = 0; a < 2; ++a)
#pragma unroll
            for (int b = 0; b < 2; ++b)
#pragma unroll
                for (int m = 0; m < 4; ++m)
#pragma unroll
                    for (int n = 0; n < 2; ++n) acc[a][b][m][n] = (f32x4){0.f, 0.f, 0.f, 0.f};
        }
        cur = nxt; cA = nA; cB = nB; ++ui;
        if (wr == 1) PG8_BAR;
    }
    PG8_WAIT_V(0);
    PG8_BAR;
#undef PG8_SA
#undef PG8_SB
#undef PG8_STAGE
#undef PG8_LDA
#undef PG8_LDB
#undef PG8_MMA
#undef PG8_WAIT_V
#undef PG8_WAIT_L
#undef PG8_BAR
#undef PG8_SCHED
#undef PG8_UA
#undef PG8_UB
}
}

namespace att {
constexpr int SHM_V = 64 * 128 * 2, OFF_K = 2 * SHM_V, OFF_WS = OFF_K + 2 * 3 * 8192, LDS_ATT = OFF_WS + NWAVES * 64 * 4;
static_assert(LDS_ATT <= RING_BYTES, "attention LDS");
__device__ __forceinline__ int crow(int r, int hi) { return (r & 3) + 8 * (r >> 2) + 4 * hi; }
__device__ __forceinline__ int v_st(int k, int c) { const int kk = (k & ~0xC) | ((k & 4) << 1) | ((k & 8) >> 1); return ((kk >> 3) * 4 + (c >> 5)) * 512 + ((kk & 7) * 32 + (c & 31)) * 2; }
__device__ __forceinline__ int v_rd_base(int lane) { return ((lane & 3) << 3) | (((lane >> 2) & 3) << 6) | (((lane >> 4) & 1) << 5) | (((lane >> 5) & 1) << 8); }
constexpr int v_rd_off(int d0, int ks, int half) { return d0 * 512 + ks * 4096 + half * 2048; }
template <int OFF> __device__ __forceinline__ s16x4 tr_read(int vb) { s16x4 r; asm volatile("ds_read_b64_tr_b16 %0, %1 offset:%2" : "=&v"(r) : "v"(vb), "i"(OFF) : "memory"); return r; }
#define ATT_SBAR() __builtin_amdgcn_sched_barrier(0)
#define ATT_SYNC() do { asm volatile("s_waitcnt lgkmcnt(0)" ::: "memory"); __builtin_amdgcn_s_barrier(); asm volatile("" ::: "memory"); } while (0)
struct VFrag { s16x4 l0, h0, l1, h1, l2, h2, l3, h3; };
template <int D0> __device__ __forceinline__ void v_reads(VFrag& f, int vb) {
    f.l0 = tr_read<v_rd_off(D0, 0, 0)>(vb); f.h0 = tr_read<v_rd_off(D0, 0, 1)>(vb); f.l1 = tr_read<v_rd_off(D0, 1, 0)>(vb); f.h1 = tr_read<v_rd_off(D0, 1, 1)>(vb);
    f.l2 = tr_read<v_rd_off(D0, 2, 0)>(vb); f.h2 = tr_read<v_rd_off(D0, 2, 1)>(vb); f.l3 = tr_read<v_rd_off(D0, 3, 0)>(vb); f.h3 = tr_read<v_rd_off(D0, 3, 1)>(vb);
}
__device__ __forceinline__ void pv_mma(f32x16& od, const VFrag& f, bf16x8 pa0, bf16x8 pa1, bf16x8 pa2, bf16x8 pa3) {
#define ATT_PK(L, H) (bf16x8){L[0], L[1], L[2], L[3], H[0], H[1], H[2], H[3]}
    od = __builtin_amdgcn_mfma_f32_32x32x16_bf16(pa0, ATT_PK(f.l0, f.h0), od, 0, 0, 0);
    od = __builtin_amdgcn_mfma_f32_32x32x16_bf16(pa1, ATT_PK(f.l1, f.h1), od, 0, 0, 0);
    od = __builtin_amdgcn_mfma_f32_32x32x16_bf16(pa2, ATT_PK(f.l2, f.h2), od, 0, 0, 0);
    od = __builtin_amdgcn_mfma_f32_32x32x16_bf16(pa3, ATT_PK(f.l3, f.h3), od, 0, 0, 0);
#undef ATT_PK
}
#define ATT_LWAIT(n) do { asm volatile("s_waitcnt lgkmcnt(" #n ")" ::: "memory"); ATT_SBAR(); } while (0)
__device__ __forceinline__ void pv_d0(f32x16* o, int vb, bf16x8 pa0, bf16x8 pa1, bf16x8 pa2, bf16x8 pa3) {
    VFrag fa, fb;
    v_reads<0>(fa, vb); v_reads<1>(fb, vb);
    ATT_LWAIT(8); pv_mma(o[0], fa, pa0, pa1, pa2, pa3); ATT_SBAR();
    v_reads<2>(fa, vb);
    ATT_LWAIT(8); pv_mma(o[1], fb, pa0, pa1, pa2, pa3); ATT_SBAR();
    v_reads<3>(fb, vb);
    ATT_LWAIT(8); pv_mma(o[2], fa, pa0, pa1, pa2, pa3); ATT_SBAR();
    ATT_LWAIT(0); pv_mma(o[3], fb, pa0, pa1, pa2, pa3);
}
__device__ __forceinline__ void exp16(f32x16& p) {
#pragma unroll
    for (int r = 0; r < 16; ++r) p[r] = __builtin_amdgcn_exp2f(p[r]);
}
__device__ __forceinline__ void finishSM(f32x16& p0, f32x16& p1, float& l_reg, bf16x8& pa0, bf16x8& pa1, bf16x8& pa2, bf16x8& pa3) {
    float ps = 0.f;
#pragma unroll
    for (int r = 0; r < 16; ++r) ps += p0[r];
#pragma unroll
    for (int r = 0; r < 16; ++r) ps += p1[r];
    l_reg += ps;
#define ATT_PK4(P, BASE, OUT) do { unsigned a0 = cvt_pk_bf16(P[BASE + 0], P[BASE + 1]), a1 = cvt_pk_bf16(P[BASE + 2], P[BASE + 3]);   \
    unsigned b0 = cvt_pk_bf16(P[BASE + 4], P[BASE + 5]), b1 = cvt_pk_bf16(P[BASE + 6], P[BASE + 7]);                              \
    auto r0 = __builtin_amdgcn_permlane32_swap(a0, b0, false, false); auto r1 = __builtin_amdgcn_permlane32_swap(a1, b1, false, false); \
    u32x4 w = {r0[0], r1[0], r0[1], r1[1]}; OUT = __builtin_bit_cast(bf16x8, w); } while (0)
    ATT_PK4(p0, 0, pa0); ATT_PK4(p0, 8, pa1); ATT_PK4(p1, 0, pa2); ATT_PK4(p1, 8, pa3);
#undef ATT_PK4
}
template <int NS, int SD>
__device__ __forceinline__ void attn_body(const bf16_t* __restrict__ Qb, int ldq, const bf16_t* __restrict__ Kh, int ldk, const bf16_t* __restrict__ Vh, int ldv,
                                          float negoff, LAS char* lds, f32x16 (&o)[4]) {
    constexpr int NQK = 4 * NS, KB = NS * 8192, NT = SEQ / 64;
    const int tid = opq(threadIdx.x), wid = tid >> 6, lane = tid & 63, r32 = lane & 31, hi = lane >> 5;
    LAS char* V_lds = lds; LAS char* K_lds = lds + OFF_K;
    LAS float* li_l = (LAS float*)(lds + OFF_WS) + wid * 64;
    float l_reg = 0.f;
#pragma unroll
    for (int d = 0; d < 4; ++d)
#pragma unroll
        for (int r = 0; r < 16; ++r) o[d][r] = 0.f;
    bf16x8 qr[NQK];
    { const bf16_t* Qw = Qb + (size_t)(wid * 32 + r32) * ldq + hi * 8;
#pragma unroll
      for (int d0 = 0; d0 < NQK; ++d0) qr[d0] = *(const bf16x8*)(Qw + d0 * 16); }
    const int vb0 = (int)(unsigned)(uintptr_t)V_lds + v_rd_base(lane);
    const int kxb = hi ^ ((r32 >> 1) & 7), krow = r32 * 128;
    struct Slot { bf16x8 vs0, vs1, ks[NS]; } sl[SD];
#define ATT_SLOAD(i, k0) do { const int t_ = opq(tid), vr = t_ >> 4, vc = (t_ & 15) * 8, kr = t_ >> 3, kc = t_ & 7; \
    const unsigned vof0 = (unsigned)(vr * ldv + vc) * 2u, vof1 = (unsigned)((32 + vr) * ldv + vc) * 2u, kof = (unsigned)(kr * ldk + kc * 8) * 2u; \
    const char* vt_ = (const char*)Vh + (size_t)(k0) * ldv * 2; const char* kt_ = (const char*)Kh + (size_t)(k0) * ldk * 2; \
    sl[i].vs0 = *(const bf16x8*)(vt_ + vof0); sl[i].vs1 = *(const bf16x8*)(vt_ + vof1); \
    _Pragma("unroll") for (int s_ = 0; s_ < NS; ++s_) sl[i].ks[s_] = *(const bf16x8*)(kt_ + kof + s_ * 128); } while (0)
#define ATT_SWRITE(b, i) do { const int t_ = opq(tid), vr = t_ >> 4, vc = (t_ & 15) * 8, vst0 = v_st(vr, vc), vst1 = v_st(32 + vr, vc), kr = t_ >> 3, kc = t_ & 7, kst = kr * 128 + ((kc ^ ((kr >> 1) & 7)) << 4); \
    *(LAS bf16x8*)(V_lds + (b) * SHM_V + vst0) = sl[i].vs0; *(LAS bf16x8*)(V_lds + (b) * SHM_V + vst1) = sl[i].vs1; \
    _Pragma("unroll") for (int s_ = 0; s_ < NS; ++s_) *(LAS bf16x8*)(K_lds + (b) * KB + s_ * 8192 + kst) = sl[i].ks[s_]; } while (0)
#define ATT_TILE(b) do { f32x16 p0_, p1_; bf16x8 pa0, pa1, pa2, pa3; \
    _Pragma("unroll") for (int r_ = 0; r_ < 16; ++r_) { p0_[r_] = 0.f; p1_[r_] = 0.f; } \
    _Pragma("unroll") for (int d0 = 0; d0 < NQK; ++d0) { const LAS char* kp_ = K_lds + (b) * KB + (d0 >> 2) * 8192 + krow + ((((d0 & 3) * 2) ^ kxb) << 4); \
        const bf16x8 b0_ = *(const LAS bf16x8*)kp_; const bf16x8 b1_ = *(const LAS bf16x8*)(kp_ + 4096); \
        p0_ = __builtin_amdgcn_mfma_f32_32x32x16_bf16(b0_, qr[d0], p0_, 0, 0, 0); p1_ = __builtin_amdgcn_mfma_f32_32x32x16_bf16(b1_, qr[d0], p1_, 0, 0, 0); } \
    _Pragma("unroll") for (int r_ = 0; r_ < 16; ++r_) { p0_[r_] = __builtin_amdgcn_exp2f(p0_[r_] + negoff); p1_[r_] = __builtin_amdgcn_exp2f(p1_[r_] + negoff); } \
    finishSM(p0_, p1_, l_reg, pa0, pa1, pa2, pa3); ATT_SBAR(); \
    pv_d0(o, vb0 + (b) * SHM_V, pa0, pa1, pa2, pa3); } while (0)
    constexpr int SE = 0, SO = SD - 1;
    ATT_SLOAD(SE, 0); ATT_SWRITE(0, SE); ATT_SLOAD(SO, 64); if constexpr (SD == 2) ATT_SLOAD(SE, 128); ATT_SYNC();
    for (int j = 0; j < NT; j += 2) {
        ATT_SWRITE(1, SO); if (j + 1 + SD < NT) ATT_SLOAD(SO, (j + 1 + SD) * 64); ATT_SBAR();
        ATT_TILE(0);
        ATT_SYNC();
        if (j + 2 < NT) ATT_SWRITE(0, SE); if (j + 2 + SD < NT) ATT_SLOAD(SE, (j + 2 + SD) * 64); ATT_SBAR();
        ATT_TILE(1);
        ATT_SYNC();
    }
    { auto rr = __builtin_amdgcn_permlane32_swap(__builtin_bit_cast(unsigned, l_reg), __builtin_bit_cast(unsigned, l_reg), false, false);
      l_reg = __builtin_bit_cast(float, rr[0]) + __builtin_bit_cast(float, rr[1]); }
    if (hi == 0) li_l[r32] = l_reg;
    LDS_WAIT();
#pragma unroll
    for (int r = 0; r < 16; ++r) { const float rl = __builtin_amdgcn_rcpf(li_l[crow(r, hi)]);
#pragma unroll
        for (int d0 = 0; d0 < 4; ++d0) o[d0][r] *= rl; }
    LDS_WAIT();
#undef ATT_SLOAD
#undef ATT_SWRITE
#undef ATT_TILE
}
constexpr int DMA_OFF_K = 3 * SHM_V, DMA_OFF_WS = DMA_OFF_K + 3 * 3 * 8192, DMA_LDS = DMA_OFF_WS + NWAVES * 64 * 4;
static_assert(DMA_LDS <= RING_BYTES && 4 * SHM_V + 3 * 3 * 8192 + NWAVES * 64 * 4 <= ATT_BYTES, "attention LDS");
template <int NS>
__device__ __forceinline__ void attn_body_dma(const bf16_t* __restrict__ Qb, int ldq, const bf16_t* __restrict__ Kh, int ldk, const bf16_t* __restrict__ Vh, int ldv,
                                              float negoff, LAS char* lds, f32x16 (&o)[4]) {
    constexpr int NQK = 4 * NS, KB = NS * 8192, NT = SEQ / 64;
    const int tid = opq(threadIdx.x), wid = __builtin_amdgcn_readfirstlane(tid >> 6), lane = tid & 63, r32 = lane & 31, hi = lane >> 5;
    LAS char* V_lds = lds; LAS char* K_lds = lds + DMA_OFF_K;
    LAS float* li_l = (LAS float*)(lds + DMA_OFF_WS) + wid * 64;
    float l_reg = 0.f;
#pragma unroll
    for (int d = 0; d < 4; ++d)
#pragma unroll
        for (int r = 0; r < 16; ++r) o[d][r] = 0.f;
    bf16x8 qr[NQK];
    { const bf16_t* Qw = Qb + (size_t)(wid * 32 + r32) * ldq + hi * 8;
#pragma unroll
      for (int d0 = 0; d0 < NQK; ++d0) qr[d0] = *(const bf16x8*)(Qw + d0 * 16); }
    const int vb0 = (int)(unsigned)(uintptr_t)V_lds + v_rd_base(lane);
    const int kxb = hi ^ ((r32 >> 1) & 7), krow = r32 * 128;
    f32x16 negv;
#pragma unroll
    for (int r = 0; r < 16; ++r) negv[r] = (NS == 1) ? negoff : 0.f;
    const float nadd = (NS == 1) ? 0.f : negoff;
    unsigned vsrc[2], ksrc;
#pragma unroll
    for (int i = 0; i < 2; ++i) { const int p = (2 * wid + i) * 64 + lane, sub = p >> 5, kk = (sub >> 2) * 8 + ((p & 31) >> 2), k = (kk & ~0xC) | ((kk & 4) << 1) | ((kk & 8) >> 1), c = (sub & 3) * 32 + (p & 3) * 8;
        vsrc[i] = (unsigned)(k * ldv + c) * 2u; }
    { const int p = wid * 64 + lane, row = p >> 3, chunk = (p & 7) ^ ((row >> 1) & 7); ksrc = (unsigned)(row * ldk + chunk * 8) * 2u; }
#define ATT_DMA(slot, k0) do { const char* vt_ = (const char*)Vh + (size_t)(k0) * ldv * 2; const char* kt_ = (const char*)Kh + (size_t)(k0) * ldk * 2; \
    _Pragma("unroll") for (int i_ = 0; i_ < 2; ++i_) __builtin_amdgcn_global_load_lds((const unsigned*)(vt_ + vsrc[i_]), (LAS unsigned*)(V_lds + (slot) * SHM_V + (2 * wid + i_) * 1024), 16, 0, 0); \
    _Pragma("unroll") for (int s_ = 0; s_ < NS; ++s_) __builtin_amdgcn_global_load_lds((const unsigned*)(kt_ + ksrc + s_ * 128), (LAS unsigned*)(K_lds + (slot) * KB + s_ * 8192 + wid * 1024), 16, 0, 0); } while (0)
#define ATT_LDK(buf, g, kb_) do { _Pragma("unroll") for (int q_ = 0; q_ < 2; ++q_) { const int d0_ = 2 * (g) + q_; \
        const LAS char* kp_ = (kb_) + (d0_ >> 2) * 8192 + ((((d0_ & 3) * 2) ^ kxb) << 4); kf[buf][2 * q_] = *(const LAS bf16x8*)kp_; kf[buf][2 * q_ + 1] = *(const LAS bf16x8*)(kp_ + 4096); } } while (0)
#define ATT_TILE_D(slot) do { f32x16 p0_, p1_; bf16x8 pa0, pa1, pa2, pa3; const LAS char* kb_ = K_lds + (slot) * KB + krow; bf16x8 kf[2][4]; \
    ATT_LDK(0, 0, kb_); ATT_SBAR(); \
    _Pragma("unroll") for (int g_ = 0; g_ < NQK / 2; ++g_) { \
        if (g_ + 1 < NQK / 2) ATT_LDK((g_ + 1) & 1, g_ + 1, kb_); ATT_SBAR(); \
        _Pragma("unroll") for (int q_ = 0; q_ < 2; ++q_) { \
            p0_ = __builtin_amdgcn_mfma_f32_32x32x16_bf16(kf[g_ & 1][2 * q_], qr[2 * g_ + q_], (g_ == 0 && q_ == 0) ? negv : p0_, 0, 0, 0); \
            p1_ = __builtin_amdgcn_mfma_f32_32x32x16_bf16(kf[g_ & 1][2 * q_ + 1], qr[2 * g_ + q_], (g_ == 0 && q_ == 0) ? negv : p1_, 0, 0, 0); } \
        ATT_SBAR(); } \
    if constexpr (NS == 1) { _Pragma("unroll") for (int r_ = 0; r_ < 16; ++r_) { p0_[r_] = __builtin_amdgcn_exp2f(p0_[r_]); p1_[r_] = __builtin_amdgcn_exp2f(p1_[r_]); } } \
    else { _Pragma("unroll") for (int r_ = 0; r_ < 16; ++r_) { p0_[r_] = __builtin_amdgcn_exp2f(p0_[r_] + nadd); p1_[r_] = __builtin_amdgcn_exp2f(p1_[r_] + nadd); } } \
    finishSM(p0_, p1_, l_reg, pa0, pa1, pa2, pa3); ATT_SBAR(); \
    pv_d0(o, vb0 + (slot) * SHM_V, pa0, pa1, pa2, pa3); } while (0)
    ATT_DMA(0, 0); ATT_DMA(1, 64);
    if constexpr (NS == 1) asm volatile("s_waitcnt vmcnt(3)" ::: "memory"); else asm volatile("s_waitcnt vmcnt(5)" ::: "memory");
    ATT_SYNC();
    int slot = 0;
    for (int j = 0; j < NT; ++j) {
        const int s2 = (slot == 0) ? 2 : slot - 1;
        if (j + 2 < NT) ATT_DMA(s2, (j + 2) * 64);
        ATT_SBAR();
        ATT_TILE_D(slot);
        if (j + 2 < NT) { if constexpr (NS == 1) asm volatile("s_waitcnt vmcnt(3)" ::: "memory"); else asm volatile("s_waitcnt vmcnt(5)" ::: "memory"); }
        else asm volatile("s_waitcnt vmcnt(0)" ::: "memory");
        ATT_SYNC();
        slot = (slot == 2) ? 0 : slot + 1;
    }
    { auto rr = __builtin_amdgcn_permlane32_swap(__builtin_bit_cast(unsigned, l_reg), __builtin_bit_cast(unsigned, l_reg), false, false);
      l_reg = __builtin_bit_cast(float, rr[0]) + __builtin_bit_cast(float, rr[1]); }
    if (hi == 0) li_l[r32] = l_reg;
    LDS_WAIT();
#pragma unroll
    for (int r = 0; r < 16; ++r) { const float rl = __builtin_amdgcn_rcpf(li_l[crow(r, hi)]);
#pragma unroll
        for (int d0 = 0; d0 < 4; ++d0) o[d0][r] *= rl; }
    LDS_WAIT();
#undef ATT_DMA
#undef ATT_TILE_D
#undef ATT_LDK
}
template <int NS>
__device__ __forceinline__ void attn_body_st(const bf16_t* __restrict__ Qb, int ldq, const bf16_t* __restrict__ Kh, int ldk, const bf16_t* __restrict__ Vh, int ldv,
                                             float negoff, LAS char* lds, f32x16 (&o)[4]) {
    constexpr int NQK = 4 * NS, KB = NS * 8192, NT = SEQ / 64;
    const int tid = opq(threadIdx.x), wid = __builtin_amdgcn_readfirstlane(tid >> 6), lane = tid & 63, r32 = lane & 31, hi = lane >> 5;
    LAS char* V_lds = lds; LAS char* K_lds = lds + 4 * SHM_V;
    LAS float* li_l = (LAS float*)(lds + 4 * SHM_V + 3 * 3 * 8192) + wid * 64;
    float l_reg = 0.f;
#pragma unroll
    for (int d = 0; d < 4; ++d)
#pragma unroll
        for (int r = 0; r < 16; ++r) o[d][r] = 0.f;
    bf16x8 qr[NQK];
    { const bf16_t* Qw = Qb + (size_t)(wid * 32 + r32) * ldq + hi * 8;
#pragma unroll
      for (int d0 = 0; d0 < NQK; ++d0) qr[d0] = *(const bf16x8*)(Qw + d0 * 16); }
    const int vb0 = (int)(unsigned)(uintptr_t)V_lds + v_rd_base(lane);
    const int kxb = hi ^ ((r32 >> 1) & 7), krow = r32 * 128;
    unsigned vsrc[2], ksrc;
#pragma unroll
    for (int i = 0; i < 2; ++i) { const int p = (2 * wid + i) * 64 + lane, sub = p >> 5, kk = (sub >> 2) * 8 + ((p & 31) >> 2), k = (kk & ~0xC) | ((kk & 4) << 1) | ((kk & 8) >> 1), c = (sub & 3) * 32 + (p & 3) * 8;
        vsrc[i] = (unsigned)(k * ldv + c) * 2u; }
    { const int p = wid * 64 + lane, row = p >> 3, chunk = (p & 7) ^ ((row >> 1) & 7); ksrc = (unsigned)(row * ldk + chunk * 8) * 2u; }
#define ATT_DMA(vslot, kslot, k0) do { const char* vt_ = (const char*)Vh + (size_t)(k0) * ldv * 2; const char* kt_ = (const char*)Kh + (size_t)(k0) * ldk * 2; \
    _Pragma("unroll") for (int i_ = 0; i_ < 2; ++i_) __builtin_amdgcn_global_load_lds((const unsigned*)(vt_ + vsrc[i_]), (LAS unsigned*)(V_lds + (vslot) * SHM_V + (2 * wid + i_) * 1024), 16, 0, 0); \
    _Pragma("unroll") for (int s_ = 0; s_ < NS; ++s_) __builtin_amdgcn_global_load_lds((const unsigned*)(kt_ + ksrc + s_ * 128), (LAS unsigned*)(K_lds + (kslot) * KB + s_ * 8192 + wid * 1024), 16, 0, 0); } while (0)
#define ATT_LDK(buf, g, kb_) do { _Pragma("unroll") for (int q_ = 0; q_ < 2; ++q_) { constexpr int dummy_ = 0; (void)dummy_; const int d0_ = 2 * (g) + q_; \
        const LAS char* kp_ = (kb_) + (d0_ >> 2) * 8192 + ((((d0_ & 3) * 2) ^ kxb) << 4); kf[buf][2 * q_] = *(const LAS bf16x8*)kp_; kf[buf][2 * q_ + 1] = *(const LAS bf16x8*)(kp_ + 4096); } } while (0)
#define ATT_QKSM(kslot) do { f32x16 p0_, p1_; const LAS char* kb_ = K_lds + (kslot) * KB + krow; bf16x8 kf[2][4]; \
    _Pragma("unroll") for (int r_ = 0; r_ < 16; ++r_) { p0_[r_] = 0.f; p1_[r_] = 0.f; } \
    ATT_LDK(0, 0, kb_); ATT_SBAR(); \
    _Pragma("unroll") for (int g_ = 0; g_ < NQK / 2; ++g_) { \
        if (g_ + 1 < NQK / 2) ATT_LDK((g_ + 1) & 1, g_ + 1, kb_); ATT_SBAR(); \
        _Pragma("unroll") for (int q_ = 0; q_ < 2; ++q_) { p0_ = __builtin_amdgcn_mfma_f32_32x32x16_bf16(kf[g_ & 1][2 * q_], qr[2 * g_ + q_], p0_, 0, 0, 0); p1_ = __builtin_amdgcn_mfma_f32_32x32x16_bf16(kf[g_ & 1][2 * q_ + 1], qr[2 * g_ + q_], p1_, 0, 0, 0); } \
        ATT_SBAR(); } \
    _Pragma("unroll") for (int r_ = 0; r_ < 16; ++r_) { p0_[r_] = __builtin_amdgcn_exp2f(p0_[r_] + negoff); p1_[r_] = __builtin_amdgcn_exp2f(p1_[r_] + negoff); } \
    finishSM(p0_, p1_, l_reg, pa0, pa1, pa2, pa3); } while (0)
#define ATT_ENDI(fly) do { if (fly) { if constexpr (NS == 1) asm volatile("s_waitcnt vmcnt(3)" ::: "memory"); else asm volatile("s_waitcnt vmcnt(5)" ::: "memory"); } else asm volatile("s_waitcnt vmcnt(0)" ::: "memory"); ATT_SYNC(); } while (0)
    bf16x8 pa0, pa1, pa2, pa3;
    ATT_DMA(0, 0, 0); ATT_DMA(1, 1, 64); ATT_ENDI(true);
    int vs = 0, ks = 0;
    if (wid < 4) {
        for (int j = 0; j < NT; ++j) {
            if (j + 2 < NT) ATT_DMA((vs + 2) & 3, (ks == 0) ? 2 : ks - 1, (j + 2) * 64);
            ATT_SBAR();
            ATT_QKSM(ks); ATT_SBAR();
            pv_d0(o, vb0 + vs * SHM_V, pa0, pa1, pa2, pa3);
            ATT_ENDI(j + 2 < NT);
            vs = (vs + 1) & 3; ks = (ks == 2) ? 0 : ks + 1;
        }
    } else {
        int vp = 0;
        for (int j = 0; j < NT; ++j) {
            if (j + 2 < NT) ATT_DMA((vs + 2) & 3, (ks == 0) ? 2 : ks - 1, (j + 2) * 64);
            ATT_SBAR();
            if (j > 0) pv_d0(o, vb0 + vp * SHM_V, pa0, pa1, pa2, pa3);
            ATT_SBAR();
            ATT_QKSM(ks);
            ATT_ENDI(j + 2 < NT);
            vp = vs; vs = (vs + 1) & 3; ks = (ks == 2) ? 0 : ks + 1;
        }
        ATT_SBAR();
        pv_d0(o, vb0 + vp * SHM_V, pa0, pa1, pa2, pa3);
    }
    ATT_SYNC();
    { auto rr = __builtin_amdgcn_permlane32_swap(__builtin_bit_cast(unsigned, l_reg), __builtin_bit_cast(unsigned, l_reg), false, false);
      l_reg = __builtin_bit_cast(float, rr[0]) + __builtin_bit_cast(float, rr[1]); }
    if (hi == 0) li_l[r32] = l_reg;
    LDS_WAIT();
#pragma unroll
    for (int r = 0; r < 16; ++r) { const float rl = __builtin_amdgcn_rcpf(li_l[crow(r, hi)]);
#pragma unroll
        for (int d0 = 0; d0 < 4; ++d0) o[d0][r] *= rl; }
    LDS_WAIT();
#undef ATT_DMA
#undef ATT_QKSM
#undef ATT_LDK
#undef ATT_ENDI
}
}

#define XB_TMO      128
#define XB_XCNT(j)  (256  + 64 * (j))
#define XB_XSUB(j)  (1280 + 64 * (j))
#define XB_XGEN(j)  (2304 + 64 * (j))
#define XB_TOP      3328
#define XB_TOPGEN   3392
#define XCD_BAR_WORDS 3456
#define XB_SPIN_CAP (1u << 22)
__device__ __forceinline__ unsigned xb_ld(unsigned* p)              { return __hip_atomic_load(p, __ATOMIC_RELAXED, __HIP_MEMORY_SCOPE_AGENT); }
__device__ __forceinline__ unsigned xb_add(unsigned* p, unsigned v) { return __hip_atomic_fetch_add(p, v, __ATOMIC_RELAXED, __HIP_MEMORY_SCOPE_AGENT); }
__device__ __forceinline__ unsigned xb_xcc_id() { return (unsigned)__builtin_amdgcn_s_getreg((3 << 11) | 20) & 0xFu; }
#define XB_SPIN(cond, bar) do { unsigned _sp = 0; while (cond) { __builtin_amdgcn_s_sleep(1); \
    if ((++_sp & 255u) == 0u) { if (xb_ld(&(bar)[XB_TMO])) break; if (_sp > XB_SPIN_CAP) { atomicAdd(&(bar)[XB_TMO], 1u); break; } } } } while (0)
struct XcdBarrier { unsigned* bar; unsigned x; volatile LAS unsigned* st; };
__device__ __forceinline__ XcdBarrier xcd_barrier_post(unsigned* bar, volatile LAS unsigned* st) {
    XcdBarrier b; b.bar = bar; b.x = xb_xcc_id(); b.st = st;
    if (threadIdx.x == 0) (void)xb_add(&bar[XB_XCNT(b.x)], 1u);
    return b;
}
__device__ __forceinline__ void xcd_barrier_complete(unsigned* bar, unsigned x, unsigned& nloc, unsigned& nx) {
    const unsigned G = gridDim.x * gridDim.y * gridDim.z;
    unsigned sum, cnt, mine, sp = 0u;
    for (;;) {
        sum = 0u; cnt = 0u; mine = 0u;
#pragma unroll
        for (unsigned j = 0; j < 16; ++j) { const unsigned c = xb_ld(&bar[XB_XCNT(j)]); sum += c; cnt += (c > 0u) ? 1u : 0u; mine = (j == x) ? c : mine; }
        if (sum == G) break;
        __builtin_amdgcn_s_sleep(1);
        if ((++sp & 255u) == 0u) { if (xb_ld(&bar[XB_TMO])) break; if (sp > XB_SPIN_CAP) { atomicAdd(&bar[XB_TMO], 1u); break; } }
    }
    nloc = mine > 0u ? mine : 1u; nx = cnt > 0u ? cnt : 1u;
}
__device__ __forceinline__ void xcd_barrier(const XcdBarrier& b) {
    asm volatile("s_waitcnt vmcnt(0)" ::: "memory");
    __syncthreads();
    if (threadIdx.x == 0) {
        unsigned* bar = b.bar;
        __builtin_amdgcn_s_waitcnt(0);
        unsigned nloc = b.st[0], nx = b.st[1];
        if (nloc == 0u) { xcd_barrier_complete(bar, b.x, nloc, nx); b.st[0] = nloc; b.st[1] = nx; }
        const unsigned old = xb_add(&bar[XB_XSUB(b.x)], 1u);
        const unsigned gen = old / nloc;
        if (old + 1u == (gen + 1u) * nloc) {
            __builtin_amdgcn_fence(__ATOMIC_RELEASE, "agent");
            asm volatile("s_waitcnt vmcnt(0)" ::: "memory");
            const unsigned og = xb_add(&bar[XB_TOP], 1u);
            const unsigned tg = og / nx;
            if (og + 1u == (tg + 1u) * nx) xb_add(&bar[XB_TOPGEN], 1u);
            else XB_SPIN(xb_ld(&bar[XB_TOPGEN]) == tg, bar);
            __builtin_amdgcn_fence(__ATOMIC_ACQUIRE, "agent");
            xb_add(&bar[XB_XGEN(b.x)], 1u);
            asm volatile("s_waitcnt vmcnt(0)" ::: "memory");
        } else {
            XB_SPIN(xb_ld(&bar[XB_XGEN(b.x)]) == gen, bar);
            __builtin_amdgcn_fence(__ATOMIC_ACQUIRE, "agent");
            asm volatile("s_waitcnt vmcnt(0)" ::: "memory");
        }
    }
    __syncthreads();
}

template <int MODE = 0>
__device__ __forceinline__ void tr_item(const float* W, size_t ldw, int k0, int n0, bf16_t* WT, size_t ldt, int drow0, int dcol0, LAS float* scr, int lane, float qinv = 1.f) {
    constexpr bool F8 = (MODE == 1);
    { f32x4 wv_[8];
#pragma unroll
      for (int i = 0; i < 8; ++i) wv_[i] = *(const f32x4*)(W + (size_t)(k0 + 8 * i + (lane >> 3)) * ldw + n0 + 4 * (lane & 7));
#pragma unroll
      for (int i = 0; i < 8; ++i) { LAS float* d_ = scr + (8 * i + (lane >> 3)) * 33 + 4 * (lane & 7); d_[0] = wv_[i].x; d_[1] = wv_[i].y; d_[2] = wv_[i].z; d_[3] = wv_[i].w; } }
    LDS_WAIT(); asm volatile("" ::: "memory");
    const int c = lane & 7;
#pragma unroll
    for (int j = 0; j < 4; ++j) { const int n = (lane >> 3) + 8 * j; const LAS float* s = scr + (8 * c) * 33 + n;
        if constexpr (MODE == 2) { u32x2 o; o.x = pk_i8x4(s[0 * 33] * qinv, s[1 * 33] * qinv, s[2 * 33] * qinv, s[3 * 33] * qinv); o.y = pk_i8x4(s[4 * 33] * qinv, s[5 * 33] * qinv, s[6 * 33] * qinv, s[7 * 33] * qinv);
            *(u32x2*)((unsigned char*)WT + (size_t)(drow0 + n) * ldt + dcol0 + 8 * c) = o; }
        else if constexpr (F8) { u32x2 o; o.x = pk_fp8x4(s[0 * 33] * W8_SCALE, s[1 * 33] * W8_SCALE, s[2 * 33] * W8_SCALE, s[3 * 33] * W8_SCALE); o.y = pk_fp8x4(s[4 * 33] * W8_SCALE, s[5 * 33] * W8_SCALE, s[6 * 33] * W8_SCALE, s[7 * 33] * W8_SCALE);
            *(u32x2*)((unsigned char*)WT + (size_t)(drow0 + n) * ldt + dcol0 + 8 * c) = o; }
        else { u32x4 o; o.x = pk2(s[0 * 33], s[1 * 33]); o.y = pk2(s[2 * 33], s[3 * 33]); o.z = pk2(s[4 * 33], s[5 * 33]); o.w = pk2(s[6 * 33], s[7 * 33]);
            *(u32x4*)(WT + (size_t)(drow0 + n) * ldt + dcol0 + 8 * c) = o; } }
    LDS_WAIT(); asm volatile("" ::: "memory");
}

struct Args { const void* in[27]; float* out; unsigned char* ws; int step_lo, step_hi; };
typedef const __attribute__((address_space(4))) Args CArgs;
__device__ __forceinline__ CArgs* opq_args() { CArgs* p = (CArgs*)__builtin_amdgcn_kernarg_segment_ptr(); asm volatile("" : "+s"(p)); return p; }

__global__ void __launch_bounds__(NWAVES * 64, 2) fwd(Args args) {
    extern __shared__ __attribute__((aligned(16))) unsigned char lds_raw[];
    LAS unsigned char* lds = (LAS unsigned char*)lds_raw;
    volatile LAS unsigned* MISC = (volatile LAS unsigned*)(lds + MISC_OFF);
    const int tid0 = threadIdx.x, wave = __builtin_amdgcn_readfirstlane(tid0 >> 6);
    const int G0 = gridDim.x, bx0 = blockIdx.x;
    const int vcu0 = (G0 % 8 == 0) ? (bx0 % 8) * (G0 / 8) + bx0 / 8 : bx0;
    const int gw0 = vcu0 * NWAVES + wave;
#define ws (A->ws)
    for (int u = tid0; u < (LDS_BYTES - LDSCTL_OFF) / 4; u += NWAVES * 64) ((LAS unsigned*)(lds + LDSCTL_OFF))[u] = 0u;
    __syncthreads();
    const int lo = args.step_lo, hi = args.step_hi;
    if (MK_ONE_LAUNCH) { CArgs* A = opq_args(); const int G = opqs(G0), bx = opqs(bx0), gw = opqs(gw0), NGW = G * NWAVES; (void)bx; (void)gw; (void)NGW; (void)xcd_barrier_post((unsigned*)(ws + WS_CTL) + CW_BAR, MISC + 8); }
#ifndef DISMASK
#define DISMASK 0
#endif
#define EN(p) (!((DISMASK >> (p)) & 1))
#ifndef P3MASK
#define P3MASK 0
#endif
#ifndef P5MASK
#define P5MASK 0
#endif
#define P5EN(p) (!((P5MASK >> (p)) & 1))
#define P3EN(p) (!((P3MASK >> (p)) & 1))
#ifndef DUPMASK
#define DUPMASK 0
#endif
#define NREP(p) ((((DUPMASK) >> (p)) & 1) ? 2 : 1)
#define IN(k) (lo <= (k) && (k) < hi)
#define SEAM(k) do { if ((k) + 1 < hi) { if (MK_ONE_LAUNCH) { XcdBarrier bar_; bar_.bar = (unsigned*)(ws + WS_CTL) + CW_BAR; bar_.x = xb_xcc_id(); bar_.st = (volatile LAS unsigned*)(lds + MISC_OFF) + 8; xcd_barrier(bar_); } } } while (0)

#define cosA ((float*)(ws + WS_COSA))
#define sinA ((float*)(ws + WS_SINA))
#define cosC ((float*)(ws + WS_COSC))
#define sinC ((float*)(ws + WS_SINC))
#define XN ((bf16_t*)(ws + WS_XN))
#define H ((bf16_t*)(ws + WS_H))
#define UC ((bf16_t*)(ws + WS_UC))
#define QM ((bf16_t*)(ws + WS_QM))
#define KV ((bf16_t*)(ws + WS_KV))
#define KM ((bf16_t*)(ws + WS_KM))
#define LAB ((unsigned*)(ws + WS_LAB))
#define AGP ((float*)(ws + WS_AGP))
#define AGH ((float*)(ws + WS_AGH))
#define GATES ((bf16_t*)(ws + WS_GATES))
#define DBUF ((float*)(ws + WS_DBUF))
#define OCAT ((bf16_t*)(ws + WS_OCAT))
#define TMP ((float*)(ws + WS_TMP))
#define YSUM ((bf16_t*)(ws + WS_YSUM))
#define HID ((bf16_t*)(ws + WS_HID))
#define x_in ((const float*)A->in[0])
#define out (A->out)

    auto conv_layer = [](CArgs* A, LAS unsigned char* lds, const int wave, const int la, const int lb, const int tid, const int lane, const int G, const int bx, const int gw, const int NGW) __attribute__((always_inline)) {
        if (lb < DEPTH) { const int l = lb;
            unsigned char* wlp = ws + WS_W + (size_t)l * WL_SIZE;
            u32x4* padp = (u32x4*)(wlp + WL_IN + (size_t)NIN * DM * 2);
            for (int i = bx * 512 + tid; i < (NINP - NIN) * DM * 2 / 16; i += G * 512) padp[i] = (u32x4){0u, 0u, 0u, 0u};
            bf16_t* wlru = (bf16_t*)(wlp + WL_LRU); const float* gwsrc = (const float*)A->in[10] + (size_t)l * 2 * 2 * 8 * 128 * 128;
            (void)gwsrc;
            for (int i = bx * 512 + tid; i < 4096 * 16; i += G * 512) { const int R = i >> 4, c8 = i & 15, nb = R >> 9;
                *(u32x4*)(wlru + (size_t)R * 256 + (1 - (nb & 1)) * 128 + 8 * c8) = (u32x4){0u, 0u, 0u, 0u}; }
        }
        { LAS float* scr = (LAS float*)(lds + wave * 16384);
          constexpr int I_IN = 64 * 210, I_UQ = 12 * 48, I_UKV = 8 * 64, I_G = 4 * 384, I_BO = 3 * 16 * 128, I_OUT = 64 * 128, I_GA = 64 * 344, I_UP = I_GA, I_DN = 172 * 128, I_LRU = 32 * 8;
          constexpr int I_MIX = I_IN + I_UQ + I_UKV + I_G + I_BO + I_OUT + I_LRU, I_L = I_MIX + I_GA + I_UP + I_DN;
          const int NA = (la >= 0) ? I_L - I_MIX : 0, NIT = NA + ((lb < DEPTH) ? I_MIX : 0);
          float qsl = 1.f / ((const float*)(ws + WS_WSC))[lane & 7];
          asm volatile("s_waitcnt vmcnt(0)" : "+v"(qsl) :: "memory");
          auto dec = [&](int it, const float*& src, size_t& ldw, unsigned char*& dst, size_t& rsb, int& mode, float& q) {
              const int l = (it < NA) ? la : lb; int r = (it < NA) ? I_MIX + it : it - NA;
              int kb, nb, drow, dcol; size_t ldt, woff; mode = 0; q = 1.f;
              if (r < I_IN) { kb = r / 210; nb = r - 210 * kb; src = (const float*)A->in[3] + (size_t)l * DM * NIN; ldw = NIN; woff = WL_IN; ldt = DM; drow = 32 * nb; dcol = 64 * kb; }
              else if ((r -= I_IN) < I_UQ) { kb = r / 48; nb = r - 48 * kb; src = (const float*)A->in[14] + (size_t)l * 768 * 1536; ldw = 1536; woff = WL_UQ; ldt = 768; drow = 32 * nb; dcol = 64 * kb; }
              else if ((r -= I_UQ) < I_UKV) { kb = r / 64; nb = r - 64 * kb; src = (const float*)A->in[16] + (size_t)l * 512 * 2048; ldw = 2048; woff = WL_UKV; ldt = 512; drow = 32 * nb; dcol = 64 * kb; }
              else if ((r -= I_UKV) < I_G) { kb = r / 384; nb = r - 384 * kb; src = (const float*)A->in[19] + (size_t)l * 256 * 12288; ldw = 12288; woff = WL_G; ldt = 256; drow = 32 * nb; dcol = 64 * kb; }
              else if ((r -= I_G) < I_BO) { const int n = r / (16 * 128), r2 = r - n * 16 * 128; kb = r2 / 128; nb = r2 - 128 * kb;
                  src = (const float*)A->in[21] + ((size_t)l * 3 + n) * 1024 * 4096; ldw = 4096; woff = WL_BO; ldt = 3072; drow = 32 * nb; dcol = 1024 * n + 64 * kb; }
              else if ((r -= I_BO) < I_OUT) { kb = r / 128; nb = r - 128 * kb; src = (const float*)A->in[22] + (size_t)l * DM * DM; ldw = DM; woff = WL_OUT; ldt = DM; drow = 32 * nb; dcol = 64 * kb; if (F8O(l)) { mode = 1; q = W8_SCALE; } }
              else if ((r -= I_OUT) < I_LRU) { const int blk = r >> 3, zg = blk >> 3, nbk = blk & 7; kb = (r >> 2) & 1; nb = r & 3;
                  src = (const float*)A->in[10] + ((size_t)l * 32 + blk) * 128 * 128; ldw = 128; woff = WL_LRU; ldt = 256; drow = (2 * nbk + (zg >> 1)) * 256 + (zg & 1) * 128 + 32 * nb; dcol = (nbk & 1) * 128 + 64 * kb; }
              else if ((r -= I_LRU) < I_GA + I_UP) { const int up = r >= I_GA; if (up) r -= I_GA; kb = r / 344; nb = r - 344 * kb; const int n0 = 32 * nb;
                  src = (const float*)A->in[up ? 25 : 24] + (size_t)l * DM * FFH; ldw = FFH; woff = WL_GU; ldt = DM; drow = 256 * (n0 >> 7) + 128 * up + (n0 & 127); dcol = 64 * kb;
                  if (I8U(l)) { mode = 2; q = __builtin_bit_cast(float, __builtin_amdgcn_readlane(__builtin_bit_cast(int, qsl), 2 * l + up)); } else if (F8U(l)) { mode = 1; q = W8_SCALE; } }
              else { r -= I_GA + I_UP; { kb = r / 128; nb = r - 128 * kb; src = (const float*)A->in[26] + (size_t)l * FFH * DM; ldw = DM; woff = WL_DN; ldt = FFH; drow = 32 * nb; dcol = 64 * kb; if (F8L(l)) { mode = 1; q = W8_SCALE; } } }
              src += (size_t)(64 * kb) * ldw + 32 * nb;
              const size_t esz = mode ? 1 : 2;
              dst = ws + WS_W + (size_t)l * WL_SIZE + woff + ((size_t)drow * ldt + dcol) * esz; rsb = ldt * esz; };
          auto LOAD = [&](int it_, f32x4 (&w)[8]) { const float* src; size_t ldw, rsb; unsigned char* dst; int mode; float q; dec(it_, src, ldw, dst, rsb, mode, q);
#pragma unroll
              for (int i = 0; i < 8; ++i) { const float* p_ = src + (size_t)(8 * i + (lane >> 3)) * ldw + 4 * (lane & 7);
                  w[i] = *(const f32x4*)p_; } };
#define TR_WAIT(N, w) do { } while (0)
          auto FIN = [&](int it_, f32x4 (&w)[8]) { const float* src; size_t ldw, rsb; unsigned char* dst; int mode; float q; dec(it_, src, ldw, dst, rsb, mode, q);
#pragma unroll
              for (int i = 0; i < 8; ++i) { LAS float* d_ = scr + (8 * i + (lane >> 3)) * 33 + 4 * (lane & 7); d_[0] = w[i].x; d_[1] = w[i].y; d_[2] = w[i].z; d_[3] = w[i].w; }
              LDS_WAIT(); asm volatile("" ::: "memory");
              const int c = lane & 7;
              if (mode == 0) {
#pragma unroll
                  for (int j = 0; j < 4; ++j) { const int n = (lane >> 3) + 8 * j; const LAS float* sp_ = scr + (8 * c) * 33 + n;
                      u32x4 o; o.x = pk2(sp_[0 * 33], sp_[1 * 33]); o.y = pk2(sp_[2 * 33], sp_[3 * 33]); o.z = pk2(sp_[4 * 33], sp_[5 * 33]); o.w = pk2(sp_[6 * 33], sp_[7 * 33]);
                      *(u32x4*)(dst + (size_t)n * rsb + 16 * c) = o; } }
              else if (mode == 1) {
#pragma unroll
                  for (int j = 0; j < 4; ++j) { const int n = (lane >> 3) + 8 * j; const LAS float* sp_ = scr + (8 * c) * 33 + n;
                      u32x2 o; o.x = pk_fp8x4(sp_[0 * 33] * q, sp_[1 * 33] * q, sp_[2 * 33] * q, sp_[3 * 33] * q); o.y = pk_fp8x4(sp_[4 * 33] * q, sp_[5 * 33] * q, sp_[6 * 33] * q, sp_[7 * 33] * q);
                      *(u32x2*)(dst + (size_t)n * rsb + 8 * c) = o; } }
              else {
#pragma unroll
                  for (int j = 0; j < 4; ++j) { const int n = (lane >> 3) + 8 * j; const LAS float* sp_ = scr + (8 * c) * 33 + n;
                      u32x2 o; o.x = pk_i8x4(sp_[0 * 33] * q, sp_[1 * 33] * q, sp_[2 * 33] * q, sp_[3 * 33] * q); o.y = pk_i8x4(sp_[4 * 33] * q, sp_[5 * 33] * q, sp_[6 * 33] * q, sp_[7 * 33] * q);
                      *(u32x2*)(dst + (size_t)n * rsb + 8 * c) = o; } }
              LDS_WAIT(); asm volatile("" ::: "memory"); };
          f32x4 wa[8], wb[8], wc[8], wd[8];
#pragma nounroll
          for (int it = gw; it < NIT; it += 8 * NGW) {
              const int i1 = it + NGW, i2 = it + 2 * NGW, i3 = it + 3 * NGW, i4 = it + 4 * NGW, i5 = it + 5 * NGW, i6 = it + 6 * NGW, i7 = it + 7 * NGW;
#define TR_C(i) ((i) < NIT ? (i) : NIT - 1)
              LOAD(it, wa); LOAD(TR_C(i1), wb); LOAD(TR_C(i2), wc);
              LOAD(TR_C(i3), wd); FIN(it, wa);
              LOAD(TR_C(i4), wa); if (i1 < NIT) FIN(i1, wb);
              LOAD(TR_C(i5), wb); if (i2 < NIT) FIN(i2, wc);
              LOAD(TR_C(i6), wc); if (i3 < NIT) FIN(i3, wd);
              LOAD(TR_C(i7), wd); if (i4 < NIT) FIN(i4, wa);
              if (i5 < NIT) FIN(i5, wb);
              if (i6 < NIT) FIN(i6, wc);
              if (i7 < NIT) FIN(i7, wd);
#undef TR_C
          }
          asm volatile("s_waitcnt vmcnt(0)" ::: "memory");
#undef TR_WAIT
        }
    };
    if (EN(12) && IN(0)) for (int rep_ = 0; rep_ < NREP(12); ++rep_) { const int tid = opq(tid0), lane = tid & 63; CArgs* A = opq_args(); const int G = opqs(G0), bx = opqs(bx0), gw = opqs(gw0), NGW = G * NWAVES; (void)bx; (void)gw; (void)NGW;
        if (I8UP_LAYERS != 0) {
            if (bx < 2 * DEPTH && I8U(bx >> 1)) {
                const float* Wt = (const float*)A->in[(bx & 1) ? 25 : 24] + (size_t)(bx >> 1) * DM * FFH; float ssq = 0.f, amx = 0.f;
#pragma nounroll
                for (int r = 0; r < 16; ++r) {
                    const f32x4* rowp = (const f32x4*)(Wt + (size_t)(256 * r) * FFH); f32x4 w[6];
#pragma unroll
                    for (int u = 0; u < 6; ++u) { const int i = tid + u * (NWAVES * 64); w[u] = rowp[i < FFH / 4 ? i : 0]; if (i >= FFH / 4) w[u] = (f32x4){0.f, 0.f, 0.f, 0.f}; }
#pragma unroll
                    for (int u = 0; u < 6; ++u) { ssq += (w[u].x * w[u].x + w[u].y * w[u].y) + (w[u].z * w[u].z + w[u].w * w[u].w); amx = fmaxf(fmaxf(amx, fmaxf(fabsf(w[u].x), fabsf(w[u].y))), fmaxf(fabsf(w[u].z), fabsf(w[u].w))); } }
                ssq = wave_sum(ssq); amx = wave_max(amx);
                LAS float* red = (LAS float*)(lds);
                if (lane == 0) { red[2 * wave] = ssq; red[2 * wave + 1] = amx; }
                __syncthreads();
                if (tid == 0) { float a = 0.f, b = 0.f;
                    for (int w = 0; w < NWAVES; ++w) { a += red[2 * w]; b = fmaxf(b, red[2 * w + 1]); }
                    const float rms = sqrtf(a / (16.f * FFH)); float sc = fminf(4.2f * rms, b * 1.05f) * (1.f / 127.f); if (!(sc > 0.f)) sc = 1.f;
                    ((float*)(ws + WS_WSC))[bx] = sc; }
                __syncthreads();
            }
            if (MK_ONE_LAUNCH) { XcdBarrier bar_; bar_.bar = (unsigned*)(ws + WS_CTL) + CW_BAR; bar_.x = xb_xcc_id(); bar_.st = (volatile LAS unsigned*)(lds + MISC_OFF) + 8; xcd_barrier(bar_); }
        }
        { const int* pos = (const int*)A->in[1];
          for (int i = bx * 512 + tid; i < MT * 40; i += G * 512) { const int m = i / 40, f = i - 40 * m;
              float inv; float* cd; float* sd;
              if (f < 8) { inv = exp2f(-(float)(2 * f) / 16.f * 18.931568569324174f); cd = cosA + m * 8 + f; sd = sinA + m * 8 + f; }
              else { const int ff = f - 8; inv = exp2f(-(float)(2 * ff) / 64.f * 18.931568569324174f); cd = cosC + m * 32 + ff; sd = sinC + m * 32 + ff; }
              const float ang = (float)pos[m] * inv; float sv, cv; sincosf(ang, &sv, &cv); *cd = cv; *sd = sv; } }
        { const float* Lsrc = (const float*)A->in[12]; float* spt = (float*)(ws + WS_SPT);
          for (int i = bx * 512 + tid; i < DEPTH * 2048; i += G * 512) spt[i] = -8.f * log1pf(expf(-Lsrc[i])); }
        conv_layer(A, lds, wave, -1, 0, tid, lane, G, bx, gw, NGW);
        SEAM(0);
    }

    for (int l = 0; l < DEPTH; ++l) {
        const int s0 = 1 + 12 * l;
        if (s0 + 12 <= lo || s0 >= hi) continue;
#define wl (ws + WS_W + (size_t)l * WL_SIZE)
#define xcur ((l == 0) ? x_in : (const float*)out)

        if (EN(0) && IN(s0 + 0)) for (int rep_ = 0; rep_ < NREP(0); ++rep_) { const int tid = opq(tid0), lane = tid & 63; (void)tid; (void)lane; CArgs* A = opq_args(); const int G = opqs(G0), bx = opqs(bx0), gw = opqs(gw0), NGW = G * NWAVES; (void)bx; (void)gw; (void)NGW;
            const float* g = (const float*)A->in[2] + (size_t)l * DM;
            for (int m = gw; m < MT; m += NGW) {
                const f32x4* xr = (const f32x4*)(xcur + (size_t)m * DM) + lane;
                f32x4 v[16]; float ss = 0.f;
#pragma unroll
                for (int j = 0; j < 16; ++j) { v[j] = xr[64 * j]; ss += (v[j].x * v[j].x + v[j].y * v[j].y) + (v[j].z * v[j].z + v[j].w * v[j].w); }
                const float rs = rsqrtf(wave_sum(ss) * (1.f / DM) + EPS);
                u32x2* o8 = (u32x2*)(XN + (size_t)m * DM) + lane; const f32x4* gr = (const f32x4*)g + lane;
#pragma unroll
                for (int j = 0; j < 16; ++j) { const f32x4 gg = gr[64 * j]; u32x2 w; w.x = pk2(v[j].x * rs * gg.x, v[j].y * rs * gg.y); w.y = pk2(v[j].z * rs * gg.z, v[j].w * rs * gg.w); o8[64 * j] = w; }
            }
            SEAM(s0 + 0);
        }
        if (EN(1) && IN(s0 + 1)) for (int rep_ = 0; rep_ < NREP(1); ++rep_) { const int tid = opq(tid0), lane = tid & 63; (void)tid; (void)lane; CArgs* A = opq_args(); const int G = opqs(G0), bx = opqs(bx0), gw = opqs(gw0), NGW = G * NWAVES; (void)bx; (void)gw; (void)NGW;
            pg8::Gemm g{XN, (const bf16_t*)(wl + WL_IN), DM, DM, DM}; pg8::SchedPlain S; S.init(MT / 256, NINP / 256 - 4, G, bx, C_BG / 256, 4);
            pg8::EpiBf16 E{H, NINP};
            pg8::gemm_phase(lds, g, S, E);
            SEAM(s0 + 1);
        }
        if (EN(2) && IN(s0 + 2)) for (int rep_ = 0; rep_ < NREP(2); ++rep_) { const int tid = opq(tid0), lane = tid & 63; (void)tid; (void)lane; CArgs* A = opq_args(); const int G = opqs(G0), bx = opqs(bx0), gw = opqs(gw0), NGW = G * NWAVES; (void)bx; (void)gw; (void)NGW;
            const float* gq = (const float*)A->in[4] + l * 64; const float* gk = (const float*)A->in[5] + l * 64;
            const float* gqa = (const float*)A->in[13] + l * 768; const float* gkva = (const float*)A->in[15] + l * 512;
            const float* cw = (const float*)A->in[8] + l * 4096; const float* cb = (const float*)A->in[9] + l * 1024;
            const bool dry = (NREP(2) == 2) && (rep_ == 0);
            for (int m = gw; m < MT; m += NGW) {
                bf16_t* hr = H + (size_t)m * NINP; bf16_t* hw = dry ? (bf16_t*)TMP + (size_t)m * NINP : hr;
                const int t = m & (SEQ - 1);
                u32x4 rq[2][2], rc0, rc1 = {0u, 0u, 0u, 0u}, rkv, ru[4][2];
#pragma unroll
                for (int qk = 0; qk < 2; ++qk) { rq[qk][0] = *(const u32x4*)(hr + qk * 1024 + 16 * lane); rq[qk][1] = *(const u32x4*)(hr + qk * 1024 + 16 * lane + 8); }
                rc0 = *(const u32x4*)(hr + C_CQ + 8 * lane); if (lane < 32) rc1 = *(const u32x4*)(hr + C_CQ + 8 * (64 + lane));
                rkv = *(const u32x4*)(hr + C_CKV + 8 * lane);
#pragma unroll
                for (int j = 0; j < 4; ++j) { const int tt = t + j - 2; const bool ok = (tt >= 0 && tt < SEQ); const bf16_t* ur = H + (size_t)(ok ? m + j - 2 : m) * NINP + C_BX + 16 * lane;
                    ru[j][0] = *(const u32x4*)ur; ru[j][1] = *(const u32x4*)(ur + 8); }
                float ca[8], sa[8];
                { const f32x4 c0 = *(const f32x4*)(cosA + m * 8), c1 = *(const f32x4*)(cosA + m * 8 + 4), s0_ = *(const f32x4*)(sinA + m * 8), s1_ = *(const f32x4*)(sinA + m * 8 + 4);
#pragma unroll
                  for (int e = 0; e < 4; ++e) { ca[e] = c0[e]; ca[4 + e] = c1[e]; sa[e] = s0_[e]; sa[4 + e] = s1_[e]; } }
#pragma unroll
                for (int qk = 0; qk < 2; ++qk) {
                    bf16_t* p = hw + qk * 1024 + 16 * lane;
                    float v[16]; unpack8(rq[qk][0], v); unpack8(rq[qk][1], v + 8);
                    float ss = 0.f;
#pragma unroll
                    for (int e = 0; e < 16; ++e) ss += v[e] * v[e];
                    ss += __shfl_xor(ss, 1); ss += __shfl_xor(ss, 2);
                    const float rs = rsqrtf(ss * (1.f / 64.f) + EPS);
                    const float* gg = (qk ? gk : gq) + 16 * (lane & 3);
#pragma unroll
                    for (int e = 0; e < 16; ++e) v[e] = v[e] * rs * gg[e];
                    if ((lane & 3) == 0) {
#pragma unroll
                        for (int i = 0; i < 8; ++i) { const float c = ca[i], sn = sa[i], x1 = v[i], x2 = v[i + 8]; v[i] = x1 * c - x2 * sn; v[i + 8] = x2 * c + x1 * sn; } }
                    if (qk == 0) {
#pragma unroll
                        for (int e = 0; e < 16; ++e) v[e] *= CA; }
                    *(u32x4*)p = pack8(v); *(u32x4*)(p + 8) = pack8(v + 8);
                }
                { bf16_t* p = hw + C_CQ; float v0[8], v1[8]; unpack8(rc0, v0); unpack8(rc1, v1);
                  float ss = 0.f;
#pragma unroll
                  for (int e = 0; e < 8; ++e) ss += v0[e] * v0[e] + v1[e] * v1[e];
                  const float rs = rsqrtf(wave_sum(ss) * (1.f / 768.f) + EPS);
#pragma unroll
                  for (int e = 0; e < 8; ++e) { v0[e] = v0[e] * rs * gqa[8 * lane + e]; }
                  *(u32x4*)(p + 8 * lane) = pack8(v0);
                  if (lane < 32) {
#pragma unroll
                      for (int e = 0; e < 8; ++e) v1[e] = v1[e] * rs * gqa[8 * (64 + lane) + e];
                      *(u32x4*)(p + 8 * (64 + lane)) = pack8(v1); } }
                { bf16_t* p = hw + C_CKV + 8 * lane; float v0[8]; unpack8(rkv, v0);
                  float ss = 0.f;
#pragma unroll
                  for (int e = 0; e < 8; ++e) ss += v0[e] * v0[e];
                  const float rs = rsqrtf(wave_sum(ss) * (1.f / 512.f) + EPS);
#pragma unroll
                  for (int e = 0; e < 8; ++e) v0[e] = v0[e] * rs * gkva[8 * lane + e];
                  *(u32x4*)p = pack8(v0); }
                { float a[16];
#pragma unroll
                  for (int e = 0; e < 16; ++e) a[e] = cb[16 * lane + e];
#pragma unroll
                  for (int j = 0; j < 4; ++j) { const int tt = t + j - 2;
                      if (tt >= 0 && tt < SEQ) { float uv[16]; unpack8(ru[j][0], uv); unpack8(ru[j][1], uv + 8);
#pragma unroll
                          for (int e = 0; e < 16; ++e) a[e] += cw[j * 1024 + 16 * lane + e] * uv[e]; } }
                  bf16_t* up = (dry ? (bf16_t*)TMP : UC) + (size_t)m * 1024 + 16 * lane; *(u32x4*)up = pack8(a); *(u32x4*)(up + 8) = pack8(a + 8); }
            }
            SEAM(s0 + 2);
        }
        if (EN(3) && IN(s0 + 3)) for (int rep_ = 0; rep_ < NREP(3); ++rep_) { const int tid = opq(tid0), lane = tid & 63; (void)tid; (void)lane; CArgs* A = opq_args(); const int G = opqs(G0), bx = opqs(bx0), gw = opqs(gw0), NGW = G * NWAVES; (void)bx; (void)gw; (void)NGW;
            const int GA = G / 2, GB = G - GA, cA = (bx < GA) ? bx : -1, cB = (bx >= GA) ? bx - GA : -1;
            { pg8::Gemm g{XN, (const bf16_t*)(wl + WL_IN) + (size_t)C_BG * DM, DM, DM, DM}; pg8::SchedPlain S; S.init(MT / 256, 4, GA, cA); pg8::EpiBf16 E{H + C_BG, NINP}; pg8::gemm_phase(lds, g, S, E); }
            if (P3EN(0)) { pg8::Gemm g{H + C_CQ, (const bf16_t*)(wl + WL_UQ), NINP, 768, 768}; pg8::SchedPlain S; S.init(MT / 256, 1536 / 256, GB, cB); pg8::EpiBf16 E{QM, 1536}; pg8::gemm_phase(lds, g, S, E); }
            if (P3EN(1)) { pg8::Gemm g{H + C_CKV, (const bf16_t*)(wl + WL_UKV), NINP, 512, 512}; pg8::SchedPlain S; S.init(MT / 256, 2048 / 256, GB, cB); pg8::EpiBf16 E{KV, 2048}; pg8::gemm_phase(lds, g, S, E); }
            if (P3EN(2)) { pg8::Gemm g{UC, (const bf16_t*)(wl + WL_LRU), 1024, 256, 256}; pg8::SchedSplit S; S.init(MT / 256, 16, GA, GB, bx, P3_LRU_A * GA < 512 ? P3_LRU_A * GA : 512, 1);
              pg8::EpiLru E{UC, (const float*)A->in[11] + (size_t)l * 4096, (const float*)(ws + WS_SPT) + (size_t)l * 2048, LAB}; pg8::gemm_phase(lds, g, S, E); }
            if (P3EN(3)) { pg8::Gemm g{H + C_GLR, (const bf16_t*)(wl + WL_G), NINP, 256, 256}; pg8::SchedSplit S; S.init(MT / 256, 12288 / 256, GA, GB, bx, P3_GATE_A * GA < 1536 ? P3_GATE_A * GA : 1536);
              pg8::EpiSig E{GATES, 12288, (const float*)A->in[20] + (size_t)l * 12288}; pg8::gemm_phase(lds, g, S, E); }
            SEAM(s0 + 3);
        }
        if (EN(4) && IN(s0 + 4)) for (int rep_ = 0; rep_ < NREP(4); ++rep_) { const int tid = opq(tid0), lane = tid & 63; (void)tid; (void)lane; CArgs* A = opq_args(); const int G = opqs(G0), bx = opqs(bx0), gw = opqs(gw0), NGW = G * NWAVES; (void)bx; (void)gw; (void)NGW;
            const float* gq = (const float*)A->in[17] + l * 192; const float* gk = (const float*)A->in[18] + l * 192;
            const int half = lane >> 5, j = lane & 31; const bool act = j < 24; const int jj = act ? j : 0;
            const bool dry = (NREP(4) == 2) && (rep_ == 0);
            for (int m = gw; m < MT; m += NGW) {
                u32x4 qraw[4], kraw[4];
                const bf16_t* qrow = QM + (size_t)m * 1536 + half * 192 + 8 * jj; const bf16_t* kvrow = KV + (size_t)m * 2048 + half * 256 + 8 * (jj < 8 ? 0 : jj - 8);
                const u32x4 kpe = *(const u32x4*)(H + (size_t)m * NINP + C_KPE + 8 * (jj & 7));
#pragma unroll
                for (int hp = 0; hp < 4; ++hp) { qraw[hp] = *(const u32x4*)(qrow + hp * 384); kraw[hp] = *(const u32x4*)(kvrow + hp * 512); }
                float cs[8], sn[8];
                { const f32x4 c0 = *(const f32x4*)(cosC + m * 32 + 8 * (jj & 3)), c1 = *(const f32x4*)(cosC + m * 32 + 8 * (jj & 3) + 4), s0_ = *(const f32x4*)(sinC + m * 32 + 8 * (jj & 3)), s1_ = *(const f32x4*)(sinC + m * 32 + 8 * (jj & 3) + 4);
#pragma unroll
                  for (int e = 0; e < 4; ++e) { cs[e] = c0[e]; cs[4 + e] = c1[e]; sn[e] = s0_[e]; sn[4 + e] = s1_[e]; } }
#pragma unroll
                for (int hp = 0; hp < 4; ++hp) {
#pragma unroll
                    for (int qk = 0; qk < 2; ++qk) {
                        float v[8]; unpack8(qk == 0 ? qraw[hp] : (j < 8 ? kpe : kraw[hp]), v);
                        if (!act) {
#pragma unroll
                            for (int e = 0; e < 8; ++e) v[e] = 0.f; }
                        float ss = 0.f;
#pragma unroll
                        for (int e = 0; e < 8; ++e) ss += v[e] * v[e];
#pragma unroll
                        for (int o = 1; o < 32; o <<= 1) ss += __shfl_xor(ss, o);
                        const float rs = rsqrtf(ss * (1.f / 192.f) + EPS);
                        const float* gg = (qk ? gk : gq) + 8 * jj;
#pragma unroll
                        for (int e = 0; e < 8; ++e) v[e] = v[e] * rs * gg[e];
                        float pr[8];
#pragma unroll
                        for (int e = 0; e < 8; ++e) pr[e] = __shfl_xor(v[e], 4);
                        if (j < 8) {
#pragma unroll
                            for (int e = 0; e < 8; ++e) v[e] = (j < 4) ? v[e] * cs[e] - pr[e] * sn[e] : v[e] * cs[e] + pr[e] * sn[e]; }
                        if (qk == 0) {
#pragma unroll
                            for (int e = 0; e < 8; ++e) v[e] *= CM; }
                        if (act) { bf16_t* dst = (dry ? (bf16_t*)TMP + (size_t)qk * MT * 1536 : (qk == 0 ? QM : KM)) + (size_t)m * 1536 + (2 * hp + half) * 192 + 8 * j; *(u32x4*)dst = pack8(v); }
                    }
                }
            }
            for (int it = gw; it < 2048; it += NGW) {
                const int cg = it & 3, k = (it >> 2) & 127, b = (it >> 9) & 1, z = it >> 10, c = 256 * cg + 4 * lane;
                const unsigned* ap = LAB + ((size_t)z * MT + b * SEQ + 32 * k) * 1024 + c;
                f32x4 P = {1.f, 1.f, 1.f, 1.f}, Hh = {0.f, 0.f, 0.f, 0.f};
#pragma unroll 8
                for (int s = 0; s < 32; ++s) { const int t = z ? 31 - s : s; const u32x4 w = *(const u32x4*)(ap + (size_t)t * 1024);
                    const f32x4 a = {1.f - bf_lo(w.x), 1.f - bf_lo(w.y), 1.f - bf_lo(w.z), 1.f - bf_lo(w.w)}, x = {bf_hi(w.x), bf_hi(w.y), bf_hi(w.z), bf_hi(w.w)}; Hh = a * Hh + x; P = P * a; }
                *(f32x4*)(AGP + ((size_t)(z * 2 + b) * 128 + k) * 1024 + c) = P; *(f32x4*)(AGH + ((size_t)(z * 2 + b) * 128 + k) * 1024 + c) = Hh;
            }
            SEAM(s0 + 4);
        }
        if (EN(5) && IN(s0 + 5)) for (int rep_ = 0; rep_ < NREP(5); ++rep_) { const int tid = opq(tid0), lane = tid & 63; (void)tid; (void)lane; CArgs* A = opq_args(); const int G = opqs(G0), bx = opqs(bx0), gw = opqs(gw0), NGW = G * NWAVES; (void)bx; (void)gw; (void)NGW;
            const int r32 = lane & 31, hh = lane >> 5;
            float negA, negC, lam;
            { const float* gq = (const float*)A->in[4] + l * 64; const float* gk = (const float*)A->in[5] + l * 64;
              const float mq = wave_max(fabsf(gq[lane])), mk = wave_max(fabsf(gk[lane]));
              negA = -(8.f * mq * mk * LOG2E * 1.01f);
              const float* gq2 = (const float*)A->in[17] + l * 192; const float* gk2 = (const float*)A->in[18] + l * 192;
              const float mq2 = wave_max(fmaxf(fmaxf(fabsf(gq2[lane]), fabsf(gq2[64 + lane])), fabsf(gq2[128 + lane])));
              const float mk2 = wave_max(fmaxf(fmaxf(fabsf(gk2[lane]), fabsf(gk2[64 + lane])), fabsf(gk2[128 + lane])));
              negC = -(13.856406460551018f * mq2 * mk2 * LOG2E * 1.01f);
              const float* lp = (const float*)A->in[6] + l * 256;
              const float s1 = wave_sum(lp[lane] * lp[64 + lane]), s2 = wave_sum(lp[128 + lane] * lp[192 + lane]);
              lam = expf(s1) - expf(s2) + (0.8f - 0.6f * expf(-0.3f * (float)l)); }
            const int cls = (bx >> 3) & 3;
            if (cls == 0) { asm volatile("s_waitcnt vmcnt(0) lgkmcnt(0)" ::: "memory"); __syncthreads(); { const int tidc = opq(tid0); CArgs* Ac = opq_args(); conv_layer(Ac, lds, wave, l, l + 1, tidc, tidc & 63, opqs(G0), opqs(bx0), opqs(gw0), opqs(G0) * NWAVES); } asm volatile("s_waitcnt vmcnt(0) lgkmcnt(0)" ::: "memory"); __syncthreads(); }
            for (int u = bx; u < 256; u += G) {
                const int jj = u >> 3, bh = 2 * (u & 7) + (jj >> 4), qb = jj & 15, b = bh >> 3, h = bh & 7;
                const size_t row0 = (size_t)b * SEQ + qb * 256, krow0 = (size_t)b * SEQ;
                f32x16 o[4];
                if (P5EN(0)) for (int n4_ = 0; n4_ < ((P5DUP & 1) ? 4 : 2); ++n4_) { const int n = n4_ & 1;
                    if (n4_ == 1) { if (cls == 1) { asm volatile("s_waitcnt vmcnt(0) lgkmcnt(0)" ::: "memory"); __syncthreads(); { const int tidc = opq(tid0); CArgs* Ac = opq_args(); conv_layer(Ac, lds, wave, l, l + 1, tidc, tidc & 63, opqs(G0), opqs(bx0), opqs(gw0), opqs(G0) * NWAVES); } asm volatile("s_waitcnt vmcnt(0) lgkmcnt(0)" ::: "memory"); __syncthreads(); } }
                    att::attn_body_dma<1>(H + row0 * NINP + C_AQ + h * 128 + n * 64, NINP, H + krow0 * NINP + C_AK + h * 128 + n * 64, NINP, H + krow0 * NINP + C_AV + h * 128, NINP, negA, (LAS char*)lds, o);
                    { const int le = opq(lane), r32e = le & 31, hhe = le >> 5;
                      float* dbase = DBUF + (row0 + wave * 32 + 4 * hhe) * 1024 + h * 128 + r32e;
                      if (n == 0) {
#pragma unroll
                          for (int r = 0; r < 16; ++r) { float* dp = dbase + ((r & 3) + 8 * (r >> 2)) * 1024;
#pragma unroll
                              for (int d0 = 0; d0 < 4; ++d0) dp[d0 * 32] = o[d0][r]; }
                      } else {
                          const float* sg = (const float*)A->in[7] + l * 128 + r32e; const float omli = 1.f - (0.8f - 0.6f * expf(-0.3f * (float)l));
                          const float g0 = sg[0] * omli, g1 = sg[32] * omli, g2 = sg[64] * omli, g3 = sg[96] * omli;
                          bf16_t* obase = OCAT + (row0 + wave * 32 + 4 * hhe) * 3072 + h * 128 + r32e;
#pragma unroll
                          for (int r = 0; r < 16; ++r) { const float* dp = dbase + ((r & 3) + 8 * (r >> 2)) * 1024;
                              const float e0 = dp[0] - lam * o[0][r], e1 = dp[32] - lam * o[1][r], e2 = dp[64] - lam * o[2][r], e3 = dp[96] - lam * o[3][r];
                              float ss = (e0 * e0 + e1 * e1) + (e2 * e2 + e3 * e3);
#pragma unroll
                              for (int of = 1; of < 32; of <<= 1) ss += __shfl_xor(ss, of);
                              const float rs = rsqrtf(ss * (1.f / 128.f) + EPS);
                              bf16_t* op = obase + ((r & 3) + 8 * (r >> 2)) * 3072;
                              op[0] = (bf16_t)f2bf(e0 * rs * g0); op[32] = (bf16_t)f2bf(e1 * rs * g1); op[64] = (bf16_t)f2bf(e2 * rs * g2); op[96] = (bf16_t)f2bf(e3 * rs * g3); }
                      } }
                }
                if (cls == 2) { asm volatile("s_waitcnt vmcnt(0) lgkmcnt(0)" ::: "memory"); __syncthreads(); { const int tidc = opq(tid0); CArgs* Ac = opq_args(); conv_layer(Ac, lds, wave, l, l + 1, tidc, tidc & 63, opqs(G0), opqs(bx0), opqs(gw0), opqs(G0) * NWAVES); } asm volatile("s_waitcnt vmcnt(0) lgkmcnt(0)" ::: "memory"); __syncthreads(); }
                for (int r5_ = 0; r5_ < ((P5DUP & 2) ? 2 : 1); ++r5_) {
                if (P5EN(1)) att::attn_body_dma<3>(QM + row0 * 1536 + h * 192, 1536, KM + krow0 * 1536 + h * 192, 1536, KV + krow0 * 2048 + h * 256 + 128, 2048, negC, (LAS char*)lds, o);
                if (P5EN(1)) { const int le = opq(lane), r32e = le & 31, hhe = le >> 5;
                  bf16_t* obase = OCAT + (row0 + wave * 32 + 4 * hhe) * 3072 + 2048 + h * 128 + r32e;
#pragma unroll
                  for (int r = 0; r < 16; ++r) { bf16_t* op = obase + ((r & 3) + 8 * (r >> 2)) * 3072;
#pragma unroll
                      for (int d0 = 0; d0 < 4; ++d0) op[d0 * 32] = (bf16_t)f2bf(o[d0][r]); } }
                }
            }
            if (cls == 3) { asm volatile("s_waitcnt vmcnt(0) lgkmcnt(0)" ::: "memory"); __syncthreads(); { const int tidc = opq(tid0); CArgs* Ac = opq_args(); conv_layer(Ac, lds, wave, l, l + 1, tidc, tidc & 63, opqs(G0), opqs(bx0), opqs(gw0), opqs(G0) * NWAVES); } asm volatile("s_waitcnt vmcnt(0) lgkmcnt(0)" ::: "memory"); __syncthreads(); }
            for (int r6_ = 0; r6_ < ((P5DUP & 4) ? 2 : 1); ++r6_)
            for (int it = gw; it < 4096; it += NGW) {
                const int cgp = it & 15, k = (it >> 4) & 127, b = it >> 11, c = 64 * cgp + lane;
                float cf = 0.f, cbk = 0.f;
                { const float* Pf = AGP + ((size_t)(0 * 2 + b) * 128) * 1024 + c; const float* Hf = AGH + ((size_t)(0 * 2 + b) * 128) * 1024 + c;
                  for (int j0 = 0; j0 < k; j0 += 32) {
                      float pp[32], hh[32];
#pragma unroll
                      for (int i = 0; i < 32; ++i) { const int j = (j0 + i < k) ? j0 + i : k - 1; pp[i] = Pf[(size_t)j * 1024]; hh[i] = Hf[(size_t)j * 1024]; }
#pragma unroll
                      for (int i = 0; i < 32; ++i) if (j0 + i < k) cf = pp[i] * cf + hh[i];
                  }
                  const float* Pb = AGP + ((size_t)(1 * 2 + b) * 128) * 1024 + c; const float* Hb = AGH + ((size_t)(1 * 2 + b) * 128) * 1024 + c;
                  for (int j0 = 127; j0 > k; j0 -= 32) {
                      float pp[32], hh[32];
#pragma unroll
                      for (int i = 0; i < 32; ++i) { const int j = (j0 - i > k) ? j0 - i : k + 1; pp[i] = Pb[(size_t)j * 1024]; hh[i] = Hb[(size_t)j * 1024]; }
#pragma unroll
                      for (int i = 0; i < 32; ++i) if (j0 - i > k) cbk = pp[i] * cbk + hh[i];
                  } }
                const size_t m0 = (size_t)b * SEQ + 32 * k;
                float hb[32]; float hcur = cbk;
#pragma unroll
                for (int s = 31; s >= 0; --s) { const unsigned w = LAB[((size_t)MT + m0 + s) * 1024 + c]; hcur = (1.f - bf_lo(w)) * hcur + bf_hi(w); hb[s] = hcur; }
                hcur = cf;
#pragma unroll
                for (int hf = 0; hf < 2; ++hf) {
                    float fa[16], fx[16], fg[16];
#pragma unroll
                    for (int s = 0; s < 16; ++s) { const size_t mm = m0 + 16 * hf + s; { const unsigned w = LAB[mm * 1024 + c]; fa[s] = 1.f - bf_lo(w); fx[s] = bf_hi(w); } fg[s] = bf2f(H[mm * NINP + C_BG + c]); }
#pragma unroll
                    for (int s = 0; s < 16; ++s) { hcur = fa[s] * hcur + fx[s];
                        OCAT[(m0 + 16 * hf + s) * 3072 + 1024 + c] = (bf16_t)f2bf((hcur + hb[16 * hf + s]) * gelu_tanh(fg[s])); }
                }
            }

            SEAM(s0 + 5);
        }
        if (EN(6) && IN(s0 + 6)) for (int rep_ = 0; rep_ < NREP(6); ++rep_) { const int tid = opq(tid0), lane = tid & 63; (void)tid; (void)lane; CArgs* A = opq_args(); const int G = opqs(G0), bx = opqs(bx0), gw = opqs(gw0), NGW = G * NWAVES; (void)bx; (void)gw; (void)NGW;
        }
        if (EN(7) && IN(s0 + 7)) for (int rep_ = 0; rep_ < NREP(7); ++rep_) { const int tid = opq(tid0), lane = tid & 63; (void)tid; (void)lane; CArgs* A = opq_args(); const int G = opqs(G0), bx = opqs(bx0), gw = opqs(gw0), NGW = G * NWAVES; (void)bx; (void)gw; (void)NGW;
            pg8::Gemm g{OCAT, (const bf16_t*)(wl + WL_BO), 3072, 3072, 1024}; pg8::SchedBo S; S.init(MT / 256, DM / 256, G, bx);
            pg8::EpiBo E{GATES, YSUM, F8O(l) ? 1 : 0};
            pg8::gemm_phase(lds, g, S, E);
            SEAM(s0 + 7);
        }
        if (EN(8) && IN(s0 + 8)) for (int rep_ = 0; rep_ < NREP(8); ++rep_) { const int tid = opq(tid0), lane = tid & 63; (void)tid; (void)lane; CArgs* A = opq_args(); const int G = opqs(G0), bx = opqs(bx0), gw = opqs(gw0), NGW = G * NWAVES; (void)bx; (void)gw; (void)NGW;
            pg8::Gemm g{YSUM, (const bf16_t*)(wl + WL_OUT), DM, DM, DM}; pg8::SchedPlain S; S.init(MT / 256, DM / 256, G, bx);
            if (F8O(l)) { pg8::EpiRes E{xcur, ((NREP(8) == 2) && (rep_ == 0)) ? TMP : out, W8_INV}; pg8::gemm_phase<pg8::EpiRes, pg8::SchedPlain, 1>(lds, g, S, E); }
            else { pg8::EpiRes E{xcur, ((NREP(8) == 2) && (rep_ == 0)) ? TMP : out, 1.f}; pg8::gemm_phase(lds, g, S, E); }
            SEAM(s0 + 8);
        }
        if (EN(9) && IN(s0 + 9)) for (int rep_ = 0; rep_ < NREP(9); ++rep_) { const int tid = opq(tid0), lane = tid & 63; (void)tid; (void)lane; CArgs* A = opq_args(); const int G = opqs(G0), bx = opqs(bx0), gw = opqs(gw0), NGW = G * NWAVES; (void)bx; (void)gw; (void)NGW;
            const float* g = (const float*)A->in[23] + (size_t)l * DM;
            for (int m = gw; m < MT; m += NGW) {
                const f32x4* xr = (const f32x4*)(out + (size_t)m * DM) + lane;
                f32x4 v[16]; float ss = 0.f;
#pragma unroll
                for (int j = 0; j < 16; ++j) { v[j] = xr[64 * j]; ss += (v[j].x * v[j].x + v[j].y * v[j].y) + (v[j].z * v[j].z + v[j].w * v[j].w); }
                const float rs = rsqrtf(wave_sum(ss) * (1.f / DM) + EPS);
                const f32x4* gr = (const f32x4*)g + lane;
                if (I8U(l)) {
                    float amx = 0.f, ssy = 0.f;
#pragma unroll
                    for (int j = 0; j < 16; ++j) { const f32x4 gg = gr[64 * j]; v[j].x = v[j].x * rs * gg.x; v[j].y = v[j].y * rs * gg.y; v[j].z = v[j].z * rs * gg.z; v[j].w = v[j].w * rs * gg.w;
                        ssy += (v[j].x * v[j].x + v[j].y * v[j].y) + (v[j].z * v[j].z + v[j].w * v[j].w);
                        amx = fmaxf(fmaxf(amx, fmaxf(fabsf(v[j].x), fabsf(v[j].y))), fmaxf(fabsf(v[j].z), fabsf(v[j].w))); }
                    amx = wave_max(amx); const float clipv = fminf(amx, 4.2f * sqrtf(wave_sum(ssy) * (1.f / DM)));
                    const float sc = (clipv > 0.f) ? clipv * (1.f / 127.f) : 1.f, inv = 1.f / sc;
                    unsigned* o4 = (unsigned*)((unsigned char*)XN + (size_t)m * DM) + lane;
#pragma unroll
                    for (int j = 0; j < 16; ++j) o4[64 * j] = pk_i8x4(v[j].x * inv, v[j].y * inv, v[j].z * inv, v[j].w * inv);
                    if (lane == 0) ((float*)(ws + WS_XS))[m] = sc; }
                else if (F8U(l)) { unsigned* o4 = (unsigned*)((unsigned char*)XN + (size_t)m * DM) + lane;
#pragma unroll
                    for (int j = 0; j < 16; ++j) { const f32x4 gg = gr[64 * j]; o4[64 * j] = pk_fp8x4(v[j].x * rs * gg.x, v[j].y * rs * gg.y, v[j].z * rs * gg.z, v[j].w * rs * gg.w); } }
                else { u32x2* o8 = (u32x2*)(XN + (size_t)m * DM) + lane;
#pragma unroll
                    for (int j = 0; j < 16; ++j) { const f32x4 gg = gr[64 * j]; u32x2 w; w.x = pk2(v[j].x * rs * gg.x, v[j].y * rs * gg.y); w.y = pk2(v[j].z * rs * gg.z, v[j].w * rs * gg.w); o8[64 * j] = w; } }
            }
            SEAM(s0 + 9);
        }
        if (EN(10) && IN(s0 + 10)) for (int rep_ = 0; rep_ < NREP(10); ++rep_) { const int tid = opq(tid0), lane = tid & 63; (void)tid; (void)lane; CArgs* A = opq_args(); const int G = opqs(G0), bx = opqs(bx0), gw = opqs(gw0), NGW = G * NWAVES; (void)bx; (void)gw; (void)NGW;
            pg8::Gemm g{XN, (const bf16_t*)(wl + WL_GU), DM, DM, DM}; pg8::SchedPlain S; S.init(MT / 256, 2 * FFH / 256, G, bx);
            if (I8U(l)) { pg8::EpiSwigluI8 E{(void*)HID, (const float*)(ws + WS_XS), (const float*)(ws + WS_WSC) + 2 * l, F8L(l) ? 1 : 0}; pg8::gemm_phase<pg8::EpiSwigluI8, pg8::SchedPlain, 2>(lds, g, S, E); }
            else if (F8U(l)) { pg8::EpiSwiglu<true> E{(void*)HID, W8_INV}; pg8::gemm_phase<pg8::EpiSwiglu<true>, pg8::SchedPlain, 1>(lds, g, S, E); }
            else if (F8L(l)) { pg8::EpiSwiglu<true> E{(void*)HID, 1.f}; pg8::gemm_phase(lds, g, S, E); }
            else { pg8::EpiSwiglu<false> E{(void*)HID, 1.f}; pg8::gemm_phase(lds, g, S, E); }
            SEAM(s0 + 10);
        }
        if (EN(11) && IN(s0 + 11)) for (int rep_ = 0; rep_ < NREP(11); ++rep_) { const int tid = opq(tid0), lane = tid & 63; (void)tid; (void)lane; CArgs* A = opq_args(); const int G = opqs(G0), bx = opqs(bx0), gw = opqs(gw0), NGW = G * NWAVES; (void)bx; (void)gw; (void)NGW;
            pg8::Gemm g{HID, (const bf16_t*)(wl + WL_DN), FFH, FFH, FFH}; pg8::SchedPlain S; S.init(MT / 256, DM / 256, G, bx);
            const bool dry11 = (NREP(11) == 2) && (rep_ == 0);
            if (F8L(l)) { pg8::EpiRes E{(const float*)out, dry11 ? TMP : out, W8_INV}; pg8::gemm_phase<pg8::EpiRes, pg8::SchedPlain, 1>(lds, g, S, E); }
            else { pg8::EpiRes E{(const float*)out, dry11 ? TMP : out, 1.f}; pg8::gemm_phase<pg8::EpiRes, pg8::SchedPlain, 0>(lds, g, S, E); }
            SEAM(s0 + 11);
        }
    }
#undef IN
#undef SEAM
#undef cosA
#undef sinA
#undef cosC
#undef sinC
#undef XN
#undef H
#undef UC
#undef QM
#undef KV
#undef KM
#undef LAB
#undef AGP
#undef AGH
#undef GATES
#undef DBUF
#undef OCAT
#undef TMP
#undef YSUM
#undef HID
#undef x_in
#undef out
#undef ws
#undef wl
#undef xcur
}


#ifdef PROBE_S
__global__ void probe_dump(const unsigned char* ws_, float* outp) {
    for (size_t i = (size_t)blockIdx.x * 256 + threadIdx.x; i < (size_t)MT * DM; i += (size_t)gridDim.x * 256) {
        const size_t m = i / DM, c = i % DM; float v = 0.f;
        const bf16_t* Hh = (const bf16_t*)(ws_ + WS_H); v += bf2f(Hh[m * NINP + c]) + bf2f(Hh[m * NINP + 2816 + c]);
        v += bf2f(((const bf16_t*)(ws_ + WS_UC))[m * 1024 + (c & 1023)]);
        v += bf2f(((const bf16_t*)(ws_ + WS_QM))[m * 1536 + (c % 1536)]) + bf2f(((const bf16_t*)(ws_ + WS_KM))[m * 1536 + (c % 1536)]) + bf2f(((const bf16_t*)(ws_ + WS_KV))[m * 2048 + (c & 2047)]);
        v += bf_hi(((const unsigned*)(ws_ + WS_LAB))[m * 1024 + (c & 1023)]) + bf_hi(((const unsigned*)(ws_ + WS_LAB))[((size_t)MT + m) * 1024 + (c & 1023)]);
        v += ((const float*)(ws_ + WS_AGP))[i % (2 * 2 * 128 * 1024)] + ((const float*)(ws_ + WS_AGH))[i % (2 * 2 * 128 * 1024)];
        const bf16_t* Gg = (const bf16_t*)(ws_ + WS_GATES); v += bf2f(Gg[m * 12288 + c]) + bf2f(Gg[m * 12288 + 4096 + c]) + bf2f(Gg[m * 12288 + 8192 + c]);
#if PROBE_S >= 7
        v += ((const float*)(ws_ + WS_DBUF))[m * 1024 + (c & 1023)];
        v += bf2f(((const bf16_t*)(ws_ + WS_OCAT))[m * 3072 + 2048 + (c & 1023)]);
#endif
#if PROBE_S >= 8
        v += bf2f(((const bf16_t*)(ws_ + WS_OCAT))[m * 3072 + (c % 3072)]);
#endif
#if PROBE_S >= 9
        v += bf2f(((const bf16_t*)(ws_ + WS_YSUM))[m * DM + c]);
#endif
        outp[i] = v;
    }
}
#endif

extern "C" void kernel_launch(void* const* d_in, const int* in_sizes, int n_in, void* d_out, int out_size, void* d_ws, size_t ws_size, hipStream_t stream) {
    static int grid = 0;
    if (grid == 0) {
        if (n_in != 27 || out_size != MT * DM || ws_size < WS_END) { fprintf(stderr, "kernel_launch: shape mismatch: n_in %d out %d ws %zu (need %zu)\n", n_in, out_size, ws_size, (size_t)WS_END); grid = -1; return; }
        int dev = 0, cus = 0, per_cu = 0;
        if (hipGetDevice(&dev) != hipSuccess || hipDeviceGetAttribute(&cus, hipDeviceAttributeMultiprocessorCount, dev) != hipSuccess) { grid = -1; return; }
        if (hipFuncSetAttribute((const void*)fwd, hipFuncAttributeMaxDynamicSharedMemorySize, LDS_BYTES) != hipSuccess) { fprintf(stderr, "kernel_launch: hipFuncSetAttribute failed\n"); grid = -1; return; }
        if (hipOccupancyMaxActiveBlocksPerMultiprocessor(&per_cu, (const void*)fwd, NWAVES * 64, LDS_BYTES) != hipSuccess || per_cu < 1) { fprintf(stderr, "kernel_launch: occupancy query says %d\n", per_cu); }
        (void)hipGetLastError();
        grid = cus;
    }
    if (grid < 0) return;
    if (hipMemsetAsync((char*)d_ws + WS_CTL, 0, CTL_BYTES, stream) != hipSuccess) return;
    Args a{};
    for (int i = 0; i < 27; ++i) a.in[i] = d_in[i];
    a.out = (float*)d_out; a.ws = (unsigned char*)d_ws;
#if MK_ONE_LAUNCH
    a.step_lo = 0; a.step_hi = NSTEP;
    hipLaunchKernelGGL(fwd, dim3(grid), dim3(NWAVES * 64), LDS_BYTES, stream, a);
#else
#ifdef PROBE_S
    for (int s = 0; s < PROBE_S; ++s) { a.step_lo = s; a.step_hi = s + 1; hipLaunchKernelGGL(fwd, dim3(grid), dim3(NWAVES * 64), LDS_BYTES, stream, a); }
    hipLaunchKernelGGL(probe_dump, dim3(2048), dim3(256), 0, stream, (const unsigned char*)d_ws, (float*)d_out);
#else
    for (int s = 0; s < NSTEP; ++s) { a.step_lo = s; a.step_hi = s + 1; hipLaunchKernelGGL(fwd, dim3(grid), dim3(NWAVES * 64), LDS_BYTES, stream, a); }
#endif
#endif
    const hipError_t le = hipPeekAtLastError();
    if (le != hipSuccess) fprintf(stderr, "kernel_launch: launch failed: %s\n", hipGetErrorName(le));
}
```

```cpp
#include <hip/hip_runtime.h>
#include <cstdio>
#include <cstdint>

#ifndef P3_LRU_A
#define P3_LRU_A 1
#endif
#ifndef P3_GATE_A
#define P3_GATE_A 7
#endif
#ifndef P5DUP
#define P5DUP 0
#endif
#ifndef F8_LAYERS
#define F8_LAYERS 0xC
#endif
#define F8L(l) ((((F8_LAYERS) >> (l)) & 1) != 0)
#ifndef F8UP_LAYERS
#define F8UP_LAYERS 0x8
#endif
#ifndef I8UP_LAYERS
#define I8UP_LAYERS 0xF
#endif
#define I8U(l) ((((I8UP_LAYERS) >> (l)) & 1) != 0)
#define F8U(l) ((((F8UP_LAYERS) & (F8_LAYERS) & ~(I8UP_LAYERS)) >> (l)) & 1)
#ifndef F8OUT_LAYERS
#define F8OUT_LAYERS 0x0
#endif
#define F8O(l) ((((F8OUT_LAYERS) >> (l)) & 1) != 0)
#ifndef MK_ONE_LAUNCH
#define MK_ONE_LAUNCH 1
#endif

#define LAS __attribute__((address_space(3)))
#define GAS __attribute__((address_space(1)))
typedef unsigned short bf16_t;
typedef short bf16x8 __attribute__((ext_vector_type(8)));
typedef short s16x4 __attribute__((ext_vector_type(4)));
typedef float f32x2 __attribute__((ext_vector_type(2)));
typedef float f32x4 __attribute__((ext_vector_type(4)));
typedef float f32x16 __attribute__((ext_vector_type(16)));
typedef unsigned u32x2 __attribute__((ext_vector_type(2)));
typedef unsigned u32x4 __attribute__((ext_vector_type(4)));
typedef GAS unsigned gu32;

constexpr int DM = 4096, BATCH = 2, SEQ = 4096, MT = BATCH * SEQ, DEPTH = 4;
constexpr int NIN = 6720, NINP = 6912, FFH = 11008;
constexpr int C_AQ = 0, C_AK = 1024, C_AV = 2048, C_BG = 3072, C_BX = 4096, C_CQ = 5120, C_CKV = 5888, C_KPE = 6400, C_GLR = 6464;
constexpr float EPS = 1e-6f;
constexpr float LOG2E = 1.4426950408889634f;
constexpr float CA = 0.125f * LOG2E;
constexpr float CM = 0.07216878364870323f * LOG2E;
constexpr int NSTEP = 1 + 12 * DEPTH;

constexpr size_t WS_CTL = 0, CTL_BYTES = 1u << 20;
constexpr size_t WS_COSA = CTL_BYTES;
constexpr size_t WS_SINA = WS_COSA + (size_t)MT * 8 * 4;
constexpr size_t WS_COSC = WS_SINA + (size_t)MT * 8 * 4;
constexpr size_t WS_SINC = WS_COSC + (size_t)MT * 32 * 4;
constexpr size_t WS_SPT  = WS_SINC + (size_t)MT * 32 * 4;
constexpr size_t WS_XS   = WS_SPT  + (size_t)DEPTH * 2048 * 4;
constexpr size_t WS_WSC  = WS_XS   + (size_t)MT * 4;
constexpr size_t WS_XN   = WS_WSC  + 256;
constexpr size_t WS_H    = WS_XN   + (size_t)MT * DM * 2;
constexpr size_t WS_UC   = WS_H    + (size_t)MT * NINP * 2;
constexpr size_t WS_QM   = WS_UC   + (size_t)MT * 1024 * 2;
constexpr size_t WS_KV   = WS_QM   + (size_t)MT * 1536 * 2;
constexpr size_t WS_KM   = WS_KV   + (size_t)MT * 2048 * 2;
constexpr size_t WS_LAB  = WS_KM   + (size_t)MT * 1536 * 2;
constexpr size_t WS_AGP  = WS_LAB  + (size_t)2 * MT * 1024 * 4;
constexpr size_t WS_AGH  = WS_AGP  + (size_t)2 * 2 * 128 * 1024 * 4;
constexpr size_t WS_GATES= WS_AGH  + (size_t)2 * 2 * 128 * 1024 * 4;
constexpr size_t WS_DBUF = WS_GATES+ (size_t)MT * 12288 * 2;
constexpr size_t WS_OCAT = WS_DBUF + (size_t)MT * 1024 * 4;
constexpr size_t WS_TMP  = WS_OCAT + (size_t)MT * 3072 * 2;
constexpr size_t WS_YSUM = WS_TMP  + (size_t)MT * DM * 4;
constexpr size_t WS_HID  = WS_YSUM + (size_t)MT * DM * 2;
constexpr size_t WS_W    = WS_HID  + (size_t)MT * FFH * 2;
constexpr size_t WL_IN = 0;
constexpr size_t WL_UQ = WL_IN + (size_t)NINP * DM * 2;
constexpr size_t WL_UKV= WL_UQ + (size_t)1536 * 768 * 2;
constexpr size_t WL_LRU= WL_UKV+ (size_t)2048 * 512 * 2;
constexpr size_t WL_G  = WL_LRU+ (size_t)4096 * 256 * 2;
constexpr size_t WL_BO = WL_G  + (size_t)12288 * 256 * 2;
constexpr size_t WL_OUT= WL_BO + (size_t)4096 * 3072 * 2;
constexpr size_t WL_GU = WL_OUT+ (size_t)4096 * 4096 * 2;
constexpr size_t WL_DN = WL_GU + (size_t)22016 * 4096 * 2;
constexpr size_t WL_SIZE = WL_DN + (size_t)4096 * FFH * 2;
constexpr size_t WS_END = WS_W + DEPTH * WL_SIZE;
static_assert(WS_XN % 256 == 0 && WS_W % 256 == 0 && WL_SIZE % 256 == 0, "alignment");

constexpr int CW_TMO = 0, CW_BAR = 4096;

constexpr int RING_BYTES = 131072, ATT_BYTES = 141312  , LDSCTL_OFF = ATT_BYTES, MISC_OFF = LDSCTL_OFF + 320, LDS_BYTES = 147456;
constexpr int NWAVES = 8;

__device__ __forceinline__ unsigned f2bf(float f) { unsigned u = __builtin_bit_cast(unsigned, f); return (u + 0x7fffu + ((u >> 16) & 1u)) >> 16; }
__device__ __forceinline__ unsigned pk2(float lo, float hi) { return f2bf(lo) | (f2bf(hi) << 16); }
typedef __bf16 bf16x2_t __attribute__((ext_vector_type(2)));
__device__ __forceinline__ unsigned cvt_pk_bf16(float lo, float hi) { f32x2 v = {lo, hi}; bf16x2_t b = __builtin_convertvector(v, bf16x2_t); return __builtin_bit_cast(unsigned, b); }
__device__ __forceinline__ float bf_lo(unsigned w) { return __builtin_bit_cast(float, w << 16); }
__device__ __forceinline__ float bf_hi(unsigned w) { return __builtin_bit_cast(float, w & 0xffff0000u); }
__device__ __forceinline__ float bf2f(bf16_t b) { return __builtin_bit_cast(float, (unsigned)b << 16); }
__device__ __forceinline__ void unpack8(u32x4 w, float* v) { v[0] = bf_lo(w.x); v[1] = bf_hi(w.x); v[2] = bf_lo(w.y); v[3] = bf_hi(w.y); v[4] = bf_lo(w.z); v[5] = bf_hi(w.z); v[6] = bf_lo(w.w); v[7] = bf_hi(w.w); }
__device__ __forceinline__ u32x4 pack8(const float* v) { u32x4 w; w.x = pk2(v[0], v[1]); w.y = pk2(v[2], v[3]); w.z = pk2(v[4], v[5]); w.w = pk2(v[6], v[7]); return w; }
__device__ __forceinline__ float wave_sum(float v) {
#pragma unroll
    for (int o = 1; o < 64; o <<= 1) v += __shfl_xor(v, o);
    return v;
}
__device__ __forceinline__ float wave_max(float v) {
#pragma unroll
    for (int o = 1; o < 64; o <<= 1) v = fmaxf(v, __shfl_xor(v, o));
    return v;
}
__device__ __forceinline__ float sigmoidf_(float x) { return __builtin_amdgcn_rcpf(1.f + __builtin_amdgcn_exp2f(-1.4426950408889634f * x)); }
__device__ __forceinline__ float gelu_tanh(float x) { const float y = 0.7978845608028654f * (x + 0.044715f * x * x * x); const float t = 1.f - 2.f / (__expf(2.f * y) + 1.f); return 0.5f * x * (1.f + t); }
__device__ __forceinline__ int opq(int x) { asm volatile("" : "+v"(x)); return x; }
__device__ __forceinline__ int opqs(int x) { asm volatile("" : "+s"(x)); return x; }
__device__ __forceinline__ float clamp_f8(float x) { return __builtin_amdgcn_fmed3f(x, -448.f, 448.f); }
__device__ __forceinline__ unsigned pk_fp8x4(float a, float b, float c, float d) { int w = 0; w = __builtin_amdgcn_cvt_pk_fp8_f32(clamp_f8(a), clamp_f8(b), w, false); w = __builtin_amdgcn_cvt_pk_fp8_f32(clamp_f8(c), clamp_f8(d), w, true); return (unsigned)w; }
__device__ __forceinline__ unsigned q8(float x) { return (unsigned)(int)__builtin_amdgcn_fmed3f(__builtin_rintf(x), -127.f, 127.f) & 0xffu; }
__device__ __forceinline__ unsigned pk_i8x4(float a, float b, float c, float d) { return q8(a) | (q8(b) << 8) | (q8(c) << 16) | (q8(d) << 24); }
constexpr float W8_SCALE = 64.f, W8_INV = 1.f / 64.f;
#define LDS_WAIT() asm volatile("s_waitcnt lgkmcnt(0)" ::: "memory")

namespace pg8 {
constexpr int BM = 256, BK = 64, HALF = 128, HTB = HALF * BK * 2, NXCD = 8, WGM = 8;
__host__ __device__ __forceinline__ int lds_byte(int r, int c) { const int st = (r >> 4) * 2 + (c >> 5), rr = r & 15, cc = c & 31, ob = rr * 64 + cc * 2; return st * 1024 + (ob ^ (((ob >> 9) & 1) << 5)); }
__host__ __device__ __forceinline__ void stage_rc(int b, int& R, int& C) { const int st = b / 1024, sb = b % 1024, swz = sb ^ (((sb >> 9) & 1) << 5); R = (st >> 1) * 16 + swz / 64; C = (st & 1) * 32 + (swz % 64) / 2; }
__host__ __device__ __forceinline__ int perm32(int rho) { const int n = rho >> 4, i = rho & 15; return 8 * (i >> 2) + 4 * n + (i & 3); }

struct Unit { int pm, pn, ka, kb, aux; };
struct Gemm { const bf16_t* A; const bf16_t* Bt; int lda, ldb, K; };

struct TileOrder {
    int nM, nN, nwg;
    __device__ __forceinline__ void init(int nM_, int nN_) { nM = nM_; nN = nN_; nwg = nM * nN; }
    __device__ __forceinline__ void tile(int L, int& pm, int& pn) const {
        int wgid = L; { const int q = nwg / NXCD, r = nwg % NXCD, xcd = wgid % NXCD, off = wgid / NXCD; wgid = (xcd < r ? xcd * (q + 1) : r * (q + 1) + (xcd - r) * q) + off; }
        const int nig = WGM * nN, gid = wgid / nig, fm = gid * WGM, gsz = (nM - fm) < WGM ? (nM - fm) : WGM;
        pm = fm + ((wgid % nig) % gsz); pn = (wgid % nig) / gsz;
    }
};
struct SchedPlain {
    TileOrder T; int G, c, sk0, skn;
    __device__ __forceinline__ void init(int nM, int nN, int G_, int c_, int sk0_ = 1 << 30, int skn_ = 0) { T.init(nM, nN); G = G_; c = c_; sk0 = sk0_; skn = skn_; }
    __device__ __forceinline__ bool next(int i, Unit& u) const { if (c < 0) return false; const long L = (long)i * G + c; if (L >= T.nwg) return false; T.tile((int)L, u.pm, u.pn); if (u.pn >= sk0) u.pn += skn; u.ka = 0; u.kb = 0; u.aux = 0; return true; }
};
struct SchedSplit {
    TileOrder T; int GA, GB, c, n0, lru;
    __device__ __forceinline__ void init(int nM, int nN, int GA_, int GB_, int c_, int n0_, int lru_ = 0) { T.init(nM, nN); GA = GA_; GB = GB_; c = c_; n0 = n0_; lru = lru_; }
    __device__ __forceinline__ bool next(int i, Unit& u) const { const bool a = c < GA; const long L = a ? (long)i * GA + c : (long)n0 + (long)i * GB + (c - GA); if (L >= (a ? n0 : T.nwg)) return false;
        T.tile((int)L, u.pm, u.pn); u.ka = lru ? 256 * (u.pn >> 2) : 0; u.kb = 0; u.aux = 0; return true; }
};
struct SchedLru {
    TileOrder T; int G, c;
    __device__ __forceinline__ void init(int nM, int nN, int G_, int c_) { T.init(nM, nN); G = G_; c = c_; }
    __device__ __forceinline__ bool next(int i, Unit& u) const { if (c < 0) return false; const long L = (long)i * G + c; if (L >= T.nwg) return false; T.tile((int)L, u.pm, u.pn); u.ka = 256 * (u.pn >> 2); u.kb = 0; u.aux = 0; return true; }
};
struct SchedBo {
    TileOrder T; int G, c;
    __device__ __forceinline__ void init(int nM, int nN, int G_, int c_) { T.init(nM, nN); G = G_; c = c_; }
    __device__ __forceinline__ bool next(int i, Unit& u) const { const int it = i / 3, n = i - 3 * it; const long L = (long)it * G + c; if (L >= T.nwg) return false; T.tile((int)L, u.pm, u.pn); u.ka = 1024 * n; u.kb = 1024 * n; u.aux = n; return true; }
};

typedef f32x4 Acc[2][2][4][2];

struct EpiBf16 {
    bf16_t* O; int ldc;
    static __device__ __forceinline__ bool keep(const Unit&) { return false; }
    __device__ __forceinline__ void operator()(const Acc& acc, const Unit& u, int wr, int wc, int fr_, int fq_) const {
        const int fr = opq(fr_), fq = opq(fq_);
        const int row0 = u.pm * BM + wr * 64 + fr, col0 = u.pn * BM + wc * 32 + 8 * fq;
#pragma unroll
        for (int ai = 0; ai < 2; ++ai)
#pragma unroll
            for (int m = 0; m < 4; ++m) { bf16_t* rowp = O + (size_t)(row0 + ai * HALF + m * 16) * ldc + col0;
#pragma unroll
                for (int bj = 0; bj < 2; ++bj) { const f32x4 v0 = acc[ai][bj][m][0], v1 = acc[ai][bj][m][1];
                    u32x4 w; w.x = cvt_pk_bf16(v0[0], v0[1]); w.y = cvt_pk_bf16(v0[2], v0[3]); w.z = cvt_pk_bf16(v1[0], v1[1]); w.w = cvt_pk_bf16(v1[2], v1[3]);
                    *(u32x4*)(rowp + bj * HALF) = w; } }
    }
};
struct EpiSig {
    bf16_t* O; int ldc; const float* bias;
    static __device__ __forceinline__ bool keep(const Unit&) { return false; }
    __device__ __forceinline__ void operator()(const Acc& acc, const Unit& u, int wr, int wc, int fr_, int fq_) const {
        const int fr = opq(fr_), fq = opq(fq_);
        const int row0 = u.pm * BM + wr * 64 + fr, col0 = u.pn * BM + wc * 32 + 8 * fq;
#pragma unroll
        for (int bj = 0; bj < 2; ++bj) {
            const f32x4 bv0 = *(const f32x4*)(bias + col0 + bj * HALF), bv1 = *(const f32x4*)(bias + col0 + bj * HALF + 4);
#pragma unroll
            for (int ai = 0; ai < 2; ++ai)
#pragma unroll
                for (int m = 0; m < 4; ++m) { bf16_t* rowp = O + (size_t)(row0 + ai * HALF + m * 16) * ldc + col0 + bj * HALF;
                    f32x4 v0 = acc[ai][bj][m][0] + bv0, v1 = acc[ai][bj][m][1] + bv1;
#pragma unroll
                    for (int i = 0; i < 4; ++i) { v0[i] = sigmoidf_(v0[i]); v1[i] = sigmoidf_(v1[i]); }
                    u32x4 w; w.x = cvt_pk_bf16(v0[0], v0[1]); w.y = cvt_pk_bf16(v0[2], v0[3]); w.z = cvt_pk_bf16(v1[0], v1[1]); w.w = cvt_pk_bf16(v1[2], v1[3]);
                    *(u32x4*)rowp = w; __builtin_amdgcn_sched_barrier(0); } }
    }
};
struct EpiRes {
    const float* Xin; float* Out; float sc;
    static __device__ __forceinline__ bool keep(const Unit&) { return false; }
    __device__ __forceinline__ void operator()(const Acc& acc, const Unit& u, int wr, int wc, int fr_, int fq_) const {
        const int fr = opq(fr_), fq = opq(fq_);
        const int row0 = u.pm * BM + wr * 64 + fr, col0 = u.pn * BM + wc * 32 + 8 * fq;
#pragma unroll
        for (int ai = 0; ai < 2; ++ai)
#pragma unroll
            for (int m = 0; m < 4; ++m) { const size_t off = (size_t)(row0 + ai * HALF + m * 16) * DM + col0;
#pragma unroll
                for (int bj = 0; bj < 2; ++bj) {
                    const f32x4 x0 = *(const f32x4*)(Xin + off + bj * HALF), x1 = *(const f32x4*)(Xin + off + bj * HALF + 4);
                    *(f32x4*)(Out + off + bj * HALF) = x0 + acc[ai][bj][m][0] * sc; *(f32x4*)(Out + off + bj * HALF + 4) = x1 + acc[ai][bj][m][1] * sc; } }
    }
};
template <bool F8OUT> struct EpiSwiglu {
    void* Ov; float sc;
    static __device__ __forceinline__ bool keep(const Unit&) { return false; }
    __device__ __forceinline__ void operator()(const Acc& acc, const Unit& u, int wr, int wc, int fr_, int fq_) const {
        const int fr = opq(fr_), fq = opq(fq_);
        const int row0 = u.pm * BM + wr * 64 + fr, col0 = u.pn * HALF + wc * 32 + 8 * fq;
#pragma unroll
        for (int ai = 0; ai < 2; ++ai)
#pragma unroll
            for (int m = 0; m < 4; ++m) { const size_t eo = (size_t)(row0 + ai * HALF + m * 16) * FFH + col0;
                f32x4 r0, r1;
#pragma unroll
                for (int i = 0; i < 4; ++i) { const float g0 = acc[ai][0][m][0][i] * sc, g1 = acc[ai][0][m][1][i] * sc;
                    r0[i] = g0 * sigmoidf_(g0) * (acc[ai][1][m][0][i] * sc); r1[i] = g1 * sigmoidf_(g1) * (acc[ai][1][m][1][i] * sc); }
                if constexpr (F8OUT) { u32x2 w; w.x = pk_fp8x4(r0[0], r0[1], r0[2], r0[3]); w.y = pk_fp8x4(r1[0], r1[1], r1[2], r1[3]); *(u32x2*)((unsigned char*)Ov + eo) = w; }
                else { u32x4 w; w.x = cvt_pk_bf16(r0[0], r0[1]); w.y = cvt_pk_bf16(r0[2], r0[3]); w.z = cvt_pk_bf16(r1[0], r1[1]); w.w = cvt_pk_bf16(r1[2], r1[3]); *(u32x4*)((bf16_t*)Ov + eo) = w; } }
    }
};
__device__ __forceinline__ float i2f_acc(float bits) { return (float)__builtin_bit_cast(int, bits); }
struct EpiSwigluI8 {
    void* Ov; const float* xs; const float* wsc; int f8out;
    static __device__ __forceinline__ bool keep(const Unit&) { return false; }
    __device__ __forceinline__ void operator()(const Acc& acc, const Unit& u, int wr, int wc, int fr_, int fq_) const {
        const int fr = opq(fr_), fq = opq(fq_);
        const int row0 = u.pm * BM + wr * 64 + fr, col0 = u.pn * HALF + wc * 32 + 8 * fq;
        const float sg = wsc[0], su = wsc[1];
        float rsv[2][4];
#pragma unroll
        for (int ai = 0; ai < 2; ++ai)
#pragma unroll
            for (int m = 0; m < 4; ++m) rsv[ai][m] = xs[row0 + ai * HALF + m * 16];
#pragma unroll
        for (int ai = 0; ai < 2; ++ai)
#pragma unroll
            for (int m = 0; m < 4; ++m) { const int row = row0 + ai * HALF + m * 16; const size_t eo = (size_t)row * FFH + col0; const float rsA = rsv[ai][m], cg = rsA * sg, cu = rsA * su;
                f32x4 r0, r1;
#pragma unroll
                for (int i = 0; i < 4; ++i) { const float g0 = i2f_acc(acc[ai][0][m][0][i]) * cg, g1 = i2f_acc(acc[ai][0][m][1][i]) * cg;
                    r0[i] = g0 * sigmoidf_(g0) * (i2f_acc(acc[ai][1][m][0][i]) * cu); r1[i] = g1 * sigmoidf_(g1) * (i2f_acc(acc[ai][1][m][1][i]) * cu); }
                if (f8out) { u32x2 w; w.x = pk_fp8x4(r0[0], r0[1], r0[2], r0[3]); w.y = pk_fp8x4(r1[0], r1[1], r1[2], r1[3]); *(u32x2*)((unsigned char*)Ov + eo) = w; }
                else { u32x4 w; w.x = cvt_pk_bf16(r0[0], r0[1]); w.y = cvt_pk_bf16(r0[2], r0[3]); w.z = cvt_pk_bf16(r1[0], r1[1]); w.w = cvt_pk_bf16(r1[2], r1[3]); *(u32x4*)((bf16_t*)Ov + eo) = w; } }
    }
};
struct EpiBo {
    const bf16_t* gates; bf16_t* ysum; int f8;
    static __device__ __forceinline__ bool keep(const Unit& u) { return u.aux < 2; }
    __device__ __forceinline__ void operator()(Acc& acc, const Unit& u, int wr, int wc, int fr_, int fq_) const {
        const int fr = opq(fr_), fq = opq(fq_);
        const int row0 = u.pm * BM + wr * 64 + fr, col0 = u.pn * BM + wc * 32 + 8 * fq, n = u.aux;
#pragma unroll
        for (int ai = 0; ai < 2; ++ai)
#pragma unroll
            for (int m = 0; m < 4; ++m) { const size_t row = (size_t)(row0 + ai * HALF + m * 16);
#pragma unroll
                for (int bj = 0; bj < 2; ++bj) { const int col = col0 + bj * HALF;
                    const bf16_t* gp = gates + row * 12288 + (size_t)n * 4096 + col;
                    float gn[8]; unpack8(*(const u32x4*)gp, gn);
#pragma unroll
                    for (int i = 0; i < 8; ++i) gn[i] = fmaxf(gn[i], 1e-18f);
                    if (n < 2) { float gd[8]; unpack8(*(const u32x4*)(gp + 4096), gd);
#pragma unroll
                        for (int i = 0; i < 8; ++i) gn[i] *= __builtin_amdgcn_rcpf(fmaxf(gd[i], 1e-18f)); }
                    f32x4 v0 = acc[ai][bj][m][0], v1 = acc[ai][bj][m][1];
#pragma unroll
                    for (int i = 0; i < 4; ++i) { v0[i] *= gn[i]; v1[i] *= gn[4 + i]; }
                    if (n < 2) { acc[ai][bj][m][0] = v0; acc[ai][bj][m][1] = v1; }
                    else { u32x4 w; w.x = cvt_pk_bf16(v0[0], v0[1]); w.y = cvt_pk_bf16(v0[2], v0[3]); w.z = cvt_pk_bf16(v1[0], v1[1]); w.w = cvt_pk_bf16(v1[2], v1[3]);
                        if (f8) { u32x2 w8; w8.x = pk_fp8x4(v0[0], v0[1], v0[2], v0[3]); w8.y = pk_fp8x4(v1[0], v1[1], v1[2], v1[3]); *(u32x2*)((unsigned char*)ysum + row * DM + col) = w8; }
                        else *(u32x4*)(ysum + row * DM + col) = w; } } }
    }
};
struct EpiLru {
    const bf16_t* uc; const float* gb; const float* Lp; unsigned* LAB;
    static __device__ __forceinline__ bool keep(const Unit&) { return false; }
    __device__ __forceinline__ void operator()(const Acc& acc, const Unit& u, int wr, int wc, int fr_, int fq_) const {
        const int fr = opq(fr_), fq = opq(fq_);
        const int row0 = u.pm * BM + wr * 64 + fr;
        const int z = u.pn & 1, nb = u.pn >> 1, ch0 = 128 * nb + 32 * wc + 8 * fq;
#pragma unroll
        for (int n = 0; n < 2; ++n) { const int ch = ch0 + 4 * n;
            const f32x4 br = *(const f32x4*)(gb + (z * 2 + 0) * 1024 + ch), bi = *(const f32x4*)(gb + (z * 2 + 1) * 1024 + ch);
            const f32x4 sp = *(const f32x4*)(Lp + z * 1024 + ch);
            __builtin_amdgcn_sched_barrier(0);
#pragma unroll
            for (int ai = 0; ai < 2; ++ai)
#pragma unroll
                for (int m = 0; m < 4; ++m) { const size_t row = (size_t)(row0 + ai * HALF + m * 16);
                    const u32x2 uw = *(const u32x2*)(uc + row * 1024 + ch);
                    const float uv[4] = {bf_lo(uw.x), bf_hi(uw.x), bf_lo(uw.y), bf_hi(uw.y)};
                    u32x4 w;
#pragma unroll
                    for (int i = 0; i < 4; ++i) { const float r = sigmoidf_(acc[ai][0][m][n][i] + br[i]), ig = sigmoidf_(acc[ai][1][m][n][i] + bi[i]);
                        const float la = r * sp[i], av = __builtin_amdgcn_exp2f(1.4426950408889634f * la);
                        const float t = -la;
                        const float ser = t * (1.f - t * 0.5f * (1.f - t * (1.f / 3.f) * (1.f - t * 0.25f * (1.f - t * 0.2f * (1.f - t * (1.f / 6.f) * (1.f - t * (1.f / 7.f)))))));
                        const float oma = (t < 0.25f) ? ser : (1.f - av);
                        const float bx = __builtin_amdgcn_sqrtf(oma * (1.f + av)) * ig * uv[i];
                        w[i] = cvt_pk_bf16(oma, bx); }
                    *(u32x4*)(LAB + ((size_t)z * MT + row) * 1024 + ch) = w; __builtin_amdgcn_sched_barrier(0); } }
    }
};

typedef int i32x8 __attribute__((ext_vector_type(8)));
typedef int i32x4_ __attribute__((ext_vector_type(4)));
template <class Epi, class Sched, int MODE = 0>
__device__ __forceinline__ void gemm_phase(LAS unsigned char* lds, const Gemm g, const Sched& S, const Epi& E) {
    constexpr bool F8 = (MODE == 1), I8 = (MODE == 2);
    const int tid = opq(threadIdx.x), wid = __builtin_amdgcn_readfirstlane(tid >> 6), lane = tid & 63, wr = wid >> 2, wc = wid & 3, fr = lane & 15, fq = lane >> 4;
    constexpr int EB = (MODE == 0) ? 2 : 1;
    const int K = g.K, nt = K * EB / (BK * 2);
    unsigned voffA[2], voffB[2];
#pragma unroll
    for (int i = 0; i < 2; ++i) { int R, C; stage_rc(tid * 16 + i * 8192, R, C); const int Rb = (R & ~31) + perm32(R & 31);
        voffA[i] = (unsigned)(R * g.lda * EB + C * 2); voffB[i] = (unsigned)(Rb * g.ldb * EB + C * 2); }
    const size_t kstep = (size_t)(BK * 2);
    const size_t hstepA = (size_t)HALF * g.lda * EB, hstepB = (size_t)HALF * g.ldb * EB;
    const unsigned ldsw = (unsigned)wid * 1024u;
    const int aoff = lds_byte(wr * 64 + fr, fq * 8), boff = lds_byte(wc * 32 + fr, fq * 8);
#define PG8_SA(b, h) (((b) * 2 + (h)) * HTB)
#define PG8_SB(b, h) ((4 + (b) * 2 + (h)) * HTB)
#define PG8_STAGE(bufoff, gbase, voff) do { _Pragma("unroll") for (int _i = 0; _i < 2; ++_i) \
        __builtin_amdgcn_global_load_lds((const unsigned*)((const char*)(gbase) + (voff)[_i]), (LAS unsigned*)(lds + (bufoff) + ldsw + _i * 8192), 16, 0, 0); } while (0)
#define PG8_LDA(dst, b, h) do { if constexpr (F8) { _Pragma("unroll") for (int m = 0; m < 4; ++m) { dst##8[m].lo = *(const LAS i32x4_*)(lds + PG8_SA(b, h) + aoff + m * 2048); dst##8[m].hi = *(const LAS i32x4_*)(lds + PG8_SA(b, h) + aoff + m * 2048 + 1024); } } \
    else { _Pragma("unroll") for (int m = 0; m < 4; ++m) _Pragma("unroll") for (int k = 0; k < 2; ++k) dst[m][k] = *(const LAS bf16x8*)(lds + PG8_SA(b, h) + aoff + m * 2048 + k * 1024); } } while (0)
#define PG8_LDB(dst, b, h) do { if constexpr (F8) { _Pragma("unroll") for (int n = 0; n < 2; ++n) { dst##8[n].lo = *(const LAS i32x4_*)(lds + PG8_SB(b, h) + boff + n * 2048); dst##8[n].hi = *(const LAS i32x4_*)(lds + PG8_SB(b, h) + boff + n * 2048 + 1024); } } \
    else { _Pragma("unroll") for (int n = 0; n < 2; ++n) _Pragma("unroll") for (int k = 0; k < 2; ++k) dst[n][k] = *(const LAS bf16x8*)(lds + PG8_SB(b, h) + boff + n * 2048 + k * 1024); } } while (0)
#define PG8_MMA(ai, bj, At, Bt) do { __builtin_amdgcn_s_setprio(1); \
        if constexpr (F8) { _Pragma("unroll") for (int m = 0; m < 4; ++m) _Pragma("unroll") for (int n = 0; n < 2; ++n) \
            asm volatile("v_mfma_f32_16x16x128_f8f6f4 %0, %1, %2, %0" : "+v"(acc[ai][bj][m][n]) : "v"(Bt##8[n]), "v"(At##8[m])); } \
        else if constexpr (I8) { _Pragma("unroll") for (int m = 0; m < 4; ++m) _Pragma("unroll") for (int n = 0; n < 2; ++n) _Pragma("unroll") for (int k = 0; k < 2; ++k) \
            acc[ai][bj][m][n] = __builtin_bit_cast(f32x4, __builtin_amdgcn_mfma_i32_16x16x64_i8(__builtin_bit_cast(i32x4_, Bt[n][k]), __builtin_bit_cast(i32x4_, At[m][k]), __builtin_bit_cast(i32x4_, acc[ai][bj][m][n]), 0, 0, 0)); } \
        else { _Pragma("unroll") for (int m = 0; m < 4; ++m) _Pragma("unroll") for (int n = 0; n < 2; ++n) _Pragma("unroll") for (int k = 0; k < 2; ++k) \
            acc[ai][bj][m][n] = __builtin_amdgcn_mfma_f32_16x16x32_bf16(Bt[n][k], At[m][k], acc[ai][bj][m][n], 0, 0, 0); } \
        __builtin_amdgcn_s_setprio(0); } while (0)
#define PG8_WAIT_V(n) asm volatile("s_waitcnt vmcnt(" #n ")" ::: "memory")
#define PG8_WAIT_L(n) asm volatile("s_waitcnt lgkmcnt(" #n ")" ::: "memory")
#define PG8_BAR __builtin_amdgcn_s_barrier()
#define PG8_SCHED __builtin_amdgcn_sched_barrier(0)
#define PG8_UA(u) ((const char*)g.A + (size_t)(u).pm * 2 * hstepA + (size_t)(u).ka * EB)
#define PG8_UB(u) ((const char*)g.Bt + (size_t)(u).pn * 2 * hstepB + (size_t)(u).kb * EB)
    Unit cur, nxt; int ui = 0;
    if (!S.next(0, cur)) return;
    Acc acc;
#pragma unroll
    for (int a = 0; a < 2; ++a)
#pragma unroll
        for (int b = 0; b < 2; ++b)
#pragma unroll
            for (int m = 0; m < 4; ++m)
#pragma unroll
                for (int n = 0; n < 2; ++n) acc[a][b][m][n] = (f32x4){0.f, 0.f, 0.f, 0.f};
    bf16x8 At[4][2], B0[2][2], B1[2][2];
    i32x8 At8[4], B08[2], B18[2];
    const char* cA = PG8_UA(cur); const char* cB = PG8_UB(cur);
    PG8_STAGE(PG8_SB(0, 0), cB, voffB); PG8_STAGE(PG8_SB(0, 1), cB + hstepB, voffB); PG8_STAGE(PG8_SA(0, 0), cA, voffA); PG8_STAGE(PG8_SA(0, 1), cA + hstepA, voffA);
    if (wr == 1) PG8_BAR;
    PG8_WAIT_V(2); PG8_BAR;
    PG8_STAGE(PG8_SB(1, 0), cB + kstep, voffB); PG8_STAGE(PG8_SA(1, 0), cA + kstep, voffA); PG8_STAGE(PG8_SB(1, 1), cB + hstepB + kstep, voffB);
    PG8_WAIT_V(6); PG8_BAR;
    for (;;) {
        const bool has_next = S.next(ui + 1, nxt);
        const char* nA = has_next ? PG8_UA(nxt) : cA; const char* nB = has_next ? PG8_UB(nxt) : cB;
#pragma nounroll
        for (int t = 0; t < nt; t += 2) {
            const bool last = (t == nt - 2);
            const char* a1 = cA + (size_t)(t + 1) * kstep;
            const char* a2 = last ? nA : cA + (size_t)(t + 2) * kstep; const char* b2 = last ? nB : cB + (size_t)(t + 2) * kstep;
            const char* a3 = a2 + kstep; const char* b3 = b2 + kstep;
            PG8_LDB(B0, 0, 0); PG8_LDB(B1, 0, 1); PG8_SCHED; PG8_LDA(At, 0, 0); PG8_STAGE(PG8_SA(1, 1), a1 + hstepA, voffA);
            PG8_WAIT_V(8); PG8_WAIT_L(0); PG8_BAR; PG8_MMA(0, 0, At, B0); PG8_MMA(0, 1, At, B1); PG8_BAR; PG8_SCHED;
            PG8_LDA(At, 0, 1); PG8_STAGE(PG8_SB(0, 0), b2, voffB); PG8_STAGE(PG8_SB(0, 1), b2 + hstepB, voffB); PG8_STAGE(PG8_SA(0, 0), a2, voffA);
            PG8_WAIT_V(8); PG8_WAIT_L(0); PG8_BAR; PG8_MMA(1, 0, At, B0); PG8_MMA(1, 1, At, B1); PG8_BAR; PG8_SCHED;
            PG8_LDB(B0, 1, 0); PG8_LDB(B1, 1, 1); PG8_SCHED; PG8_LDA(At, 1, 0); PG8_STAGE(PG8_SA(0, 1), a2 + hstepA, voffA);
            PG8_WAIT_V(8); PG8_WAIT_L(0); PG8_BAR; PG8_MMA(0, 0, At, B0); PG8_MMA(0, 1, At, B1); PG8_BAR; PG8_SCHED;
            PG8_LDA(At, 1, 1); PG8_STAGE(PG8_SB(1, 0), b3, voffB); PG8_STAGE(PG8_SB(1, 1), b3 + hstepB, voffB); PG8_STAGE(PG8_SA(1, 0), a3, voffA);
            PG8_WAIT_V(8); PG8_WAIT_L(0); PG8_BAR; PG8_MMA(1, 0, At, B0); PG8_MMA(1, 1, At, B1); PG8_BAR; PG8_SCHED;
        }
        if (wr == 0) PG8_BAR;
        if constexpr (F8) asm volatile("s_nop 15\n\ts_nop 15" ::: "memory");
        E(acc, cur, wr, wc, fr, fq);
        if (!has_next) break;
        if (!Epi::keep(cur)) {
#pragma unroll
        for (int a = 0; a < 2; ++a)
#pragma unroll
            for (int b = 0; b < 2; ++b)
#pragma unroll
                for (int m = 0; m < 4; ++m)
#pragma unroll
                    for (int n = 0; n < 2; ++n) acc[a][b][m][n] = (f32x4){0.f, 0.f, 0.f, 0.f};
        }
        cur = nxt; cA = nA; cB = nB; ++ui;
        if (wr == 1) PG8_BAR;
    }
    PG8_WAIT_V(0);
    PG8_BAR;
#undef PG8_SA
#undef PG8_SB
#undef PG8_STAGE
#undef PG8_LDA
#undef PG8_LDB
#undef PG8_MMA
#undef PG8_WAIT_V
#undef PG8_WAIT_L
#undef PG8_BAR
#undef PG8_SCHED
#undef PG8_UA
#undef PG8_UB
}
}

namespace att {
constexpr int SHM_V = 64 * 128 * 2, OFF_K = 2 * SHM_V, OFF_WS = OFF_K + 2 * 3 * 8192, LDS_ATT = OFF_WS + NWAVES * 64 * 4;
static_assert(LDS_ATT <= RING_BYTES, "attention LDS");
__device__ __forceinline__ int crow(int r, int hi) { return (r & 3) + 8 * (r >> 2) + 4 * hi; }
__device__ __forceinline__ int v_st(int k, int c) { const int kk = (k & ~0xC) | ((k & 4) << 1) | ((k & 8) >> 1); return ((kk >> 3) * 4 + (c >> 5)) * 512 + ((kk & 7) * 32 + (c & 31)) * 2; }
__device__ __forceinline__ int v_rd_base(int lane) { return ((lane & 3) << 3) | (((lane >> 2) & 3) << 6) | (((lane >> 4) & 1) << 5) | (((lane >> 5) & 1) << 8); }
constexpr int v_rd_off(int d0, int ks, int half) { return d0 * 512 + ks * 4096 + half * 2048; }
template <int OFF> __device__ __forceinline__ s16x4 tr_read(int vb) { s16x4 r; asm volatile("ds_read_b64_tr_b16 %0, %1 offset:%2" : "=&v"(r) : "v"(vb), "i"(OFF) : "memory"); return r; }
#define ATT_SBAR() __builtin_amdgcn_sched_barrier(0)
#define ATT_SYNC() do { asm volatile("s_waitcnt lgkmcnt(0)" ::: "memory"); __builtin_amdgcn_s_barrier(); asm volatile("" ::: "memory"); } while (0)
struct VFrag { s16x4 l0, h0, l1, h1, l2, h2, l3, h3; };
template <int D0> __device__ __forceinline__ void v_reads(VFrag& f, int vb) {
    f.l0 = tr_read<v_rd_off(D0, 0, 0)>(vb); f.h0 = tr_read<v_rd_off(D0, 0, 1)>(vb); f.l1 = tr_read<v_rd_off(D0, 1, 0)>(vb); f.h1 = tr_read<v_rd_off(D0, 1, 1)>(vb);
    f.l2 = tr_read<v_rd_off(D0, 2, 0)>(vb); f.h2 = tr_read<v_rd_off(D0, 2, 1)>(vb); f.l3 = tr_read<v_rd_off(D0, 3, 0)>(vb); f.h3 = tr_read<v_rd_off(D0, 3, 1)>(vb);
}
__device__ __forceinline__ void pv_mma(f32x16& od, const VFrag& f, bf16x8 pa0, bf16x8 pa1, bf16x8 pa2, bf16x8 pa3) {
#define ATT_PK(L, H) (bf16x8){L[0], L[1], L[2], L[3], H[0], H[1], H[2], H[3]}
    od = __builtin_amdgcn_mfma_f32_32x32x16_bf16(pa0, ATT_PK(f.l0, f.h0), od, 0, 0, 0);
    od = __builtin_amdgcn_mfma_f32_32x32x16_bf16(pa1, ATT_PK(f.l1, f.h1), od, 0, 0, 0);
    od = __builtin_amdgcn_mfma_f32_32x32x16_bf16(pa2, ATT_PK(f.l2, f.h2), od, 0, 0, 0);
    od = __builtin_amdgcn_mfma_f32_32x32x16_bf16(pa3, ATT_PK(f.l3, f.h3), od, 0, 0, 0);
#undef ATT_PK
}
#define ATT_LWAIT(n) do { asm volatile("s_waitcnt lgkmcnt(" #n ")" ::: "memory"); ATT_SBAR(); } while (0)
__device__ __forceinline__ void pv_d0(f32x16* o, int vb, bf16x8 pa0, bf16x8 pa1, bf16x8 pa2, bf16x8 pa3) {
    VFrag fa, fb;
    v_reads<0>(fa, vb); v_reads<1>(fb, vb);
    ATT_LWAIT(8); pv_mma(o[0], fa, pa0, pa1, pa2, pa3); ATT_SBAR();
    v_reads<2>(fa, vb);
    ATT_LWAIT(8); pv_mma(o[1], fb, pa0, pa1, pa2, pa3); ATT_SBAR();
    v_reads<3>(fb, vb);
    ATT_LWAIT(8); pv_mma(o[2], fa, pa0, pa1, pa2, pa3); ATT_SBAR();
    ATT_LWAIT(0); pv_mma(o[3], fb, pa0, pa1, pa2, pa3);
}
__device__ __forceinline__ void exp16(f32x16& p) {
#pragma unroll
    for (int r = 0; r < 16; ++r) p[r] = __builtin_amdgcn_exp2f(p[r]);
}
__device__ __forceinline__ void finishSM(f32x16& p0, f32x16& p1, float& l_reg, bf16x8& pa0, bf16x8& pa1, bf16x8& pa2, bf16x8& pa3) {
    float ps = 0.f;
#pragma unroll
    for (int r = 0; r < 16; ++r) ps += p0[r];
#pragma unroll
    for (int r = 0; r < 16; ++r) ps += p1[r];
    l_reg += ps;
#define ATT_PK4(P, BASE, OUT) do { unsigned a0 = cvt_pk_bf16(P[BASE + 0], P[BASE + 1]), a1 = cvt_pk_bf16(P[BASE + 2], P[BASE + 3]);   \
    unsigned b0 = cvt_pk_bf16(P[BASE + 4], P[BASE + 5]), b1 = cvt_pk_bf16(P[BASE + 6], P[BASE + 7]);                              \
    auto r0 = __builtin_amdgcn_permlane32_swap(a0, b0, false, false); auto r1 = __builtin_amdgcn_permlane32_swap(a1, b1, false, false); \
    u32x4 w = {r0[0], r1[0], r0[1], r1[1]}; OUT = __builtin_bit_cast(bf16x8, w); } while (0)
    ATT_PK4(p0, 0, pa0); ATT_PK4(p0, 8, pa1); ATT_PK4(p1, 0, pa2); ATT_PK4(p1, 8, pa3);
#undef ATT_PK4
}
template <int NS, int SD>
__device__ __forceinline__ void attn_body(const bf16_t* __restrict__ Qb, int ldq, const bf16_t* __restrict__ Kh, int ldk, const bf16_t* __restrict__ Vh, int ldv,
                                          float negoff, LAS char* lds, f32x16 (&o)[4]) {
    constexpr int NQK = 4 * NS, KB = NS * 8192, NT = SEQ / 64;
    const int tid = opq(threadIdx.x), wid = tid >> 6, lane = tid & 63, r32 = lane & 31, hi = lane >> 5;
    LAS char* V_lds = lds; LAS char* K_lds = lds + OFF_K;
    LAS float* li_l = (LAS float*)(lds + OFF_WS) + wid * 64;
    float l_reg = 0.f;
#pragma unroll
    for (int d = 0; d < 4; ++d)
#pragma unroll
        for (int r = 0; r < 16; ++r) o[d][r] = 0.f;
    bf16x8 qr[NQK];
    { const bf16_t* Qw = Qb + (size_t)(wid * 32 + r32) * ldq + hi * 8;
#pragma unroll
      for (int d0 = 0; d0 < NQK; ++d0) qr[d0] = *(const bf16x8*)(Qw + d0 * 16); }
    const int vb0 = (int)(unsigned)(uintptr_t)V_lds + v_rd_base(lane);
    const int kxb = hi ^ ((r32 >> 1) & 7), krow = r32 * 128;
    struct Slot { bf16x8 vs0, vs1, ks[NS]; } sl[SD];
#define ATT_SLOAD(i, k0) do { const int t_ = opq(tid), vr = t_ >> 4, vc = (t_ & 15) * 8, kr = t_ >> 3, kc = t_ & 7; \
    const unsigned vof0 = (unsigned)(vr * ldv + vc) * 2u, vof1 = (unsigned)((32 + vr) * ldv + vc) * 2u, kof = (unsigned)(kr * ldk + kc * 8) * 2u; \
    const char* vt_ = (const char*)Vh + (size_t)(k0) * ldv * 2; const char* kt_ = (const char*)Kh + (size_t)(k0) * ldk * 2; \
    sl[i].vs0 = *(const bf16x8*)(vt_ + vof0); sl[i].vs1 = *(const bf16x8*)(vt_ + vof1); \
    _Pragma("unroll") for (int s_ = 0; s_ < NS; ++s_) sl[i].ks[s_] = *(const bf16x8*)(kt_ + kof + s_ * 128); } while (0)
#define ATT_SWRITE(b, i) do { const int t_ = opq(tid), vr = t_ >> 4, vc = (t_ & 15) * 8, vst0 = v_st(vr, vc), vst1 = v_st(32 + vr, vc), kr = t_ >> 3, kc = t_ & 7, kst = kr * 128 + ((kc ^ ((kr >> 1) & 7)) << 4); \
    *(LAS bf16x8*)(V_lds + (b) * SHM_V + vst0) = sl[i].vs0; *(LAS bf16x8*)(V_lds + (b) * SHM_V + vst1) = sl[i].vs1; \
    _Pragma("unroll") for (int s_ = 0; s_ < NS; ++s_) *(LAS bf16x8*)(K_lds + (b) * KB + s_ * 8192 + kst) = sl[i].ks[s_]; } while (0)
#define ATT_TILE(b) do { f32x16 p0_, p1_; bf16x8 pa0, pa1, pa2, pa3; \
    _Pragma("unroll") for (int r_ = 0; r_ < 16; ++r_) { p0_[r_] = 0.f; p1_[r_] = 0.f; } \
    _Pragma("unroll") for (int d0 = 0; d0 < NQK; ++d0) { const LAS char* kp_ = K_lds + (b) * KB + (d0 >> 2) * 8192 + krow + ((((d0 & 3) * 2) ^ kxb) << 4); \
        const bf16x8 b0_ = *(const LAS bf16x8*)kp_; const bf16x8 b1_ = *(const LAS bf16x8*)(kp_ + 4096); \
        p0_ = __builtin_amdgcn_mfma_f32_32x32x16_bf16(b0_, qr[d0], p0_, 0, 0, 0); p1_ = __builtin_amdgcn_mfma_f32_32x32x16_bf16(b1_, qr[d0], p1_, 0, 0, 0); } \
    _Pragma("unroll") for (int r_ = 0; r_ < 16; ++r_) { p0_[r_] = __builtin_amdgcn_exp2f(p0_[r_] + negoff); p1_[r_] = __builtin_amdgcn_exp2f(p1_[r_] + negoff); } \
    finishSM(p0_, p1_, l_reg, pa0, pa1, pa2, pa3); ATT_SBAR(); \
    pv_d0(o, vb0 + (b) * SHM_V, pa0, pa1, pa2, pa3); } while (0)
    constexpr int SE = 0, SO = SD - 1;
    ATT_SLOAD(SE, 0); ATT_SWRITE(0, SE); ATT_SLOAD(SO, 64); if constexpr (SD == 2) ATT_SLOAD(SE, 128); ATT_SYNC();
    for (int j = 0; j < NT; j += 2) {
        ATT_SWRITE(1, SO); if (j + 1 + SD < NT) ATT_SLOAD(SO, (j + 1 + SD) * 64); ATT_SBAR();
        ATT_TILE(0);
        ATT_SYNC();
        if (j + 2 < NT) ATT_SWRITE(0, SE); if (j + 2 + SD < NT) ATT_SLOAD(SE, (j + 2 + SD) * 64); ATT_SBAR();
        ATT_TILE(1);
        ATT_SYNC();
    }
    { auto rr = __builtin_amdgcn_permlane32_swap(__builtin_bit_cast(unsigned, l_reg), __builtin_bit_cast(unsigned, l_reg), false, false);
      l_reg = __builtin_bit_cast(float, rr[0]) + __builtin_bit_cast(float, rr[1]); }
    if (hi == 0) li_l[r32] = l_reg;
    LDS_WAIT();
#pragma unroll
    for (int r = 0; r < 16; ++r) { const float rl = __builtin_amdgcn_rcpf(li_l[crow(r, hi)]);
#pragma unroll
        for (int d0 = 0; d0 < 4; ++d0) o[d0][r] *= rl; }
    LDS_WAIT();
#undef ATT_SLOAD
#undef ATT_SWRITE
#undef ATT_TILE
}
constexpr int DMA_OFF_K = 3 * SHM_V, DMA_OFF_WS = DMA_OFF_K + 3 * 3 * 8192, DMA_LDS = DMA_OFF_WS + NWAVES * 64 * 4;
static_assert(DMA_LDS <= RING_BYTES && 4 * SHM_V + 3 * 3 * 8192 + NWAVES * 64 * 4 <= ATT_BYTES, "attention LDS");
template <int NS>
__device__ __forceinline__ void attn_body_dma(const bf16_t* __restrict__ Qb, int ldq, const bf16_t* __restrict__ Kh, int ldk, const bf16_t* __restrict__ Vh, int ldv,
                                              float negoff, LAS char* lds, f32x16 (&o)[4]) {
    constexpr int NQK = 4 * NS, KB = NS * 8192, NT = SEQ / 64;
    const int tid = opq(threadIdx.x), wid = __builtin_amdgcn_readfirstlane(tid >> 6), lane = tid & 63, r32 = lane & 31, hi = lane >> 5;
    LAS char* V_lds = lds; LAS char* K_lds = lds + DMA_OFF_K;
    LAS float* li_l = (LAS float*)(lds + DMA_OFF_WS) + wid * 64;
    float l_reg = 0.f;
#pragma unroll
    for (int d = 0; d < 4; ++d)
#pragma unroll
        for (int r = 0; r < 16; ++r) o[d][r] = 0.f;
    bf16x8 qr[NQK];
    { const bf16_t* Qw = Qb + (size_t)(wid * 32 + r32) * ldq + hi * 8;
#pragma unroll
      for (int d0 = 0; d0 < NQK; ++d0) qr[d0] = *(const bf16x8*)(Qw + d0 * 16); }
    const int vb0 = (int)(unsigned)(uintptr_t)V_lds + v_rd_base(lane);
    const int kxb = hi ^ ((r32 >> 1) & 7), krow = r32 * 128;
    f32x16 negv;
#pragma unroll
    for (int r = 0; r < 16; ++r) negv[r] = (NS == 1) ? negoff : 0.f;
    const float nadd = (NS == 1) ? 0.f : negoff;
    unsigned vsrc[2], ksrc;
#pragma unroll
    for (int i = 0; i < 2; ++i) { const int p = (2 * wid + i) * 64 + lane, sub = p >> 5, kk = (sub >> 2) * 8 + ((p & 31) >> 2), k = (kk & ~0xC) | ((kk & 4) << 1) | ((kk & 8) >> 1), c = (sub & 3) * 32 + (p & 3) * 8;
        vsrc[i] = (unsigned)(k * ldv + c) * 2u; }
    { const int p = wid * 64 + lane, row = p >> 3, chunk = (p & 7) ^ ((row >> 1) & 7); ksrc = (unsigned)(row * ldk + chunk * 8) * 2u; }
#define ATT_DMA(slot, k0) do { const char* vt_ = (const char*)Vh + (size_t)(k0) * ldv * 2; const char* kt_ = (const char*)Kh + (size_t)(k0) * ldk * 2; \
    _Pragma("unroll") for (int i_ = 0; i_ < 2; ++i_) __builtin_amdgcn_global_load_lds((const unsigned*)(vt_ + vsrc[i_]), (LAS unsigned*)(V_lds + (slot) * SHM_V + (2 * wid + i_) * 1024), 16, 0, 0); \
    _Pragma("unroll") for (int s_ = 0; s_ < NS; ++s_) __builtin_amdgcn_global_load_lds((const unsigned*)(kt_ + ksrc + s_ * 128), (LAS unsigned*)(K_lds + (slot) * KB + s_ * 8192 + wid * 1024), 16, 0, 0); } while (0)
#define ATT_LDK(buf, g, kb_) do { _Pragma("unroll") for (int q_ = 0; q_ < 2; ++q_) { const int d0_ = 2 * (g) + q_; \
        const LAS char* kp_ = (kb_) + (d0_ >> 2) * 8192 + ((((d0_ & 3) * 2) ^ kxb) << 4); kf[buf][2 * q_] = *(const LAS bf16x8*)kp_; kf[buf][2 * q_ + 1] = *(const LAS bf16x8*)(kp_ + 4096); } } while (0)
#define ATT_TILE_D(slot) do { f32x16 p0_, p1_; bf16x8 pa0, pa1, pa2, pa3; const LAS char* kb_ = K_lds + (slot) * KB + krow; bf16x8 kf[2][4]; \
    ATT_LDK(0, 0, kb_); ATT_SBAR(); \
    _Pragma("unroll") for (int g_ = 0; g_ < NQK / 2; ++g_) { \
        if (g_ + 1 < NQK / 2) ATT_LDK((g_ + 1) & 1, g_ + 1, kb_); ATT_SBAR(); \
        _Pragma("unroll") for (int q_ = 0; q_ < 2; ++q_) { \
            p0_ = __builtin_amdgcn_mfma_f32_32x32x16_bf16(kf[g_ & 1][2 * q_], qr[2 * g_ + q_], (g_ == 0 && q_ == 0) ? negv : p0_, 0, 0, 0); \
            p1_ = __builtin_amdgcn_mfma_f32_32x32x16_bf16(kf[g_ & 1][2 * q_ + 1], qr[2 * g_ + q_], (g_ == 0 && q_ == 0) ? negv : p1_, 0, 0, 0); } \
        ATT_SBAR(); } \
    if constexpr (NS == 1) { _Pragma("unroll") for (int r_ = 0; r_ < 16; ++r_) { p0_[r_] = __builtin_amdgcn_exp2f(p0_[r_]); p1_[r_] = __builtin_amdgcn_exp2f(p1_[r_]); } } \
    else { _Pragma("unroll") for (int r_ = 0; r_ < 16; ++r_) { p0_[r_] = __builtin_amdgcn_exp2f(p0_[r_] + nadd); p1_[r_] = __builtin_amdgcn_exp2f(p1_[r_] + nadd); } } \
    finishSM(p0_, p1_, l_reg, pa0, pa1, pa2, pa3); ATT_SBAR(); \
    pv_d0(o, vb0 + (slot) * SHM_V, pa0, pa1, pa2, pa3); } while (0)
    ATT_DMA(0, 0); ATT_DMA(1, 64);
    if constexpr (NS == 1) asm volatile("s_waitcnt vmcnt(3)" ::: "memory"); else asm volatile("s_waitcnt vmcnt(5)" ::: "memory");
    ATT_SYNC();
    int slot = 0;
    for (int j = 0; j < NT; ++j) {
        const int s2 = (slot == 0) ? 2 : slot - 1;
        if (j + 2 < NT) ATT_DMA(s2, (j + 2) * 64);
        ATT_SBAR();
        ATT_TILE_D(slot);
        if (j + 2 < NT) { if constexpr (NS == 1) asm volatile("s_waitcnt vmcnt(3)" ::: "memory"); else asm volatile("s_waitcnt vmcnt(5)" ::: "memory"); }
        else asm volatile("s_waitcnt vmcnt(0)" ::: "memory");
        ATT_SYNC();
        slot = (slot == 2) ? 0 : slot + 1;
    }
    { auto rr = __builtin_amdgcn_permlane32_swap(__builtin_bit_cast(unsigned, l_reg), __builtin_bit_cast(unsigned, l_reg), false, false);
      l_reg = __builtin_bit_cast(float, rr[0]) + __builtin_bit_cast(float, rr[1]); }
    if (hi == 0) li_l[r32] = l_reg;
    LDS_WAIT();
#pragma unroll
    for (int r = 0; r < 16; ++r) { const float rl = __builtin_amdgcn_rcpf(li_l[crow(r, hi)]);
#pragma unroll
        for (int d0 = 0; d0 < 4; ++d0) o[d0][r] *= rl; }
    LDS_WAIT();
#undef ATT_DMA
#undef ATT_TILE_D
#undef ATT_LDK
}
template <int NS>
__device__ __forceinline__ void attn_body_st(const bf16_t* __restrict__ Qb, int ldq, const bf16_t* __restrict__ Kh, int ldk, const bf16_t* __restrict__ Vh, int ldv,
                                             float negoff, LAS char* lds, f32x16 (&o)[4]) {
    constexpr int NQK = 4 * NS, KB = NS * 8192, NT = SEQ / 64;
    const int tid = opq(threadIdx.x), wid = __builtin_amdgcn_readfirstlane(tid >> 6), lane = tid & 63, r32 = lane & 31, hi = lane >> 5;
    LAS char* V_lds = lds; LAS char* K_lds = lds + 4 * SHM_V;
    LAS float* li_l = (LAS float*)(lds + 4 * SHM_V + 3 * 3 * 8192) + wid * 64;
    float l_reg = 0.f;
#pragma unroll
    for (int d = 0; d < 4; ++d)
#pragma unroll
        for (int r = 0; r < 16; ++r) o[d][r] = 0.f;
    bf16x8 qr[NQK];
    { const bf16_t* Qw = Qb + (size_t)(wid * 32 + r32) * ldq + hi * 8;
#pragma unroll
      for (int d0 = 0; d0 < NQK; ++d0) qr[d0] = *(const bf16x8*)(Qw + d0 * 16); }
    const int vb0 = (int)(unsigned)(uintptr_t)V_lds + v_rd_base(lane);
    const int kxb = hi ^ ((r32 >> 1) & 7), krow = r32 * 128;
    unsigned vsrc[2], ksrc;
#pragma unroll
    for (int i = 0; i < 2; ++i) { const int p = (2 * wid + i) * 64 + lane, sub = p >> 5, kk = (sub >> 2) * 8 + ((p & 31) >> 2), k = (kk & ~0xC) | ((kk & 4) << 1) | ((kk & 8) >> 1), c = (sub & 3) * 32 + (p & 3) * 8;
        vsrc[i] = (unsigned)(k * ldv + c) * 2u; }
    { const int p = wid * 64 + lane, row = p >> 3, chunk = (p & 7) ^ ((row >> 1) & 7); ksrc = (unsigned)(row * ldk + chunk * 8) * 2u; }
#define ATT_DMA(vslot, kslot, k0) do { const char* vt_ = (const char*)Vh + (size_t)(k0) * ldv * 2; const char* kt_ = (const char*)Kh + (size_t)(k0) * ldk * 2; \
    _Pragma("unroll") for (int i_ = 0; i_ < 2; ++i_) __builtin_amdgcn_global_load_lds((const unsigned*)(vt_ + vsrc[i_]), (LAS unsigned*)(V_lds + (vslot) * SHM_V + (2 * wid + i_) * 1024), 16, 0, 0); \
    _Pragma("unroll") for (int s_ = 0; s_ < NS; ++s_) __builtin_amdgcn_global_load_lds((const unsigned*)(kt_ + ksrc + s_ * 128), (LAS unsigned*)(K_lds + (kslot) * KB + s_ * 8192 + wid * 1024), 16, 0, 0); } while (0)
#define ATT_LDK(buf, g, kb_) do { _Pragma("unroll") for (int q_ = 0; q_ < 2; ++q_) { constexpr int dummy_ = 0; (void)dummy_; const int d0_ = 2 * (g) + q_; \
        const LAS char* kp_ = (kb_) + (d0_ >> 2) * 8192 + ((((d0_ & 3) * 2) ^ kxb) << 4); kf[buf][2 * q_] = *(const LAS bf16x8*)kp_; kf[buf][2 * q_ + 1] = *(const LAS bf16x8*)(kp_ + 4096); } } while (0)
#define ATT_QKSM(kslot) do { f32x16 p0_, p1_; const LAS char* kb_ = K_lds + (kslot) * KB + krow; bf16x8 kf[2][4]; \
    _Pragma("unroll") for (int r_ = 0; r_ < 16; ++r_) { p0_[r_] = 0.f; p1_[r_] = 0.f; } \
    ATT_LDK(0, 0, kb_); ATT_SBAR(); \
    _Pragma("unroll") for (int g_ = 0; g_ < NQK / 2; ++g_) { \
        if (g_ + 1 < NQK / 2) ATT_LDK((g_ + 1) & 1, g_ + 1, kb_); ATT_SBAR(); \
        _Pragma("unroll") for (int q_ = 0; q_ < 2; ++q_) { p0_ = __builtin_amdgcn_mfma_f32_32x32x16_bf16(kf[g_ & 1][2 * q_], qr[2 * g_ + q_], p0_, 0, 0, 0); p1_ = __builtin_amdgcn_mfma_f32_32x32x16_bf16(kf[g_ & 1][2 * q_ + 1], qr[2 * g_ + q_], p1_, 0, 0, 0); } \
        ATT_SBAR(); } \
    _Pragma("unroll") for (int r_ = 0; r_ < 16; ++r_) { p0_[r_] = __builtin_amdgcn_exp2f(p0_[r_] + negoff); p1_[r_] = __builtin_amdgcn_exp2f(p1_[r_] + negoff); } \
    finishSM(p0_, p1_, l_reg, pa0, pa1, pa2, pa3); } while (0)
#define ATT_ENDI(fly) do { if (fly) { if constexpr (NS == 1) asm volatile("s_waitcnt vmcnt(3)" ::: "memory"); else asm volatile("s_waitcnt vmcnt(5)" ::: "memory"); } else asm volatile("s_waitcnt vmcnt(0)" ::: "memory"); ATT_SYNC(); } while (0)
    bf16x8 pa0, pa1, pa2, pa3;
    ATT_DMA(0, 0, 0); ATT_DMA(1, 1, 64); ATT_ENDI(true);
    int vs = 0, ks = 0;
    if (wid < 4) {
        for (int j = 0; j < NT; ++j) {
            if (j + 2 < NT) ATT_DMA((vs + 2) & 3, (ks == 0) ? 2 : ks - 1, (j + 2) * 64);
            ATT_SBAR();
            ATT_QKSM(ks); ATT_SBAR();
            pv_d0(o, vb0 + vs * SHM_V, pa0, pa1, pa2, pa3);
            ATT_ENDI(j + 2 < NT);
            vs = (vs + 1) & 3; ks = (ks == 2) ? 0 : ks + 1;
        }
    } else {
        int vp = 0;
        for (int j = 0; j < NT; ++j) {
            if (j + 2 < NT) ATT_DMA((vs + 2) & 3, (ks == 0) ? 2 : ks - 1, (j + 2) * 64);
            ATT_SBAR();
            if (j > 0) pv_d0(o, vb0 + vp * SHM_V, pa0, pa1, pa2, pa3);
            ATT_SBAR();
            ATT_QKSM(ks);
            ATT_ENDI(j + 2 < NT);
            vp = vs; vs = (vs + 1) & 3; ks = (ks == 2) ? 0 : ks + 1;
        }
        ATT_SBAR();
        pv_d0(o, vb0 + vp * SHM_V, pa0, pa1, pa2, pa3);
    }
    ATT_SYNC();
    { auto rr = __builtin_amdgcn_permlane32_swap(__builtin_bit_cast(unsigned, l_reg), __builtin_bit_cast(unsigned, l_reg), false, false);
      l_reg = __builtin_bit_cast(float, rr[0]) + __builtin_bit_cast(float, rr[1]); }
    if (hi == 0) li_l[r32] = l_reg;
    LDS_WAIT();
#pragma unroll
    for (int r = 0; r < 16; ++r) { const float rl = __builtin_amdgcn_rcpf(li_l[crow(r, hi)]);
#pragma unroll
        for (int d0 = 0; d0 < 4; ++d0) o[d0][r] *= rl; }
    LDS_WAIT();
#undef ATT_DMA
#undef ATT_QKSM
#undef ATT_LDK
#undef ATT_ENDI
}
}

#define XB_TMO      128
#define XB_XCNT(j)  (256  + 64 * (j))
#define XB_XSUB(j)  (1280 + 64 * (j))
#define XB_XGEN(j)  (2304 + 64 * (j))
#define XB_TOP      3328
#define XB_TOPGEN   3392
#define XCD_BAR_WORDS 3456
#define XB_SPIN_CAP (1u << 22)
__device__ __forceinline__ unsigned xb_ld(unsigned* p)              { return __hip_atomic_load(p, __ATOMIC_RELAXED, __HIP_MEMORY_SCOPE_AGENT); }
__device__ __forceinline__ unsigned xb_add(unsigned* p, unsigned v) { return __hip_atomic_fetch_add(p, v, __ATOMIC_RELAXED, __HIP_MEMORY_SCOPE_AGENT); }
__device__ __forceinline__ unsigned xb_xcc_id() { return (unsigned)__builtin_amdgcn_s_getreg((3 << 11) | 20) & 0xFu; }
#define XB_SPIN(cond, bar) do { unsigned _sp = 0; while (cond) { __builtin_amdgcn_s_sleep(1); \
    if ((++_sp & 255u) == 0u) { if (xb_ld(&(bar)[XB_TMO])) break; if (_sp > XB_SPIN_CAP) { atomicAdd(&(bar)[XB_TMO], 1u); break; } } } } while (0)
struct XcdBarrier { unsigned* bar; unsigned x; volatile LAS unsigned* st; };
__device__ __forceinline__ XcdBarrier xcd_barrier_post(unsigned* bar, volatile LAS unsigned* st) {
    XcdBarrier b; b.bar = bar; b.x = xb_xcc_id(); b.st = st;
    if (threadIdx.x == 0) (void)xb_add(&bar[XB_XCNT(b.x)], 1u);
    return b;
}
__device__ __forceinline__ void xcd_barrier_complete(unsigned* bar, unsigned x, unsigned& nloc, unsigned& nx) {
    const unsigned G = gridDim.x * gridDim.y * gridDim.z;
    unsigned sum, cnt, mine, sp = 0u;
    for (;;) {
        sum = 0u; cnt = 0u; mine = 0u;
#pragma unroll
        for (unsigned j = 0; j < 16; ++j) { const unsigned c = xb_ld(&bar[XB_XCNT(j)]); sum += c; cnt += (c > 0u) ? 1u : 0u; mine = (j == x) ? c : mine; }
        if (sum == G) break;
        __builtin_amdgcn_s_sleep(1);
        if ((++sp & 255u) == 0u) { if (xb_ld(&bar[XB_TMO])) break; if (sp > XB_SPIN_CAP) { atomicAdd(&bar[XB_TMO], 1u); break; } }
    }
    nloc = mine > 0u ? mine : 1u; nx = cnt > 0u ? cnt : 1u;
}
__device__ __forceinline__ void xcd_barrier(const XcdBarrier& b) {
    asm volatile("s_waitcnt vmcnt(0)" ::: "memory");
    __syncthreads();
    if (threadIdx.x == 0) {
        unsigned* bar = b.bar;
        __builtin_amdgcn_s_waitcnt(0);
        unsigned nloc = b.st[0], nx = b.st[1];
        if (nloc == 0u) { xcd_barrier_complete(bar, b.x, nloc, nx); b.st[0] = nloc; b.st[1] = nx; }
        const unsigned old = xb_add(&bar[XB_XSUB(b.x)], 1u);
        const unsigned gen = old / nloc;
        if (old + 1u == (gen + 1u) * nloc) {
            __builtin_amdgcn_fence(__ATOMIC_RELEASE, "agent");
            asm volatile("s_waitcnt vmcnt(0)" ::: "memory");
            const unsigned og = xb_add(&bar[XB_TOP], 1u);
            const unsigned tg = og / nx;
            if (og + 1u == (tg + 1u) * nx) xb_add(&bar[XB_TOPGEN], 1u);
            else XB_SPIN(xb_ld(&bar[XB_TOPGEN]) == tg, bar);
            __builtin_amdgcn_fence(__ATOMIC_ACQUIRE, "agent");
            xb_add(&bar[XB_XGEN(b.x)], 1u);
            asm volatile("s_waitcnt vmcnt(0)" ::: "memory");
        } else {
            XB_SPIN(xb_ld(&bar[XB_XGEN(b.x)]) == gen, bar);
            __builtin_amdgcn_fence(__ATOMIC_ACQUIRE, "agent");
            asm volatile("s_waitcnt vmcnt(0)" ::: "memory");
        }
    }
    __syncthreads();
}

template <int MODE = 0>
__device__ __forceinline__ void tr_item(const float* W, size_t ldw, int k0, int n0, bf16_t* WT, size_t ldt, int drow0, int dcol0, LAS float* scr, int lane, float qinv = 1.f) {
    constexpr bool F8 = (MODE == 1);
    { f32x4 wv_[8];
#pragma unroll
      for (int i = 0; i < 8; ++i) wv_[i] = *(const f32x4*)(W + (size_t)(k0 + 8 * i + (lane >> 3)) * ldw + n0 + 4 * (lane & 7));
#pragma unroll
      for (int i = 0; i < 8; ++i) { LAS float* d_ = scr + (8 * i + (lane >> 3)) * 33 + 4 * (lane & 7); d_[0] = wv_[i].x; d_[1] = wv_[i].y; d_[2] = wv_[i].z; d_[3] = wv_[i].w; } }
    LDS_WAIT(); asm volatile("" ::: "memory");
    const int c = lane & 7;
#pragma unroll
    for (int j = 0; j < 4; ++j) { const int n = (lane >> 3) + 8 * j; const LAS float* s = scr + (8 * c) * 33 + n;
        if constexpr (MODE == 2) { u32x2 o; o.x = pk_i8x4(s[0 * 33] * qinv, s[1 * 33] * qinv, s[2 * 33] * qinv, s[3 * 33] * qinv); o.y = pk_i8x4(s[4 * 33] * qinv, s[5 * 33] * qinv, s[6 * 33] * qinv, s[7 * 33] * qinv);
            *(u32x2*)((unsigned char*)WT + (size_t)(drow0 + n) * ldt + dcol0 + 8 * c) = o; }
        else if constexpr (F8) { u32x2 o; o.x = pk_fp8x4(s[0 * 33] * W8_SCALE, s[1 * 33] * W8_SCALE, s[2 * 33] * W8_SCALE, s[3 * 33] * W8_SCALE); o.y = pk_fp8x4(s[4 * 33] * W8_SCALE, s[5 * 33] * W8_SCALE, s[6 * 33] * W8_SCALE, s[7 * 33] * W8_SCALE);
            *(u32x2*)((unsigned char*)WT + (size_t)(drow0 + n) * ldt + dcol0 + 8 * c) = o; }
        else { u32x4 o; o.x = pk2(s[0 * 33], s[1 * 33]); o.y = pk2(s[2 * 33], s[3 * 33]); o.z = pk2(s[4 * 33], s[5 * 33]); o.w = pk2(s[6 * 33], s[7 * 33]);
            *(u32x4*)(WT + (size_t)(drow0 + n) * ldt + dcol0 + 8 * c) = o; } }
    LDS_WAIT(); asm volatile("" ::: "memory");
}

struct Args { const void* in[27]; float* out; unsigned char* ws; int step_lo, step_hi; };
typedef const __attribute__((address_space(4))) Args CArgs;
__device__ __forceinline__ CArgs* opq_args() { CArgs* p = (CArgs*)__builtin_amdgcn_kernarg_segment_ptr(); asm volatile("" : "+s"(p)); return p; }

__global__ void __launch_bounds__(NWAVES * 64, 2) fwd(Args args) {
    extern __shared__ __attribute__((aligned(16))) unsigned char lds_raw[];
    LAS unsigned char* lds = (LAS unsigned char*)lds_raw;
    volatile LAS unsigned* MISC = (volatile LAS unsigned*)(lds + MISC_OFF);
    const int tid0 = threadIdx.x, wave = __builtin_amdgcn_readfirstlane(tid0 >> 6);
    const int G0 = gridDim.x, bx0 = blockIdx.x;
    const int vcu0 = (G0 % 8 == 0) ? (bx0 % 8) * (G0 / 8) + bx0 / 8 : bx0;
    const int gw0 = vcu0 * NWAVES + wave;
#define ws (A->ws)
    for (int u = tid0; u < (LDS_BYTES - LDSCTL_OFF) / 4; u += NWAVES * 64) ((LAS unsigned*)(lds + LDSCTL_OFF))[u] = 0u;
    __syncthreads();
    const int lo = args.step_lo, hi = args.step_hi;
    if (MK_ONE_LAUNCH) { CArgs* A = opq_args(); const int G = opqs(G0), bx = opqs(bx0), gw = opqs(gw0), NGW = G * NWAVES; (void)bx; (void)gw; (void)NGW; (void)xcd_barrier_post((unsigned*)(ws + WS_CTL) + CW_BAR, MISC + 8); }
#ifndef DISMASK
#define DISMASK 0
#endif
#define EN(p) (!((DISMASK >> (p)) & 1))
#ifndef P3MASK
#define P3MASK 0
#endif
#ifndef P5MASK
#define P5MASK 0
#endif
#define P5EN(p) (!((P5MASK >> (p)) & 1))
#define P3EN(p) (!((P3MASK >> (p)) & 1))
#ifndef DUPMASK
#define DUPMASK 0
#endif
#define NREP(p) ((((DUPMASK) >> (p)) & 1) ? 2 : 1)
#define IN(k) (lo <= (k) && (k) < hi)
#define SEAM(k) do { if ((k) + 1 < hi) { if (MK_ONE_LAUNCH) { XcdBarrier bar_; bar_.bar = (unsigned*)(ws + WS_CTL) + CW_BAR; bar_.x = xb_xcc_id(); bar_.st = (volatile LAS unsigned*)(lds + MISC_OFF) + 8; xcd_barrier(bar_); } } } while (0)

#define cosA ((float*)(ws + WS_COSA))
#define sinA ((float*)(ws + WS_SINA))
#define cosC ((float*)(ws + WS_COSC))
#define sinC ((float*)(ws + WS_SINC))
#define XN ((bf16_t*)(ws + WS_XN))
#define H ((bf16_t*)(ws + WS_H))
#define UC ((bf16_t*)(ws + WS_UC))
#define QM ((bf16_t*)(ws + WS_QM))
#define KV ((bf16_t*)(ws + WS_KV))
#define KM ((bf16_t*)(ws + WS_KM))
#define LAB ((unsigned*)(ws + WS_LAB))
#define AGP ((float*)(ws + WS_AGP))
#define AGH ((float*)(ws + WS_AGH))
#define GATES ((bf16_t*)(ws + WS_GATES))
#define DBUF ((float*)(ws + WS_DBUF))
#define OCAT ((bf16_t*)(ws + WS_OCAT))
#define TMP ((float*)(ws + WS_TMP))
#define YSUM ((bf16_t*)(ws + WS_YSUM))
#define HID ((bf16_t*)(ws + WS_HID))
#define x_in ((const float*)A->in[0])
#define out (A->out)

    auto conv_layer = [](CArgs* A, LAS unsigned char* lds, const int wave, const int lc, const int part, const int tid, const int lane, const int G, const int bx, const int gw, const int NGW) __attribute__((always_inline)) {
        if (part == 0) { const int l = lc;
            unsigned char* wlp = ws + WS_W + (size_t)l * WL_SIZE;
            u32x4* padp = (u32x4*)(wlp + WL_IN + (size_t)NIN * DM * 2);
            for (int i = bx * 512 + tid; i < (NINP - NIN) * DM * 2 / 16; i += G * 512) padp[i] = (u32x4){0u, 0u, 0u, 0u};
            bf16_t* wlru = (bf16_t*)(wlp + WL_LRU); const float* gwsrc = (const float*)A->in[10] + (size_t)l * 2 * 2 * 8 * 128 * 128;
            (void)gwsrc;
            for (int i = bx * 512 + tid; i < 4096 * 16; i += G * 512) { const int R = i >> 4, c8 = i & 15, nb = R >> 9;
                *(u32x4*)(wlru + (size_t)R * 256 + (1 - (nb & 1)) * 128 + 8 * c8) = (u32x4){0u, 0u, 0u, 0u}; }
        }
        { LAS float* scr = (LAS float*)(lds + wave * 16384);
          constexpr int I_IN = 64 * 210, I_UQ = 12 * 48, I_UKV = 8 * 64, I_G = 4 * 384, I_BO = 3 * 16 * 128, I_OUT = 64 * 128, I_GA = 64 * 344, I_UP = I_GA, I_DN = 172 * 128, I_LRU = 32 * 8;
          constexpr int I_MIX = I_IN + I_UQ + I_UKV + I_G + I_BO + I_OUT + I_LRU, I_L = I_MIX + I_GA + I_UP + I_DN;
          const int IT0 = part ? I_MIX : 0, NIT = part ? I_L : I_MIX;
          float qsl = 1.f / ((const float*)(ws + WS_WSC))[lane & 7];
          asm volatile("s_waitcnt vmcnt(0)" : "+v"(qsl) :: "memory");
          auto dec = [&](int it, const float*& src, size_t& ldw, unsigned char*& dst, size_t& rsb, int& mode, float& q) {
              const int l = lc; int r = it;
              int kb, nb, drow, dcol; size_t ldt, woff; mode = 0; q = 1.f;
              if (r < I_IN) { kb = r / 210; nb = r - 210 * kb; src = (const float*)A->in[3] + (size_t)l * DM * NIN; ldw = NIN; woff = WL_IN; ldt = DM; drow = 32 * nb; dcol = 64 * kb; }
              else if ((r -= I_IN) < I_UQ) { kb = r / 48; nb = r - 48 * kb; src = (const float*)A->in[14] + (size_t)l * 768 * 1536; ldw = 1536; woff = WL_UQ; ldt = 768; drow = 32 * nb; dcol = 64 * kb; }
              else if ((r -= I_UQ) < I_UKV) { kb = r / 64; nb = r - 64 * kb; src = (const float*)A->in[16] + (size_t)l * 512 * 2048; ldw = 2048; woff = WL_UKV; ldt = 512; drow = 32 * nb; dcol = 64 * kb; }
              else if ((r -= I_UKV) < I_G) { kb = r / 384; nb = r - 384 * kb; src = (const float*)A->in[19] + (size_t)l * 256 * 12288; ldw = 12288; woff = WL_G; ldt = 256; drow = 32 * nb; dcol = 64 * kb; }
              else if ((r -= I_G) < I_BO) { const int n = r / (16 * 128), r2 = r - n * 16 * 128; kb = r2 / 128; nb = r2 - 128 * kb;
                  src = (const float*)A->in[21] + ((size_t)l * 3 + n) * 1024 * 4096; ldw = 4096; woff = WL_BO; ldt = 3072; drow = 32 * nb; dcol = 1024 * n + 64 * kb; }
              else if ((r -= I_BO) < I_OUT) { kb = r / 128; nb = r - 128 * kb; src = (const float*)A->in[22] + (size_t)l * DM * DM; ldw = DM; woff = WL_OUT; ldt = DM; drow = 32 * nb; dcol = 64 * kb; if (F8O(l)) { mode = 1; q = W8_SCALE; } }
              else if ((r -= I_OUT) < I_LRU) { const int blk = r >> 3, zg = blk >> 3, nbk = blk & 7; kb = (r >> 2) & 1; nb = r & 3;
                  src = (const float*)A->in[10] + ((size_t)l * 32 + blk) * 128 * 128; ldw = 128; woff = WL_LRU; ldt = 256; drow = (2 * nbk + (zg >> 1)) * 256 + (zg & 1) * 128 + 32 * nb; dcol = (nbk & 1) * 128 + 64 * kb; }
              else if ((r -= I_LRU) < I_GA + I_UP) { const int up = r >= I_GA; if (up) r -= I_GA; kb = r / 344; nb = r - 344 * kb; const int n0 = 32 * nb;
                  src = (const float*)A->in[up ? 25 : 24] + (size_t)l * DM * FFH; ldw = FFH; woff = WL_GU; ldt = DM; drow = 256 * (n0 >> 7) + 128 * up + (n0 & 127); dcol = 64 * kb;
                  if (I8U(l)) { mode = 2; q = __builtin_bit_cast(float, __builtin_amdgcn_readlane(__builtin_bit_cast(int, qsl), 2 * l + up)); } else if (F8U(l)) { mode = 1; q = W8_SCALE; } }
              else { r -= I_GA + I_UP; { kb = r / 128; nb = r - 128 * kb; src = (const float*)A->in[26] + (size_t)l * FFH * DM; ldw = DM; woff = WL_DN; ldt = FFH; drow = 32 * nb; dcol = 64 * kb; if (F8L(l)) { mode = 1; q = W8_SCALE; } } }
              src += (size_t)(64 * kb) * ldw + 32 * nb;
              const size_t esz = mode ? 1 : 2;
              dst = ws + WS_W + (size_t)l * WL_SIZE + woff + ((size_t)drow * ldt + dcol) * esz; rsb = ldt * esz; };
          auto LOAD = [&](int it_, f32x4 (&w)[8]) { const float* src; size_t ldw, rsb; unsigned char* dst; int mode; float q; dec(it_, src, ldw, dst, rsb, mode, q);
#pragma unroll
              for (int i = 0; i < 8; ++i) { const float* p_ = src + (size_t)(8 * i + (lane >> 3)) * ldw + 4 * (lane & 7);
                  w[i] = __builtin_nontemporal_load((const f32x4*)p_); } };
#define TR_WAIT(N, w) do { } while (0)
          auto FIN = [&](int it_, f32x4 (&w)[8]) { const float* src; size_t ldw, rsb; unsigned char* dst; int mode; float q; dec(it_, src, ldw, dst, rsb, mode, q);
#pragma unroll
              for (int i = 0; i < 8; ++i) { LAS float* d_ = scr + (8 * i + (lane >> 3)) * 33 + 4 * (lane & 7); d_[0] = w[i].x; d_[1] = w[i].y; d_[2] = w[i].z; d_[3] = w[i].w; }
              LDS_WAIT(); asm volatile("" ::: "memory");
              const int c = lane & 7;
              if (mode == 0) {
#pragma unroll
                  for (int j = 0; j < 4; ++j) { const int n = (lane >> 3) + 8 * j; const LAS float* sp_ = scr + (8 * c) * 33 + n;
                      u32x4 o; o.x = pk2(sp_[0 * 33], sp_[1 * 33]); o.y = pk2(sp_[2 * 33], sp_[3 * 33]); o.z = pk2(sp_[4 * 33], sp_[5 * 33]); o.w = pk2(sp_[6 * 33], sp_[7 * 33]);
                      __builtin_nontemporal_store(o, (u32x4*)(dst + (size_t)n * rsb + 16 * c)); } }
              else if (mode == 1) {
#pragma unroll
                  for (int j = 0; j < 4; ++j) { const int n = (lane >> 3) + 8 * j; const LAS float* sp_ = scr + (8 * c) * 33 + n;
                      u32x2 o; o.x = pk_fp8x4(sp_[0 * 33] * q, sp_[1 * 33] * q, sp_[2 * 33] * q, sp_[3 * 33] * q); o.y = pk_fp8x4(sp_[4 * 33] * q, sp_[5 * 33] * q, sp_[6 * 33] * q, sp_[7 * 33] * q);
                      __builtin_nontemporal_store(o, (u32x2*)(dst + (size_t)n * rsb + 8 * c)); } }
              else {
#pragma unroll
                  for (int j = 0; j < 4; ++j) { const int n = (lane >> 3) + 8 * j; const LAS float* sp_ = scr + (8 * c) * 33 + n;
                      u32x2 o; o.x = pk_i8x4(sp_[0 * 33] * q, sp_[1 * 33] * q, sp_[2 * 33] * q, sp_[3 * 33] * q); o.y = pk_i8x4(sp_[4 * 33] * q, sp_[5 * 33] * q, sp_[6 * 33] * q, sp_[7 * 33] * q);
                      __builtin_nontemporal_store(o, (u32x2*)(dst + (size_t)n * rsb + 8 * c)); } }
              LDS_WAIT(); asm volatile("" ::: "memory"); };
          f32x4 wa[8], wb[8];
#pragma nounroll
          for (int it = IT0 + gw; it < NIT; it += 4 * NGW) {
              const int i1 = it + NGW, i2 = it + 2 * NGW, i3 = it + 3 * NGW;
              LOAD(it, wa); LOAD(i1 < NIT ? i1 : NIT - 1, wb);
              TR_WAIT(8, wa); FIN(it, wa);
              LOAD(i2 < NIT ? i2 : NIT - 1, wa);
              TR_WAIT(12, wb); if (i1 < NIT) FIN(i1, wb);
              LOAD(i3 < NIT ? i3 : NIT - 1, wb);
              TR_WAIT(12, wa); if (i2 < NIT) FIN(i2, wa);
              TR_WAIT(4, wb); if (i3 < NIT) FIN(i3, wb);
          }
          asm volatile("s_waitcnt vmcnt(0)" ::: "memory");
#undef TR_WAIT
        }
    };
    if (EN(12) && IN(0)) for (int rep_ = 0; rep_ < NREP(12); ++rep_) { const int tid = opq(tid0), lane = tid & 63; CArgs* A = opq_args(); const int G = opqs(G0), bx = opqs(bx0), gw = opqs(gw0), NGW = G * NWAVES; (void)bx; (void)gw; (void)NGW;
        if (I8UP_LAYERS != 0) {
            if (bx < 2 * DEPTH && I8U(bx >> 1)) {
                const float* Wt = (const float*)A->in[(bx & 1) ? 25 : 24] + (size_t)(bx >> 1) * DM * FFH; float ssq = 0.f, amx = 0.f;
#pragma nounroll
                for (int r = 0; r < 16; ++r) {
                    const f32x4* rowp = (const f32x4*)(Wt + (size_t)(256 * r) * FFH); f32x4 w[6];
#pragma unroll
                    for (int u = 0; u < 6; ++u) { const int i = tid + u * (NWAVES * 64); w[u] = rowp[i < FFH / 4 ? i : 0]; if (i >= FFH / 4) w[u] = (f32x4){0.f, 0.f, 0.f, 0.f}; }
#pragma unroll
                    for (int u = 0; u < 6; ++u) { ssq += (w[u].x * w[u].x + w[u].y * w[u].y) + (w[u].z * w[u].z + w[u].w * w[u].w); amx = fmaxf(fmaxf(amx, fmaxf(fabsf(w[u].x), fabsf(w[u].y))), fmaxf(fabsf(w[u].z), fabsf(w[u].w))); } }
                ssq = wave_sum(ssq); amx = wave_max(amx);
                LAS float* red = (LAS float*)(lds);
                if (lane == 0) { red[2 * wave] = ssq; red[2 * wave + 1] = amx; }
                __syncthreads();
                if (tid == 0) { float a = 0.f, b = 0.f;
                    for (int w = 0; w < NWAVES; ++w) { a += red[2 * w]; b = fmaxf(b, red[2 * w + 1]); }
                    const float rms = sqrtf(a / (16.f * FFH)); float sc = fminf(4.2f * rms, b * 1.05f) * (1.f / 127.f); if (!(sc > 0.f)) sc = 1.f;
                    ((float*)(ws + WS_WSC))[bx] = sc; }
                __syncthreads();
            }
            if (MK_ONE_LAUNCH) { XcdBarrier bar_; bar_.bar = (unsigned*)(ws + WS_CTL) + CW_BAR; bar_.x = xb_xcc_id(); bar_.st = (volatile LAS unsigned*)(lds + MISC_OFF) + 8; xcd_barrier(bar_); }
        }
        { const int* pos = (const int*)A->in[1];
          for (int i = bx * 512 + tid; i < MT * 40; i += G * 512) { const int m = i / 40, f = i - 40 * m;
              float inv; float* cd; float* sd;
              if (f < 8) { inv = exp2f(-(float)(2 * f) / 16.f * 18.931568569324174f); cd = cosA + m * 8 + f; sd = sinA + m * 8 + f; }
              else { const int ff = f - 8; inv = exp2f(-(float)(2 * ff) / 64.f * 18.931568569324174f); cd = cosC + m * 32 + ff; sd = sinC + m * 32 + ff; }
              const float ang = (float)pos[m] * inv; float sv, cv; sincosf(ang, &sv, &cv); *cd = cv; *sd = sv; } }
        { const float* Lsrc = (const float*)A->in[12]; float* spt = (float*)(ws + WS_SPT);
          for (int i = bx * 512 + tid; i < DEPTH * 2048; i += G * 512) spt[i] = -8.f * log1pf(expf(-Lsrc[i])); }
        conv_layer(A, lds, wave, 0, 0, tid, lane, G, bx, gw, NGW);
        SEAM(0);
    }

    for (int l = 0; l < DEPTH; ++l) {
        const int s0 = 1 + 12 * l;
        if (s0 + 12 <= lo || s0 >= hi) continue;
#define wl (ws + WS_W + (size_t)l * WL_SIZE)
#define xcur ((l == 0) ? x_in : (const float*)out)

        if (EN(0) && IN(s0 + 0)) for (int rep_ = 0; rep_ < NREP(0); ++rep_) { const int tid = opq(tid0), lane = tid & 63; (void)tid; (void)lane; CArgs* A = opq_args(); const int G = opqs(G0), bx = opqs(bx0), gw = opqs(gw0), NGW = G * NWAVES; (void)bx; (void)gw; (void)NGW;
            const float* g = (const float*)A->in[2] + (size_t)l * DM;
            for (int m = gw; m < MT; m += NGW) {
                const f32x4* xr = (const f32x4*)(xcur + (size_t)m * DM) + lane;
                f32x4 v[16]; float ss = 0.f;
#pragma unroll
                for (int j = 0; j < 16; ++j) { v[j] = xr[64 * j]; ss += (v[j].x * v[j].x + v[j].y * v[j].y) + (v[j].z * v[j].z + v[j].w * v[j].w); }
                const float rs = rsqrtf(wave_sum(ss) * (1.f / DM) + EPS);
                u32x2* o8 = (u32x2*)(XN + (size_t)m * DM) + lane; const f32x4* gr = (const f32x4*)g + lane;
#pragma unroll
                for (int j = 0; j < 16; ++j) { const f32x4 gg = gr[64 * j]; u32x2 w; w.x = pk2(v[j].x * rs * gg.x, v[j].y * rs * gg.y); w.y = pk2(v[j].z * rs * gg.z, v[j].w * rs * gg.w); o8[64 * j] = w; }
            }
            SEAM(s0 + 0);
        }
        if (EN(1) && IN(s0 + 1)) for (int rep_ = 0; rep_ < NREP(1); ++rep_) { const int tid = opq(tid0), lane = tid & 63; (void)tid; (void)lane; CArgs* A = opq_args(); const int G = opqs(G0), bx = opqs(bx0), gw = opqs(gw0), NGW = G * NWAVES; (void)bx; (void)gw; (void)NGW;
            pg8::Gemm g{XN, (const bf16_t*)(wl + WL_IN), DM, DM, DM}; pg8::SchedPlain S; S.init(MT / 256, NINP / 256 - 4, G, bx, C_BG / 256, 4);
            pg8::EpiBf16 E{H, NINP};
            pg8::gemm_phase(lds, g, S, E);
            SEAM(s0 + 1);
        }
        if (EN(2) && IN(s0 + 2)) for (int rep_ = 0; rep_ < NREP(2); ++rep_) { const int tid = opq(tid0), lane = tid & 63; (void)tid; (void)lane; CArgs* A = opq_args(); const int G = opqs(G0), bx = opqs(bx0), gw = opqs(gw0), NGW = G * NWAVES; (void)bx; (void)gw; (void)NGW;
            const float* gq = (const float*)A->in[4] + l * 64; const float* gk = (const float*)A->in[5] + l * 64;
            const float* gqa = (const float*)A->in[13] + l * 768; const float* gkva = (const float*)A->in[15] + l * 512;
            const float* cw = (const float*)A->in[8] + l * 4096; const float* cb = (const float*)A->in[9] + l * 1024;
            const bool dry = (NREP(2) == 2) && (rep_ == 0);
            for (int m = gw; m < MT; m += NGW) {
                bf16_t* hr = H + (size_t)m * NINP; bf16_t* hw = dry ? (bf16_t*)TMP + (size_t)m * NINP : hr;
                const int t = m & (SEQ - 1);
                u32x4 rq[2][2], rc0, rc1 = {0u, 0u, 0u, 0u}, rkv, ru[4][2];
#pragma unroll
                for (int qk = 0; qk < 2; ++qk) { rq[qk][0] = *(const u32x4*)(hr + qk * 1024 + 16 * lane); rq[qk][1] = *(const u32x4*)(hr + qk * 1024 + 16 * lane + 8); }
                rc0 = *(const u32x4*)(hr + C_CQ + 8 * lane); if (lane < 32) rc1 = *(const u32x4*)(hr + C_CQ + 8 * (64 + lane));
                rkv = *(const u32x4*)(hr + C_CKV + 8 * lane);
#pragma unroll
                for (int j = 0; j < 4; ++j) { const int tt = t + j - 2; const bool ok = (tt >= 0 && tt < SEQ); const bf16_t* ur = H + (size_t)(ok ? m + j - 2 : m) * NINP + C_BX + 16 * lane;
                    ru[j][0] = *(const u32x4*)ur; ru[j][1] = *(const u32x4*)(ur + 8); }
                float ca[8], sa[8];
                { const f32x4 c0 = *(const f32x4*)(cosA + m * 8), c1 = *(const f32x4*)(cosA + m * 8 + 4), s0_ = *(const f32x4*)(sinA + m * 8), s1_ = *(const f32x4*)(sinA + m * 8 + 4);
#pragma unroll
                  for (int e = 0; e < 4; ++e) { ca[e] = c0[e]; ca[4 + e] = c1[e]; sa[e] = s0_[e]; sa[4 + e] = s1_[e]; } }
#pragma unroll
                for (int qk = 0; qk < 2; ++qk) {
                    bf16_t* p = hw + qk * 1024 + 16 * lane;
                    float v[16]; unpack8(rq[qk][0], v); unpack8(rq[qk][1], v + 8);
                    float ss = 0.f;
#pragma unroll
                    for (int e = 0; e < 16; ++e) ss += v[e] * v[e];
                    ss += __shfl_xor(ss, 1); ss += __shfl_xor(ss, 2);
                    const float rs = rsqrtf(ss * (1.f / 64.f) + EPS);
                    const float* gg = (qk ? gk : gq) + 16 * (lane & 3);
#pragma unroll
                    for (int e = 0; e < 16; ++e) v[e] = v[e] * rs * gg[e];
                    if ((lane & 3) == 0) {
#pragma unroll
                        for (int i = 0; i < 8; ++i) { const float c = ca[i], sn = sa[i], x1 = v[i], x2 = v[i + 8]; v[i] = x1 * c - x2 * sn; v[i + 8] = x2 * c + x1 * sn; } }
                    if (qk == 0) {
#pragma unroll
                        for (int e = 0; e < 16; ++e) v[e] *= CA; }
                    *(u32x4*)p = pack8(v); *(u32x4*)(p + 8) = pack8(v + 8);
                }
                { bf16_t* p = hw + C_CQ; float v0[8], v1[8]; unpack8(rc0, v0); unpack8(rc1, v1);
                  float ss = 0.f;
#pragma unroll
                  for (int e = 0; e < 8; ++e) ss += v0[e] * v0[e] + v1[e] * v1[e];
                  const float rs = rsqrtf(wave_sum(ss) * (1.f / 768.f) + EPS);
#pragma unroll
                  for (int e = 0; e < 8; ++e) { v0[e] = v0[e] * rs * gqa[8 * lane + e]; }
                  *(u32x4*)(p + 8 * lane) = pack8(v0);
                  if (lane < 32) {
#pragma unroll
                      for (int e = 0; e < 8; ++e) v1[e] = v1[e] * rs * gqa[8 * (64 + lane) + e];
                      *(u32x4*)(p + 8 * (64 + lane)) = pack8(v1); } }
                { bf16_t* p = hw + C_CKV + 8 * lane; float v0[8]; unpack8(rkv, v0);
                  float ss = 0.f;
#pragma unroll
                  for (int e = 0; e < 8; ++e) ss += v0[e] * v0[e];
                  const float rs = rsqrtf(wave_sum(ss) * (1.f / 512.f) + EPS);
#pragma unroll
                  for (int e = 0; e < 8; ++e) v0[e] = v0[e] * rs * gkva[8 * lane + e];
                  *(u32x4*)p = pack8(v0); }
                { float a[16];
#pragma unroll
                  for (int e = 0; e < 16; ++e) a[e] = cb[16 * lane + e];
#pragma unroll
                  for (int j = 0; j < 4; ++j) { const int tt = t + j - 2;
                      if (tt >= 0 && tt < SEQ) { float uv[16]; unpack8(ru[j][0], uv); unpack8(ru[j][1], uv + 8);
#pragma unroll
                          for (int e = 0; e < 16; ++e) a[e] += cw[j * 1024 + 16 * lane + e] * uv[e]; } }
                  bf16_t* up = (dry ? (bf16_t*)TMP : UC) + (size_t)m * 1024 + 16 * lane; *(u32x4*)up = pack8(a); *(u32x4*)(up + 8) = pack8(a + 8); }
            }
            SEAM(s0 + 2);
        }
        if (EN(3) && IN(s0 + 3)) for (int rep_ = 0; rep_ < NREP(3); ++rep_) { const int tid = opq(tid0), lane = tid & 63; (void)tid; (void)lane; CArgs* A = opq_args(); const int G = opqs(G0), bx = opqs(bx0), gw = opqs(gw0), NGW = G * NWAVES; (void)bx; (void)gw; (void)NGW;
            const int GA = G / 2, GB = G - GA, cA = (bx < GA) ? bx : -1, cB = (bx >= GA) ? bx - GA : -1;
            { pg8::Gemm g{XN, (const bf16_t*)(wl + WL_IN) + (size_t)C_BG * DM, DM, DM, DM}; pg8::SchedPlain S; S.init(MT / 256, 4, GA, cA); pg8::EpiBf16 E{H + C_BG, NINP}; pg8::gemm_phase(lds, g, S, E); }
            if (P3EN(0)) { pg8::Gemm g{H + C_CQ, (const bf16_t*)(wl + WL_UQ), NINP, 768, 768}; pg8::SchedPlain S; S.init(MT / 256, 1536 / 256, GB, cB); pg8::EpiBf16 E{QM, 1536}; pg8::gemm_phase(lds, g, S, E); }
            if (P3EN(1)) { pg8::Gemm g{H + C_CKV, (const bf16_t*)(wl + WL_UKV), NINP, 512, 512}; pg8::SchedPlain S; S.init(MT / 256, 2048 / 256, GB, cB); pg8::EpiBf16 E{KV, 2048}; pg8::gemm_phase(lds, g, S, E); }
            if (P3EN(2)) { pg8::Gemm g{UC, (const bf16_t*)(wl + WL_LRU), 1024, 256, 256}; pg8::SchedSplit S; S.init(MT / 256, 16, GA, GB, bx, P3_LRU_A * GA < 512 ? P3_LRU_A * GA : 512, 1);
              pg8::EpiLru E{UC, (const float*)A->in[11] + (size_t)l * 4096, (const float*)(ws + WS_SPT) + (size_t)l * 2048, LAB}; pg8::gemm_phase(lds, g, S, E); }
            if (P3EN(3)) { pg8::Gemm g{H + C_GLR, (const bf16_t*)(wl + WL_G), NINP, 256, 256}; pg8::SchedSplit S; S.init(MT / 256, 12288 / 256, GA, GB, bx, P3_GATE_A * GA < 1536 ? P3_GATE_A * GA : 1536);
              pg8::EpiSig E{GATES, 12288, (const float*)A->in[20] + (size_t)l * 12288}; pg8::gemm_phase(lds, g, S, E); }
            SEAM(s0 + 3);
        }
        if (EN(4) && IN(s0 + 4)) for (int rep_ = 0; rep_ < NREP(4); ++rep_) { const int tid = opq(tid0), lane = tid & 63; (void)tid; (void)lane; CArgs* A = opq_args(); const int G = opqs(G0), bx = opqs(bx0), gw = opqs(gw0), NGW = G * NWAVES; (void)bx; (void)gw; (void)NGW;
            const float* gq = (const float*)A->in[17] + l * 192; const float* gk = (const float*)A->in[18] + l * 192;
            const int half = lane >> 5, j = lane & 31; const bool act = j < 24; const int jj = act ? j : 0;
            const bool dry = (NREP(4) == 2) && (rep_ == 0);
            for (int m = gw; m < MT; m += NGW) {
                u32x4 qraw[4], kraw[4];
                const bf16_t* qrow = QM + (size_t)m * 1536 + half * 192 + 8 * jj; const bf16_t* kvrow = KV + (size_t)m * 2048 + half * 256 + 8 * (jj < 8 ? 0 : jj - 8);
                const u32x4 kpe = *(const u32x4*)(H + (size_t)m * NINP + C_KPE + 8 * (jj & 7));
#pragma unroll
                for (int hp = 0; hp < 4; ++hp) { qraw[hp] = *(const u32x4*)(qrow + hp * 384); kraw[hp] = *(const u32x4*)(kvrow + hp * 512); }
                float cs[8], sn[8];
                { const f32x4 c0 = *(const f32x4*)(cosC + m * 32 + 8 * (jj & 3)), c1 = *(const f32x4*)(cosC + m * 32 + 8 * (jj & 3) + 4), s0_ = *(const f32x4*)(sinC + m * 32 + 8 * (jj & 3)), s1_ = *(const f32x4*)(sinC + m * 32 + 8 * (jj & 3) + 4);
#pragma unroll
                  for (int e = 0; e < 4; ++e) { cs[e] = c0[e]; cs[4 + e] = c1[e]; sn[e] = s0_[e]; sn[4 + e] = s1_[e]; } }
#pragma unroll
                for (int hp = 0; hp < 4; ++hp) {
#pragma unroll
                    for (int qk = 0; qk < 2; ++qk) {
                        float v[8]; unpack8(qk == 0 ? qraw[hp] : (j < 8 ? kpe : kraw[hp]), v);
                        if (!act) {
#pragma unroll
                            for (int e = 0; e < 8; ++e) v[e] = 0.f; }
                        float ss = 0.f;
#pragma unroll
                        for (int e = 0; e < 8; ++e) ss += v[e] * v[e];
#pragma unroll
                        for (int o = 1; o < 32; o <<= 1) ss += __shfl_xor(ss, o);
                        const float rs = rsqrtf(ss * (1.f / 192.f) + EPS);
                        const float* gg = (qk ? gk : gq) + 8 * jj;
#pragma unroll
                        for (int e = 0; e < 8; ++e) v[e] = v[e] * rs * gg[e];
                        float pr[8];
#pragma unroll
                        for (int e = 0; e < 8; ++e) pr[e] = __shfl_xor(v[e], 4);
                        if (j < 8) {
#pragma unroll
                            for (int e = 0; e < 8; ++e) v[e] = (j < 4) ? v[e] * cs[e] - pr[e] * sn[e] : v[e] * cs[e] + pr[e] * sn[e]; }
                        if (qk == 0) {
#pragma unroll
                            for (int e = 0; e < 8; ++e) v[e] *= CM; }
                        if (act) { bf16_t* dst = (dry ? (bf16_t*)TMP + (size_t)qk * MT * 1536 : (qk == 0 ? QM : KM)) + (size_t)m * 1536 + (2 * hp + half) * 192 + 8 * j; *(u32x4*)dst = pack8(v); }
                    }
                }
            }
            for (int it = gw; it < 2048; it += NGW) {
                const int cg = it & 3, k = (it >> 2) & 127, b = (it >> 9) & 1, z = it >> 10, c = 256 * cg + 4 * lane;
                const unsigned* ap = LAB + ((size_t)z * MT + b * SEQ + 32 * k) * 1024 + c;
                f32x4 P = {1.f, 1.f, 1.f, 1.f}, Hh = {0.f, 0.f, 0.f, 0.f};
#pragma unroll 8
                for (int s = 0; s < 32; ++s) { const int t = z ? 31 - s : s; const u32x4 w = *(const u32x4*)(ap + (size_t)t * 1024);
                    const f32x4 a = {1.f - bf_lo(w.x), 1.f - bf_lo(w.y), 1.f - bf_lo(w.z), 1.f - bf_lo(w.w)}, x = {bf_hi(w.x), bf_hi(w.y), bf_hi(w.z), bf_hi(w.w)}; Hh = a * Hh + x; P = P * a; }
                *(f32x4*)(AGP + ((size_t)(z * 2 + b) * 128 + k) * 1024 + c) = P; *(f32x4*)(AGH + ((size_t)(z * 2 + b) * 128 + k) * 1024 + c) = Hh;
            }
            SEAM(s0 + 4);
        }
        if (EN(5) && IN(s0 + 5)) for (int rep_ = 0; rep_ < NREP(5); ++rep_) { const int tid = opq(tid0), lane = tid & 63; (void)tid; (void)lane; CArgs* A = opq_args(); const int G = opqs(G0), bx = opqs(bx0), gw = opqs(gw0), NGW = G * NWAVES; (void)bx; (void)gw; (void)NGW;
            const int r32 = lane & 31, hh = lane >> 5;
            float negA, negC, lam;
            { const float* gq = (const float*)A->in[4] + l * 64; const float* gk = (const float*)A->in[5] + l * 64;
              const float mq = wave_max(fabsf(gq[lane])), mk = wave_max(fabsf(gk[lane]));
              negA = -(8.f * mq * mk * LOG2E * 1.01f);
              const float* gq2 = (const float*)A->in[17] + l * 192; const float* gk2 = (const float*)A->in[18] + l * 192;
              const float mq2 = wave_max(fmaxf(fmaxf(fabsf(gq2[lane]), fabsf(gq2[64 + lane])), fabsf(gq2[128 + lane])));
              const float mk2 = wave_max(fmaxf(fmaxf(fabsf(gk2[lane]), fabsf(gk2[64 + lane])), fabsf(gk2[128 + lane])));
              negC = -(13.856406460551018f * mq2 * mk2 * LOG2E * 1.01f);
              const float* lp = (const float*)A->in[6] + l * 256;
              const float s1 = wave_sum(lp[lane] * lp[64 + lane]), s2 = wave_sum(lp[128 + lane] * lp[192 + lane]);
              lam = expf(s1) - expf(s2) + (0.8f - 0.6f * expf(-0.3f * (float)l)); }
            const int cls = (bx >> 3) & 3;
            if (cls == 0) { asm volatile("s_waitcnt vmcnt(0) lgkmcnt(0)" ::: "memory"); __syncthreads(); { const int tidc = opq(tid0); CArgs* Ac = opq_args(); conv_layer(Ac, lds, wave, l, 1, tidc, tidc & 63, opqs(G0), opqs(bx0), opqs(gw0), opqs(G0) * NWAVES); if (l + 1 < DEPTH) conv_layer(Ac, lds, wave, l + 1, 0, tidc, tidc & 63, opqs(G0), opqs(bx0), opqs(gw0), opqs(G0) * NWAVES); } asm volatile("s_waitcnt vmcnt(0) lgkmcnt(0)" ::: "memory"); __syncthreads(); }
            for (int u = bx; u < 256; u += G) {
                const int jj = u >> 3, bh = 2 * (u & 7) + (jj >> 4), qb = jj & 15, b = bh >> 3, h = bh & 7;
                const size_t row0 = (size_t)b * SEQ + qb * 256, krow0 = (size_t)b * SEQ;
                f32x16 o[4];
                if (P5EN(0)) for (int n4_ = 0; n4_ < ((P5DUP & 1) ? 4 : 2); ++n4_) { const int n = n4_ & 1;
                    if (n4_ == 1) { if (cls == 1) { asm volatile("s_waitcnt vmcnt(0) lgkmcnt(0)" ::: "memory"); __syncthreads(); { const int tidc = opq(tid0); CArgs* Ac = opq_args(); conv_layer(Ac, lds, wave, l, 1, tidc, tidc & 63, opqs(G0), opqs(bx0), opqs(gw0), opqs(G0) * NWAVES); if (l + 1 < DEPTH) conv_layer(Ac, lds, wave, l + 1, 0, tidc, tidc & 63, opqs(G0), opqs(bx0), opqs(gw0), opqs(G0) * NWAVES); } asm volatile("s_waitcnt vmcnt(0) lgkmcnt(0)" ::: "memory"); __syncthreads(); } }
                    att::attn_body_dma<1>(H + row0 * NINP + C_AQ + h * 128 + n * 64, NINP, H + krow0 * NINP + C_AK + h * 128 + n * 64, NINP, H + krow0 * NINP + C_AV + h * 128, NINP, negA, (LAS char*)lds, o);
                    { const int le = opq(lane), r32e = le & 31, hhe = le >> 5;
                      float* dbase = DBUF + (row0 + wave * 32 + 4 * hhe) * 1024 + h * 128 + r32e;
                      if (n == 0) {
#pragma unroll
                          for (int r = 0; r < 16; ++r) { float* dp = dbase + ((r & 3) + 8 * (r >> 2)) * 1024;
#pragma unroll
                              for (int d0 = 0; d0 < 4; ++d0) dp[d0 * 32] = o[d0][r]; }
                      } else {
                          const float* sg = (const float*)A->in[7] + l * 128 + r32e; const float omli = 1.f - (0.8f - 0.6f * expf(-0.3f * (float)l));
                          const float g0 = sg[0] * omli, g1 = sg[32] * omli, g2 = sg[64] * omli, g3 = sg[96] * omli;
                          bf16_t* obase = OCAT + (row0 + wave * 32 + 4 * hhe) * 3072 + h * 128 + r32e;
#pragma unroll
                          for (int r = 0; r < 16; ++r) { const float* dp = dbase + ((r & 3) + 8 * (r >> 2)) * 1024;
                              const float e0 = dp[0] - lam * o[0][r], e1 = dp[32] - lam * o[1][r], e2 = dp[64] - lam * o[2][r], e3 = dp[96] - lam * o[3][r];
                              float ss = (e0 * e0 + e1 * e1) + (e2 * e2 + e3 * e3);
#pragma unroll
                              for (int of = 1; of < 32; of <<= 1) ss += __shfl_xor(ss, of);
                              const float rs = rsqrtf(ss * (1.f / 128.f) + EPS);
                              bf16_t* op = obase + ((r & 3) + 8 * (r >> 2)) * 3072;
                              op[0] = (bf16_t)f2bf(e0 * rs * g0); op[32] = (bf16_t)f2bf(e1 * rs * g1); op[64] = (bf16_t)f2bf(e2 * rs * g2); op[96] = (bf16_t)f2bf(e3 * rs * g3); }
                      } }
                }
                if (cls == 2) { asm volatile("s_waitcnt vmcnt(0) lgkmcnt(0)" ::: "memory"); __syncthreads(); { const int tidc = opq(tid0); CArgs* Ac = opq_args(); conv_layer(Ac, lds, wave, l, 1, tidc, tidc & 63, opqs(G0), opqs(bx0), opqs(gw0), opqs(G0) * NWAVES); if (l + 1 < DEPTH) conv_layer(Ac, lds, wave, l + 1, 0, tidc, tidc & 63, opqs(G0), opqs(bx0), opqs(gw0), opqs(G0) * NWAVES); } asm volatile("s_waitcnt vmcnt(0) lgkmcnt(0)" ::: "memory"); __syncthreads(); }
                for (int r5_ = 0; r5_ < ((P5DUP & 2) ? 2 : 1); ++r5_) {
                if (P5EN(1)) att::attn_body_dma<3>(QM + row0 * 1536 + h * 192, 1536, KM + krow0 * 1536 + h * 192, 1536, KV + krow0 * 2048 + h * 256 + 128, 2048, negC, (LAS char*)lds, o);
                if (P5EN(1)) { const int le = opq(lane), r32e = le & 31, hhe = le >> 5;
                  bf16_t* obase = OCAT + (row0 + wave * 32 + 4 * hhe) * 3072 + 2048 + h * 128 + r32e;
#pragma unroll
                  for (int r = 0; r < 16; ++r) { bf16_t* op = obase + ((r & 3) + 8 * (r >> 2)) * 3072;
#pragma unroll
                      for (int d0 = 0; d0 < 4; ++d0) op[d0 * 32] = (bf16_t)f2bf(o[d0][r]); } }
                }
            }
            if (cls == 3) { asm volatile("s_waitcnt vmcnt(0) lgkmcnt(0)" ::: "memory"); __syncthreads(); { const int tidc = opq(tid0); CArgs* Ac = opq_args(); conv_layer(Ac, lds, wave, l, 1, tidc, tidc & 63, opqs(G0), opqs(bx0), opqs(gw0), opqs(G0) * NWAVES); if (l + 1 < DEPTH) conv_layer(Ac, lds, wave, l + 1, 0, tidc, tidc & 63, opqs(G0), opqs(bx0), opqs(gw0), opqs(G0) * NWAVES); } asm volatile("s_waitcnt vmcnt(0) lgkmcnt(0)" ::: "memory"); __syncthreads(); }
            for (int r6_ = 0; r6_ < ((P5DUP & 4) ? 2 : 1); ++r6_)
            for (int it = gw; it < 4096; it += NGW) {
                const int cgp = it & 15, k = (it >> 4) & 127, b = it >> 11, c = 64 * cgp + lane;
                float cf = 0.f, cbk = 0.f;
                { const float* Pf = AGP + ((size_t)(0 * 2 + b) * 128) * 1024 + c; const float* Hf = AGH + ((size_t)(0 * 2 + b) * 128) * 1024 + c;
                  for (int j0 = 0; j0 < k; j0 += 32) {
                      float pp[32], hh[32];
#pragma unroll
                      for (int i = 0; i < 32; ++i) { const int j = (j0 + i < k) ? j0 + i : k - 1; pp[i] = Pf[(size_t)j * 1024]; hh[i] = Hf[(size_t)j * 1024]; }
#pragma unroll
                      for (int i = 0; i < 32; ++i) if (j0 + i < k) cf = pp[i] * cf + hh[i];
                  }
                  const float* Pb = AGP + ((size_t)(1 * 2 + b) * 128) * 1024 + c; const float* Hb = AGH + ((size_t)(1 * 2 + b) * 128) * 1024 + c;
                  for (int j0 = 127; j0 > k; j0 -= 32) {
                      float pp[32], hh[32];
#pragma unroll
                      for (int i = 0; i < 32; ++i) { const int j = (j0 - i > k) ? j0 - i : k + 1; pp[i] = Pb[(size_t)j * 1024]; hh[i] = Hb[(size_t)j * 1024]; }
#pragma unroll
                      for (int i = 0; i < 32; ++i) if (j0 - i > k) cbk = pp[i] * cbk + hh[i];
                  } }
                const size_t m0 = (size_t)b * SEQ + 32 * k;
                float hb[32]; float hcur = cbk;
#pragma unroll
                for (int s = 31; s >= 0; --s) { const unsigned w = LAB[((size_t)MT + m0 + s) * 1024 + c]; hcur = (1.f - bf_lo(w)) * hcur + bf_hi(w); hb[s] = hcur; }
                hcur = cf;
#pragma unroll
                for (int hf = 0; hf < 2; ++hf) {
                    float fa[16], fx[16], fg[16];
#pragma unroll
                    for (int s = 0; s < 16; ++s) { const size_t mm = m0 + 16 * hf + s; { const unsigned w = LAB[mm * 1024 + c]; fa[s] = 1.f - bf_lo(w); fx[s] = bf_hi(w); } fg[s] = bf2f(H[mm * NINP + C_BG + c]); }
#pragma unroll
                    for (int s = 0; s < 16; ++s) { hcur = fa[s] * hcur + fx[s];
                        OCAT[(m0 + 16 * hf + s) * 3072 + 1024 + c] = (bf16_t)f2bf((hcur + hb[16 * hf + s]) * gelu_tanh(fg[s])); }
                }
            }

            SEAM(s0 + 5);
        }
        if (EN(6) && IN(s0 + 6)) for (int rep_ = 0; rep_ < NREP(6); ++rep_) { const int tid = opq(tid0), lane = tid & 63; (void)tid; (void)lane; CArgs* A = opq_args(); const int G = opqs(G0), bx = opqs(bx0), gw = opqs(gw0), NGW = G * NWAVES; (void)bx; (void)gw; (void)NGW;
        }
        if (EN(7) && IN(s0 + 7)) for (int rep_ = 0; rep_ < NREP(7); ++rep_) { const int tid = opq(tid0), lane = tid & 63; (void)tid; (void)lane; CArgs* A = opq_args(); const int G = opqs(G0), bx = opqs(bx0), gw = opqs(gw0), NGW = G * NWAVES; (void)bx; (void)gw; (void)NGW;
            pg8::Gemm g{OCAT, (const bf16_t*)(wl + WL_BO), 3072, 3072, 1024}; pg8::SchedBo S; S.init(MT / 256, DM / 256, G, bx);
            pg8::EpiBo E{GATES, YSUM, F8O(l) ? 1 : 0};
            pg8::gemm_phase(lds, g, S, E);
            SEAM(s0 + 7);
        }
        if (EN(8) && IN(s0 + 8)) for (int rep_ = 0; rep_ < NREP(8); ++rep_) { const int tid = opq(tid0), lane = tid & 63; (void)tid; (void)lane; CArgs* A = opq_args(); const int G = opqs(G0), bx = opqs(bx0), gw = opqs(gw0), NGW = G * NWAVES; (void)bx; (void)gw; (void)NGW;
            pg8::Gemm g{YSUM, (const bf16_t*)(wl + WL_OUT), DM, DM, DM}; pg8::SchedPlain S; S.init(MT / 256, DM / 256, G, bx);
            if (F8O(l)) { pg8::EpiRes E{xcur, ((NREP(8) == 2) && (rep_ == 0)) ? TMP : out, W8_INV}; pg8::gemm_phase<pg8::EpiRes, pg8::SchedPlain, 1>(lds, g, S, E); }
            else { pg8::EpiRes E{xcur, ((NREP(8) == 2) && (rep_ == 0)) ? TMP : out, 1.f}; pg8::gemm_phase(lds, g, S, E); }
            SEAM(s0 + 8);
        }
        if (EN(9) && IN(s0 + 9)) for (int rep_ = 0; rep_ < NREP(9); ++rep_) { const int tid = opq(tid0), lane = tid & 63; (void)tid; (void)lane; CArgs* A = opq_args(); const int G = opqs(G0), bx = opqs(bx0), gw = opqs(gw0), NGW = G * NWAVES; (void)bx; (void)gw; (void)NGW;
            const float* g = (const float*)A->in[23] + (size_t)l * DM;
            for (int m = gw; m < MT; m += NGW) {
                const f32x4* xr = (const f32x4*)(out + (size_t)m * DM) + lane;
                f32x4 v[16]; float ss = 0.f;
#pragma unroll
                for (int j = 0; j < 16; ++j) { v[j] = xr[64 * j]; ss += (v[j].x * v[j].x + v[j].y * v[j].y) + (v[j].z * v[j].z + v[j].w * v[j].w); }
                const float rs = rsqrtf(wave_sum(ss) * (1.f / DM) + EPS);
                const f32x4* gr = (const f32x4*)g + lane;
                if (I8U(l)) {
                    float amx = 0.f, ssy = 0.f;
#pragma unroll
                    for (int j = 0; j < 16; ++j) { const f32x4 gg = gr[64 * j]; v[j].x = v[j].x * rs * gg.x; v[j].y = v[j].y * rs * gg.y; v[j].z = v[j].z * rs * gg.z; v[j].w = v[j].w * rs * gg.w;
                        ssy += (v[j].x * v[j].x + v[j].y * v[j].y) + (v[j].z * v[j].z + v[j].w * v[j].w);
                        amx = fmaxf(fmaxf(amx, fmaxf(fabsf(v[j].x), fabsf(v[j].y))), fmaxf(fabsf(v[j].z), fabsf(v[j].w))); }
                    amx = wave_max(amx); const float clipv = fminf(amx, 4.2f * sqrtf(wave_sum(ssy) * (1.f / DM)));
                    const float sc = (clipv > 0.f) ? clipv * (1.f / 127.f) : 1.f, inv = 1.f / sc;
                    unsigned* o4 = (unsigned*)((unsigned char*)XN + (size_t)m * DM) + lane;
#pragma unroll
                    for (int j = 0; j < 16; ++j) o4[64 * j] = pk_i8x4(v[j].x * inv, v[j].y * inv, v[j].z * inv, v[j].w * inv);
                    if (lane == 0) ((float*)(ws + WS_XS))[m] = sc; }
                else if (F8U(l)) { unsigned* o4 = (unsigned*)((unsigned char*)XN + (size_t)m * DM) + lane;
#pragma unroll
                    for (int j = 0; j < 16; ++j) { const f32x4 gg = gr[64 * j]; o4[64 * j] = pk_fp8x4(v[j].x * rs * gg.x, v[j].y * rs * gg.y, v[j].z * rs * gg.z, v[j].w * rs * gg.w); } }
                else { u32x2* o8 = (u32x2*)(XN + (size_t)m * DM) + lane;
#pragma unroll
                    for (int j = 0; j < 16; ++j) { const f32x4 gg = gr[64 * j]; u32x2 w; w.x = pk2(v[j].x * rs * gg.x, v[j].y * rs * gg.y); w.y = pk2(v[j].z * rs * gg.z, v[j].w * rs * gg.w); o8[64 * j] = w; } }
            }
            SEAM(s0 + 9);
        }
        if (EN(10) && IN(s0 + 10)) for (int rep_ = 0; rep_ < NREP(10); ++rep_) { const int tid = opq(tid0), lane = tid & 63; (void)tid; (void)lane; CArgs* A = opq_args(); const int G = opqs(G0), bx = opqs(bx0), gw = opqs(gw0), NGW = G * NWAVES; (void)bx; (void)gw; (void)NGW;
            pg8::Gemm g{XN, (const bf16_t*)(wl + WL_GU), DM, DM, DM}; pg8::SchedPlain S; S.init(MT / 256, 2 * FFH / 256, G, bx);
            if (I8U(l)) { pg8::EpiSwigluI8 E{(void*)HID, (const float*)(ws + WS_XS), (const float*)(ws + WS_WSC) + 2 * l, F8L(l) ? 1 : 0}; pg8::gemm_phase<pg8::EpiSwigluI8, pg8::SchedPlain, 2>(lds, g, S, E); }
            else if (F8U(l)) { pg8::EpiSwiglu<true> E{(void*)HID, W8_INV}; pg8::gemm_phase<pg8::EpiSwiglu<true>, pg8::SchedPlain, 1>(lds, g, S, E); }
            else if (F8L(l)) { pg8::EpiSwiglu<true> E{(void*)HID, 1.f}; pg8::gemm_phase(lds, g, S, E); }
            else { pg8::EpiSwiglu<false> E{(void*)HID, 1.f}; pg8::gemm_phase(lds, g, S, E); }
            SEAM(s0 + 10);
        }
        if (EN(11) && IN(s0 + 11)) for (int rep_ = 0; rep_ < NREP(11); ++rep_) { const int tid = opq(tid0), lane = tid & 63; (void)tid; (void)lane; CArgs* A = opq_args(); const int G = opqs(G0), bx = opqs(bx0), gw = opqs(gw0), NGW = G * NWAVES; (void)bx; (void)gw; (void)NGW;
            pg8::Gemm g{HID, (const bf16_t*)(wl + WL_DN), FFH, FFH, FFH}; pg8::SchedPlain S; S.init(MT / 256, DM / 256, G, bx);
            const bool dry11 = (NREP(11) == 2) && (rep_ == 0);
            if (F8L(l)) { pg8::EpiRes E{(const float*)out, dry11 ? TMP : out, W8_INV}; pg8::gemm_phase<pg8::EpiRes, pg8::SchedPlain, 1>(lds, g, S, E); }
            else { pg8::EpiRes E{(const float*)out, dry11 ? TMP : out, 1.f}; pg8::gemm_phase<pg8::EpiRes, pg8::SchedPlain, 0>(lds, g, S, E); }
            SEAM(s0 + 11);
        }
    }
#undef IN
#undef SEAM
#undef cosA
#undef sinA
#undef cosC
#undef sinC
#undef XN
#undef H
#undef UC
#undef QM
#undef KV
#undef KM
#undef LAB
#undef AGP
#undef AGH
#undef GATES
#undef DBUF
#undef OCAT
#undef TMP
#undef YSUM
#undef HID
#undef x_in
#undef out
#undef ws
#undef wl
#undef xcur
}


#ifdef PROBE_S
__global__ void probe_dump(const unsigned char* ws_, float* outp) {
    for (size_t i = (size_t)blockIdx.x * 256 + threadIdx.x; i < (size_t)MT * DM; i += (size_t)gridDim.x * 256) {
        const size_t m = i / DM, c = i % DM; float v = 0.f;
        const bf16_t* Hh = (const bf16_t*)(ws_ + WS_H); v += bf2f(Hh[m * NINP + c]) + bf2f(Hh[m * NINP + 2816 + c]);
        v += bf2f(((const bf16_t*)(ws_ + WS_UC))[m * 1024 + (c & 1023)]);
        v += bf2f(((const bf16_t*)(ws_ + WS_QM))[m * 1536 + (c % 1536)]) + bf2f(((const bf16_t*)(ws_ + WS_KM))[m * 1536 + (c % 1536)]) + bf2f(((const bf16_t*)(ws_ + WS_KV))[m * 2048 + (c & 2047)]);
        v += bf_hi(((const unsigned*)(ws_ + WS_LAB))[m * 1024 + (c & 1023)]) + bf_hi(((const unsigned*)(ws_ + WS_LAB))[((size_t)MT + m) * 1024 + (c & 1023)]);
        v += ((const float*)(ws_ + WS_AGP))[i % (2 * 2 * 128 * 1024)] + ((const float*)(ws_ + WS_AGH))[i % (2 * 2 * 128 * 1024)];
        const bf16_t* Gg = (const bf16_t*)(ws_ + WS_GATES); v += bf2f(Gg[m * 12288 + c]) + bf2f(Gg[m * 12288 + 4096 + c]) + bf2f(Gg[m * 12288 + 8192 + c]);
#if PROBE_S >= 7
        v += ((const float*)(ws_ + WS_DBUF))[m * 1024 + (c & 1023)];
        v += bf2f(((const bf16_t*)(ws_ + WS_OCAT))[m * 3072 + 2048 + (c & 1023)]);
#endif
#if PROBE_S >= 8
        v += bf2f(((const bf16_t*)(ws_ + WS_OCAT))[m * 3072 + (c % 3072)]);
#endif
#if PROBE_S >= 9
        v += bf2f(((const bf16_t*)(ws_ + WS_YSUM))[m * DM + c]);
#endif
        outp[i] = v;
    }
}
#endif

extern "C" void kernel_launch(void* const* d_in, const int* in_sizes, int n_in, void* d_out, int out_size, void* d_ws, size_t ws_size, hipStream_t stream) {
    static int grid = 0;
    if (grid == 0) {
        if (n_in != 27 || out_size != MT * DM || ws_size < WS_END) { fprintf(stderr, "kernel_launch: shape mismatch: n_in %d out %d ws %zu (need %zu)\n", n_in, out_size, ws_size, (size_t)WS_END); grid = -1; return; }
        int dev = 0, cus = 0, per_cu = 0;
        if (hipGetDevice(&dev) != hipSuccess || hipDeviceGetAttribute(&cus, hipDeviceAttributeMultiprocessorCount, dev) != hipSuccess) { grid = -1; return; }
        if (hipFuncSetAttribute((const void*)fwd, hipFuncAttributeMaxDynamicSharedMemorySize, LDS_BYTES) != hipSuccess) { fprintf(stderr, "kernel_launch: hipFuncSetAttribute failed\n"); grid = -1; return; }
        if (hipOccupancyMaxActiveBlocksPerMultiprocessor(&per_cu, (const void*)fwd, NWAVES * 64, LDS_BYTES) != hipSuccess || per_cu < 1) { fprintf(stderr, "kernel_launch: occupancy query says %d\n", per_cu); }
        (void)hipGetLastError();
        grid = cus;
    }
    if (grid < 0) return;
    if (hipMemsetAsync((char*)d_ws + WS_CTL, 0, CTL_BYTES, stream) != hipSuccess) return;
    Args a{};
    for (int i = 0; i < 27; ++i) a.in[i] = d_in[i];
    a.out = (float*)d_out; a.ws = (unsigned char*)d_ws;
#if MK_ONE_LAUNCH
    a.step_lo = 0; a.step_hi = NSTEP;
    hipLaunchKernelGGL(fwd, dim3(grid), dim3(NWAVES * 64), LDS_BYTES, stream, a);
#else
#ifdef PROBE_S
    for (int s = 0; s < PROBE_S; ++s) { a.step_lo = s; a.step_hi = s + 1; hipLaunchKernelGGL(fwd, dim3(grid), dim3(NWAVES * 64), LDS_BYTES, stream, a); }
    hipLaunchKernelGGL(probe_dump, dim3(2048), dim3(256), 0, stream, (const unsigned char*)d_ws, (float*)d_out);
#else
    for (int s = 0; s < NSTEP; ++s) { a.step_lo = s; a.step_hi = s + 1; hipLaunchKernelGGL(fwd, dim3(grid), dim3(NWAVES * 64), LDS_BYTES, stream, a); }
#endif
#endif
    const hipError_t le = hipPeekAtLastError();
    if (le != hipSuccess) fprintf(stderr, "kernel_launch: launch failed: %s\n", hipGetErrorName(le));
}
```

```cpp
#include <hip/hip_runtime.h>
#include <cstdio>
#include <cstdint>

#ifndef P3_LRU_A
#define P3_LRU_A 1
#endif
#ifndef P3_GATE_A
#define P3_GATE_A 7
#endif
#ifndef P5DUP
#define P5DUP 0
#endif
#ifndef F8_LAYERS
#define F8_LAYERS 0xC
#endif
#define F8L(l) ((((F8_LAYERS) >> (l)) & 1) != 0)
#ifndef F8UP_LAYERS
#define F8UP_LAYERS 0x8
#endif
#ifndef I8UP_LAYERS
#define I8UP_LAYERS 0xF
#endif
#define I8U(l) ((((I8UP_LAYERS) >> (l)) & 1) != 0)
#ifndef I8IN_LAYERS
#define I8IN_LAYERS 0x8
#endif
#define I8N(l) ((((I8IN_LAYERS) >> (l)) & 1) != 0)
#define F8U(l) ((((F8UP_LAYERS) & (F8_LAYERS) & ~(I8UP_LAYERS)) >> (l)) & 1)
#ifndef F8OUT_LAYERS
#define F8OUT_LAYERS 0x0
#endif
#define F8O(l) ((((F8OUT_LAYERS) >> (l)) & 1) != 0)
#ifndef MK_ONE_LAUNCH
#define MK_ONE_LAUNCH 1
#endif

#define LAS __attribute__((address_space(3)))
#define GAS __attribute__((address_space(1)))
typedef unsigned short bf16_t;
typedef short bf16x8 __attribute__((ext_vector_type(8)));
typedef short s16x4 __attribute__((ext_vector_type(4)));
typedef float f32x2 __attribute__((ext_vector_type(2)));
typedef float f32x4 __attribute__((ext_vector_type(4)));
typedef float f32x16 __attribute__((ext_vector_type(16)));
typedef unsigned u32x2 __attribute__((ext_vector_type(2)));
typedef unsigned u32x4 __attribute__((ext_vector_type(4)));
typedef GAS unsigned gu32;

constexpr int DM = 4096, BATCH = 2, SEQ = 4096, MT = BATCH * SEQ, DEPTH = 4;
constexpr int NIN = 6720, NINP = 6912, FFH = 11008;
constexpr int C_AQ = 0, C_AK = 1024, C_AV = 2048, C_BG = 3072, C_BX = 4096, C_CQ = 5120, C_CKV = 5888, C_KPE = 6400, C_GLR = 6464;
constexpr float EPS = 1e-6f;
constexpr float LOG2E = 1.4426950408889634f;
constexpr float CA = 0.125f * LOG2E;
constexpr float CM = 0.07216878364870323f * LOG2E;
constexpr int NSTEP = 1 + 12 * DEPTH;

constexpr size_t WS_CTL = 0, CTL_BYTES = 1u << 20;
constexpr size_t WS_COSA = CTL_BYTES;
constexpr size_t WS_SINA = WS_COSA + (size_t)MT * 8 * 4;
constexpr size_t WS_COSC = WS_SINA + (size_t)MT * 8 * 4;
constexpr size_t WS_SINC = WS_COSC + (size_t)MT * 32 * 4;
constexpr size_t WS_SPT  = WS_SINC + (size_t)MT * 32 * 4;
constexpr size_t WS_XS   = WS_SPT  + (size_t)DEPTH * 2048 * 4;
constexpr size_t WS_WSC  = WS_XS   + (size_t)MT * 4;
constexpr size_t WS_XN   = WS_WSC  + 256;
constexpr size_t WS_H    = WS_XN   + (size_t)MT * DM * 2;
constexpr size_t WS_UC   = WS_H    + (size_t)MT * NINP * 2;
constexpr size_t WS_QM   = WS_UC   + (size_t)MT * 1024 * 2;
constexpr size_t WS_KV   = WS_QM   + (size_t)MT * 1536 * 2;
constexpr size_t WS_KM   = WS_KV   + (size_t)MT * 2048 * 2;
constexpr size_t WS_LAB  = WS_KM   + (size_t)MT * 1536 * 2;
constexpr size_t WS_AGP  = WS_LAB  + (size_t)2 * MT * 1024 * 4;
constexpr size_t WS_AGH  = WS_AGP  + (size_t)2 * 2 * 128 * 1024 * 4;
constexpr size_t WS_GATES= WS_AGH  + (size_t)2 * 2 * 128 * 1024 * 4;
constexpr size_t WS_DBUF = WS_GATES+ (size_t)MT * 12288 * 2;
constexpr size_t WS_OCAT = WS_DBUF + (size_t)MT * 1024 * 4;
constexpr size_t WS_TMP  = WS_OCAT + (size_t)MT * 3072 * 2;
constexpr size_t WS_YSUM = WS_TMP  + (size_t)MT * DM * 4;
constexpr size_t WS_HID  = WS_YSUM + (size_t)MT * DM * 2;
constexpr size_t WS_W    = WS_HID  + (size_t)MT * FFH * 2;
constexpr size_t WL_IN = 0;
constexpr size_t WL_UQ = WL_IN + (size_t)NINP * DM * 2;
constexpr size_t WL_UKV= WL_UQ + (size_t)1536 * 768 * 2;
constexpr size_t WL_LRU= WL_UKV+ (size_t)2048 * 512 * 2;
constexpr size_t WL_G  = WL_LRU+ (size_t)4096 * 256 * 2;
constexpr size_t WL_BO = WL_G  + (size_t)12288 * 256 * 2;
constexpr size_t WL_OUT= WL_BO + (size_t)4096 * 3072 * 2;
constexpr size_t WL_GU = WL_OUT+ (size_t)4096 * 4096 * 2;
constexpr size_t WL_DN = WL_GU + (size_t)22016 * 4096 * 2;
constexpr size_t WL_SIZE = WL_DN + (size_t)4096 * FFH * 2;
constexpr size_t WS_END = WS_W + DEPTH * WL_SIZE;
static_assert(WS_XN % 256 == 0 && WS_W % 256 == 0 && WL_SIZE % 256 == 0, "alignment");

constexpr int CW_TMO = 0, CW_BAR = 4096;

constexpr int RING_BYTES = 131072, ATT_BYTES = 141312  , LDSCTL_OFF = ATT_BYTES, MISC_OFF = LDSCTL_OFF + 320, LDS_BYTES = 147456;
constexpr int NWAVES = 8;

__device__ __forceinline__ unsigned f2bf(float f) { unsigned u = __builtin_bit_cast(unsigned, f); return (u + 0x7fffu + ((u >> 16) & 1u)) >> 16; }
__device__ __forceinline__ unsigned pk2(float lo, float hi) { return f2bf(lo) | (f2bf(hi) << 16); }
typedef __bf16 bf16x2_t __attribute__((ext_vector_type(2)));
__device__ __forceinline__ unsigned cvt_pk_bf16(float lo, float hi) { f32x2 v = {lo, hi}; bf16x2_t b = __builtin_convertvector(v, bf16x2_t); return __builtin_bit_cast(unsigned, b); }
__device__ __forceinline__ float bf_lo(unsigned w) { return __builtin_bit_cast(float, w << 16); }
__device__ __forceinline__ float bf_hi(unsigned w) { return __builtin_bit_cast(float, w & 0xffff0000u); }
__device__ __forceinline__ float bf2f(bf16_t b) { return __builtin_bit_cast(float, (unsigned)b << 16); }
__device__ __forceinline__ void unpack8(u32x4 w, float* v) { v[0] = bf_lo(w.x); v[1] = bf_hi(w.x); v[2] = bf_lo(w.y); v[3] = bf_hi(w.y); v[4] = bf_lo(w.z); v[5] = bf_hi(w.z); v[6] = bf_lo(w.w); v[7] = bf_hi(w.w); }
__device__ __forceinline__ u32x4 pack8(const float* v) { u32x4 w; w.x = pk2(v[0], v[1]); w.y = pk2(v[2], v[3]); w.z = pk2(v[4], v[5]); w.w = pk2(v[6], v[7]); return w; }
__device__ __forceinline__ float wave_sum(float v) {
#pragma unroll
    for (int o = 1; o < 64; o <<= 1) v += __shfl_xor(v, o);
    return v;
}
__device__ __forceinline__ float wave_max(float v) {
#pragma unroll
    for (int o = 1; o < 64; o <<= 1) v = fmaxf(v, __shfl_xor(v, o));
    return v;
}
__device__ __forceinline__ float sigmoidf_(float x) { return __builtin_amdgcn_rcpf(1.f + __builtin_amdgcn_exp2f(-1.4426950408889634f * x)); }
__device__ __forceinline__ float gelu_tanh(float x) { const float y = 0.7978845608028654f * (x + 0.044715f * x * x * x); const float t = 1.f - 2.f / (__expf(2.f * y) + 1.f); return 0.5f * x * (1.f + t); }
__device__ __forceinline__ int opq(int x) { asm volatile("" : "+v"(x)); return x; }
__device__ __forceinline__ int opqs(int x) { asm volatile("" : "+s"(x)); return x; }
__device__ __forceinline__ float clamp_f8(float x) { return __builtin_amdgcn_fmed3f(x, -448.f, 448.f); }
__device__ __forceinline__ unsigned pk_fp8x4(float a, float b, float c, float d) { int w = 0; w = __builtin_amdgcn_cvt_pk_fp8_f32(clamp_f8(a), clamp_f8(b), w, false); w = __builtin_amdgcn_cvt_pk_fp8_f32(clamp_f8(c), clamp_f8(d), w, true); return (unsigned)w; }
__device__ __forceinline__ unsigned q8(float x) { return (unsigned)(int)__builtin_amdgcn_fmed3f(__builtin_rintf(x), -127.f, 127.f) & 0xffu; }
__device__ __forceinline__ unsigned pk_i8x4(float a, float b, float c, float d) { return q8(a) | (q8(b) << 8) | (q8(c) << 16) | (q8(d) << 24); }
constexpr float W8_SCALE = 64.f, W8_INV = 1.f / 64.f;
#define LDS_WAIT() asm volatile("s_waitcnt lgkmcnt(0)" ::: "memory")

namespace pg8 {
constexpr int BM = 256, BK = 64, HALF = 128, HTB = HALF * BK * 2, NXCD = 8, WGM = 8;
__host__ __device__ __forceinline__ int lds_byte(int r, int c) { const int st = (r >> 4) * 2 + (c >> 5), rr = r & 15, cc = c & 31, ob = rr * 64 + cc * 2; return st * 1024 + (ob ^ (((ob >> 9) & 1) << 5)); }
__host__ __device__ __forceinline__ void stage_rc(int b, int& R, int& C) { const int st = b / 1024, sb = b % 1024, swz = sb ^ (((sb >> 9) & 1) << 5); R = (st >> 1) * 16 + swz / 64; C = (st & 1) * 32 + (swz % 64) / 2; }
__host__ __device__ __forceinline__ int perm32(int rho) { const int n = rho >> 4, i = rho & 15; return 8 * (i >> 2) + 4 * n + (i & 3); }

struct Unit { int pm, pn, ka, kb, aux; };
struct Gemm { const bf16_t* A; const bf16_t* Bt; int lda, ldb, K; };

struct TileOrder {
    int nM, nN, nwg;
    __device__ __forceinline__ void init(int nM_, int nN_) { nM = nM_; nN = nN_; nwg = nM * nN; }
    __device__ __forceinline__ void tile(int L, int& pm, int& pn) const {
        int wgid = L; { const int q = nwg / NXCD, r = nwg % NXCD, xcd = wgid % NXCD, off = wgid / NXCD; wgid = (xcd < r ? xcd * (q + 1) : r * (q + 1) + (xcd - r) * q) + off; }
        const int nig = WGM * nN, gid = wgid / nig, fm = gid * WGM, gsz = (nM - fm) < WGM ? (nM - fm) : WGM;
        pm = fm + ((wgid % nig) % gsz); pn = (wgid % nig) / gsz;
    }
};
struct SchedPlain {
    TileOrder T; int G, c, sk0, skn;
    __device__ __forceinline__ void init(int nM, int nN, int G_, int c_, int sk0_ = 1 << 30, int skn_ = 0) { T.init(nM, nN); G = G_; c = c_; sk0 = sk0_; skn = skn_; }
    __device__ __forceinline__ bool next(int i, Unit& u) const { if (c < 0) return false; const long L = (long)i * G + c; if (L >= T.nwg) return false; T.tile((int)L, u.pm, u.pn); if (u.pn >= sk0) u.pn += skn; u.ka = 0; u.kb = 0; u.aux = 0; return true; }
};
struct SchedSplit {
    TileOrder T; int GA, GB, c, n0, lru;
    __device__ __forceinline__ void init(int nM, int nN, int GA_, int GB_, int c_, int n0_, int lru_ = 0) { T.init(nM, nN); GA = GA_; GB = GB_; c = c_; n0 = n0_; lru = lru_; }
    __device__ __forceinline__ bool next(int i, Unit& u) const { const bool a = c < GA; const long L = a ? (long)i * GA + c : (long)n0 + (long)i * GB + (c - GA); if (L >= (a ? n0 : T.nwg)) return false;
        T.tile((int)L, u.pm, u.pn); u.ka = lru ? 256 * (u.pn >> 2) : 0; u.kb = 0; u.aux = 0; return true; }
};
struct SchedLru {
    TileOrder T; int G, c;
    __device__ __forceinline__ void init(int nM, int nN, int G_, int c_) { T.init(nM, nN); G = G_; c = c_; }
    __device__ __forceinline__ bool next(int i, Unit& u) const { if (c < 0) return false; const long L = (long)i * G + c; if (L >= T.nwg) return false; T.tile((int)L, u.pm, u.pn); u.ka = 256 * (u.pn >> 2); u.kb = 0; u.aux = 0; return true; }
};
struct SchedBo {
    TileOrder T; int G, c;
    __device__ __forceinline__ void init(int nM, int nN, int G_, int c_) { T.init(nM, nN); G = G_; c = c_; }
    __device__ __forceinline__ bool next(int i, Unit& u) const { const int it = i / 3, n = i - 3 * it; const long L = (long)it * G + c; if (L >= T.nwg) return false; T.tile((int)L, u.pm, u.pn); u.ka = 1024 * n; u.kb = 1024 * n; u.aux = n; return true; }
};

typedef f32x4 Acc[2][2][4][2];

struct EpiBf16 {
    bf16_t* O; int ldc;
    static __device__ __forceinline__ bool keep(const Unit&) { return false; }
    __device__ __forceinline__ void operator()(const Acc& acc, const Unit& u, int wr, int wc, int fr_, int fq_) const {
        const int fr = opq(fr_), fq = opq(fq_);
        const int row0 = u.pm * BM + wr * 64 + fr, col0 = u.pn * BM + wc * 32 + 8 * fq;
#pragma unroll
        for (int ai = 0; ai < 2; ++ai)
#pragma unroll
            for (int m = 0; m < 4; ++m) { bf16_t* rowp = O + (size_t)(row0 + ai * HALF + m * 16) * ldc + col0;
#pragma unroll
                for (int bj = 0; bj < 2; ++bj) { const f32x4 v0 = acc[ai][bj][m][0], v1 = acc[ai][bj][m][1];
                    u32x4 w; w.x = cvt_pk_bf16(v0[0], v0[1]); w.y = cvt_pk_bf16(v0[2], v0[3]); w.z = cvt_pk_bf16(v1[0], v1[1]); w.w = cvt_pk_bf16(v1[2], v1[3]);
                    *(u32x4*)(rowp + bj * HALF) = w; } }
    }
};
struct EpiSig {
    bf16_t* O; int ldc; const float* bias;
    static __device__ __forceinline__ bool keep(const Unit&) { return false; }
    __device__ __forceinline__ void operator()(const Acc& acc, const Unit& u, int wr, int wc, int fr_, int fq_) const {
        const int fr = opq(fr_), fq = opq(fq_);
        const int row0 = u.pm * BM + wr * 64 + fr, col0 = u.pn * BM + wc * 32 + 8 * fq;
#pragma unroll
        for (int bj = 0; bj < 2; ++bj) {
            const f32x4 bv0 = *(const f32x4*)(bias + col0 + bj * HALF), bv1 = *(const f32x4*)(bias + col0 + bj * HALF + 4);
#pragma unroll
            for (int ai = 0; ai < 2; ++ai)
#pragma unroll
                for (int m = 0; m < 4; ++m) { bf16_t* rowp = O + (size_t)(row0 + ai * HALF + m * 16) * ldc + col0 + bj * HALF;
                    f32x4 v0 = acc[ai][bj][m][0] + bv0, v1 = acc[ai][bj][m][1] + bv1;
#pragma unroll
                    for (int i = 0; i < 4; ++i) { v0[i] = sigmoidf_(v0[i]); v1[i] = sigmoidf_(v1[i]); }
                    u32x4 w; w.x = cvt_pk_bf16(v0[0], v0[1]); w.y = cvt_pk_bf16(v0[2], v0[3]); w.z = cvt_pk_bf16(v1[0], v1[1]); w.w = cvt_pk_bf16(v1[2], v1[3]);
                    *(u32x4*)rowp = w; __builtin_amdgcn_sched_barrier(0); } }
    }
};
struct EpiRes {
    const float* Xin; float* Out; float sc;
    static __device__ __forceinline__ bool keep(const Unit&) { return false; }
    __device__ __forceinline__ void operator()(const Acc& acc, const Unit& u, int wr, int wc, int fr_, int fq_) const {
        const int fr = opq(fr_), fq = opq(fq_);
        const int row0 = u.pm * BM + wr * 64 + fr, col0 = u.pn * BM + wc * 32 + 8 * fq;
#pragma unroll
        for (int ai = 0; ai < 2; ++ai)
#pragma unroll
            for (int m = 0; m < 4; ++m) { const size_t off = (size_t)(row0 + ai * HALF + m * 16) * DM + col0;
#pragma unroll
                for (int bj = 0; bj < 2; ++bj) {
                    const f32x4 x0 = *(const f32x4*)(Xin + off + bj * HALF), x1 = *(const f32x4*)(Xin + off + bj * HALF + 4);
                    *(f32x4*)(Out + off + bj * HALF) = x0 + acc[ai][bj][m][0] * sc; *(f32x4*)(Out + off + bj * HALF + 4) = x1 + acc[ai][bj][m][1] * sc; } }
    }
};
template <bool F8OUT> struct EpiSwiglu {
    void* Ov; float sc;
    static __device__ __forceinline__ bool keep(const Unit&) { return false; }
    __device__ __forceinline__ void operator()(const Acc& acc, const Unit& u, int wr, int wc, int fr_, int fq_) const {
        const int fr = opq(fr_), fq = opq(fq_);
        const int row0 = u.pm * BM + wr * 64 + fr, col0 = u.pn * HALF + wc * 32 + 8 * fq;
#pragma unroll
        for (int ai = 0; ai < 2; ++ai)
#pragma unroll
            for (int m = 0; m < 4; ++m) { const size_t eo = (size_t)(row0 + ai * HALF + m * 16) * FFH + col0;
                f32x4 r0, r1;
#pragma unroll
                for (int i = 0; i < 4; ++i) { const float g0 = acc[ai][0][m][0][i] * sc, g1 = acc[ai][0][m][1][i] * sc;
                    r0[i] = g0 * sigmoidf_(g0) * (acc[ai][1][m][0][i] * sc); r1[i] = g1 * sigmoidf_(g1) * (acc[ai][1][m][1][i] * sc); }
                if constexpr (F8OUT) { u32x2 w; w.x = pk_fp8x4(r0[0], r0[1], r0[2], r0[3]); w.y = pk_fp8x4(r1[0], r1[1], r1[2], r1[3]); *(u32x2*)((unsigned char*)Ov + eo) = w; }
                else { u32x4 w; w.x = cvt_pk_bf16(r0[0], r0[1]); w.y = cvt_pk_bf16(r0[2], r0[3]); w.z = cvt_pk_bf16(r1[0], r1[1]); w.w = cvt_pk_bf16(r1[2], r1[3]); *(u32x4*)((bf16_t*)Ov + eo) = w; } }
    }
};
__device__ __forceinline__ float i2f_acc(float bits) { return (float)__builtin_bit_cast(int, bits); }
struct EpiBf16I8 {
    bf16_t* O; int ldc; const float* xs; const float* wsc;
    static __device__ __forceinline__ bool keep(const Unit&) { return false; }
    __device__ __forceinline__ void operator()(const Acc& acc, const Unit& u, int wr, int wc, int fr_, int fq_) const {
        const int fr = opq(fr_), fq = opq(fq_);
        const int row0 = u.pm * BM + wr * 64 + fr, col0 = u.pn * BM + wc * 32 + 8 * fq;
        const float sw = wsc[0]; float rsv[2][4];
#pragma unroll
        for (int ai = 0; ai < 2; ++ai)
#pragma unroll
            for (int m = 0; m < 4; ++m) rsv[ai][m] = xs[row0 + ai * HALF + m * 16] * sw;
#pragma unroll
        for (int ai = 0; ai < 2; ++ai)
#pragma unroll
            for (int m = 0; m < 4; ++m) { bf16_t* rowp = O + (size_t)(row0 + ai * HALF + m * 16) * ldc + col0; const float c = rsv[ai][m];
#pragma unroll
                for (int bj = 0; bj < 2; ++bj) { const f32x4 v0 = acc[ai][bj][m][0], v1 = acc[ai][bj][m][1];
                    u32x4 w; w.x = cvt_pk_bf16(i2f_acc(v0[0]) * c, i2f_acc(v0[1]) * c); w.y = cvt_pk_bf16(i2f_acc(v0[2]) * c, i2f_acc(v0[3]) * c);
                    w.z = cvt_pk_bf16(i2f_acc(v1[0]) * c, i2f_acc(v1[1]) * c); w.w = cvt_pk_bf16(i2f_acc(v1[2]) * c, i2f_acc(v1[3]) * c);
                    *(u32x4*)(rowp + bj * HALF) = w; } }
    }
};
struct EpiSwigluI8 {
    void* Ov; const float* xs; const float* wsc; int f8out;
    static __device__ __forceinline__ bool keep(const Unit&) { return false; }
    __device__ __forceinline__ void operator()(const Acc& acc, const Unit& u, int wr, int wc, int fr_, int fq_) const {
        const int fr = opq(fr_), fq = opq(fq_);
        const int row0 = u.pm * BM + wr * 64 + fr, col0 = u.pn * HALF + wc * 32 + 8 * fq;
        const float sg = wsc[0], su = wsc[1];
        float rsv[2][4];
#pragma unroll
        for (int ai = 0; ai < 2; ++ai)
#pragma unroll
            for (int m = 0; m < 4; ++m) rsv[ai][m] = xs[row0 + ai * HALF + m * 16];
#pragma unroll
        for (int ai = 0; ai < 2; ++ai)
#pragma unroll
            for (int m = 0; m < 4; ++m) { const int row = row0 + ai * HALF + m * 16; const size_t eo = (size_t)row * FFH + col0; const float rsA = rsv[ai][m], cg = rsA * sg, cu = rsA * su;
                f32x4 r0, r1;
#pragma unroll
                for (int i = 0; i < 4; ++i) { const float g0 = i2f_acc(acc[ai][0][m][0][i]) * cg, g1 = i2f_acc(acc[ai][0][m][1][i]) * cg;
                    r0[i] = g0 * sigmoidf_(g0) * (i2f_acc(acc[ai][1][m][0][i]) * cu); r1[i] = g1 * sigmoidf_(g1) * (i2f_acc(acc[ai][1][m][1][i]) * cu); }
                if (f8out) { u32x2 w; w.x = pk_fp8x4(r0[0], r0[1], r0[2], r0[3]); w.y = pk_fp8x4(r1[0], r1[1], r1[2], r1[3]); *(u32x2*)((unsigned char*)Ov + eo) = w; }
                else { u32x4 w; w.x = cvt_pk_bf16(r0[0], r0[1]); w.y = cvt_pk_bf16(r0[2], r0[3]); w.z = cvt_pk_bf16(r1[0], r1[1]); w.w = cvt_pk_bf16(r1[2], r1[3]); *(u32x4*)((bf16_t*)Ov + eo) = w; } }
    }
};
struct EpiBo {
    const bf16_t* gates; bf16_t* ysum; int f8;
    static __device__ __forceinline__ bool keep(const Unit& u) { return u.aux < 2; }
    __device__ __forceinline__ void operator()(Acc& acc, const Unit& u, int wr, int wc, int fr_, int fq_) const {
        const int fr = opq(fr_), fq = opq(fq_);
        const int row0 = u.pm * BM + wr * 64 + fr, col0 = u.pn * BM + wc * 32 + 8 * fq, n = u.aux;
#pragma unroll
        for (int ai = 0; ai < 2; ++ai)
#pragma unroll
            for (int m = 0; m < 4; ++m) { const size_t row = (size_t)(row0 + ai * HALF + m * 16);
#pragma unroll
                for (int bj = 0; bj < 2; ++bj) { const int col = col0 + bj * HALF;
                    const bf16_t* gp = gates + row * 12288 + (size_t)n * 4096 + col;
                    float gn[8]; unpack8(*(const u32x4*)gp, gn);
#pragma unroll
                    for (int i = 0; i < 8; ++i) gn[i] = fmaxf(gn[i], 1e-18f);
                    if (n < 2) { float gd[8]; unpack8(*(const u32x4*)(gp + 4096), gd);
#pragma unroll
                        for (int i = 0; i < 8; ++i) gn[i] *= __builtin_amdgcn_rcpf(fmaxf(gd[i], 1e-18f)); }
                    f32x4 v0 = acc[ai][bj][m][0], v1 = acc[ai][bj][m][1];
#pragma unroll
                    for (int i = 0; i < 4; ++i) { v0[i] *= gn[i]; v1[i] *= gn[4 + i]; }
                    if (n < 2) { acc[ai][bj][m][0] = v0; acc[ai][bj][m][1] = v1; }
                    else { u32x4 w; w.x = cvt_pk_bf16(v0[0], v0[1]); w.y = cvt_pk_bf16(v0[2], v0[3]); w.z = cvt_pk_bf16(v1[0], v1[1]); w.w = cvt_pk_bf16(v1[2], v1[3]);
                        if (f8) { u32x2 w8; w8.x = pk_fp8x4(v0[0], v0[1], v0[2], v0[3]); w8.y = pk_fp8x4(v1[0], v1[1], v1[2], v1[3]); *(u32x2*)((unsigned char*)ysum + row * DM + col) = w8; }
                        else *(u32x4*)(ysum + row * DM + col) = w; } } }
    }
};
struct EpiLru {
    const bf16_t* uc; const float* gb; const float* Lp; unsigned* LAB;
    static __device__ __forceinline__ bool keep(const Unit&) { return false; }
    __device__ __forceinline__ void operator()(const Acc& acc, const Unit& u, int wr, int wc, int fr_, int fq_) const {
        const int fr = opq(fr_), fq = opq(fq_);
        const int row0 = u.pm * BM + wr * 64 + fr;
        const int z = u.pn & 1, nb = u.pn >> 1, ch0 = 128 * nb + 32 * wc + 8 * fq;
#pragma unroll
        for (int n = 0; n < 2; ++n) { const int ch = ch0 + 4 * n;
            const f32x4 br = *(const f32x4*)(gb + (z * 2 + 0) * 1024 + ch), bi = *(const f32x4*)(gb + (z * 2 + 1) * 1024 + ch);
            const f32x4 sp = *(const f32x4*)(Lp + z * 1024 + ch);
            __builtin_amdgcn_sched_barrier(0);
#pragma unroll
            for (int ai = 0; ai < 2; ++ai)
#pragma unroll
                for (int m = 0; m < 4; ++m) { const size_t row = (size_t)(row0 + ai * HALF + m * 16);
                    const u32x2 uw = *(const u32x2*)(uc + row * 1024 + ch);
                    const float uv[4] = {bf_lo(uw.x), bf_hi(uw.x), bf_lo(uw.y), bf_hi(uw.y)};
                    u32x4 w;
#pragma unroll
                    for (int i = 0; i < 4; ++i) { const float r = sigmoidf_(acc[ai][0][m][n][i] + br[i]), ig = sigmoidf_(acc[ai][1][m][n][i] + bi[i]);
                        const float la = r * sp[i], av = __builtin_amdgcn_exp2f(1.4426950408889634f * la);
                        const float t = -la;
                        const float ser = t * (1.f - t * 0.5f * (1.f - t * (1.f / 3.f) * (1.f - t * 0.25f * (1.f - t * 0.2f * (1.f - t * (1.f / 6.f) * (1.f - t * (1.f / 7.f)))))));
                        const float oma = (t < 0.25f) ? ser : (1.f - av);
                        const float bx = __builtin_amdgcn_sqrtf(oma * (1.f + av)) * ig * uv[i];
                        w[i] = cvt_pk_bf16(oma, bx); }
                    *(u32x4*)(LAB + ((size_t)z * MT + row) * 1024 + ch) = w; __builtin_amdgcn_sched_barrier(0); } }
    }
};

typedef int i32x8 __attribute__((ext_vector_type(8)));
typedef int i32x4_ __attribute__((ext_vector_type(4)));
template <class Epi, class Sched, int MODE = 0>
__device__ __forceinline__ void gemm_phase(LAS unsigned char* lds, const Gemm g, const Sched& S, const Epi& E) {
    constexpr bool F8 = (MODE == 1), I8 = (MODE == 2);
    const int tid = opq(threadIdx.x), wid = __builtin_amdgcn_readfirstlane(tid >> 6), lane = tid & 63, wr = wid >> 2, wc = wid & 3, fr = lane & 15, fq = lane >> 4;
    constexpr int EB = (MODE == 0) ? 2 : 1;
    const int K = g.K, nt = K * EB / (BK * 2);
    unsigned voffA[2], voffB[2];
#pragma unroll
    for (int i = 0; i < 2; ++i) { int R, C; stage_rc(tid * 16 + i * 8192, R, C); const int Rb = (R & ~31) + perm32(R & 31);
        voffA[i] = (unsigned)(R * g.lda * EB + C * 2); voffB[i] = (unsigned)(Rb * g.ldb * EB + C * 2); }
    const size_t kstep = (size_t)(BK * 2);
    const size_t hstepA = (size_t)HALF * g.lda * EB, hstepB = (size_t)HALF * g.ldb * EB;
    const unsigned ldsw = (unsigned)wid * 1024u;
    const int aoff = lds_byte(wr * 64 + fr, fq * 8), boff = lds_byte(wc * 32 + fr, fq * 8);
#define PG8_SA(b, h) (((b) * 2 + (h)) * HTB)
#define PG8_SB(b, h) ((4 + (b) * 2 + (h)) * HTB)
#define PG8_STAGE(bufoff, gbase, voff) do { _Pragma("unroll") for (int _i = 0; _i < 2; ++_i) \
        __builtin_amdgcn_global_load_lds((const unsigned*)((const char*)(gbase) + (voff)[_i]), (LAS unsigned*)(lds + (bufoff) + ldsw + _i * 8192), 16, 0, 0); } while (0)
#define PG8_LDA(dst, b, h) do { if constexpr (F8) { _Pragma("unroll") for (int m = 0; m < 4; ++m) { dst##8[m].lo = *(const LAS i32x4_*)(lds + PG8_SA(b, h) + aoff + m * 2048); dst##8[m].hi = *(const LAS i32x4_*)(lds + PG8_SA(b, h) + aoff + m * 2048 + 1024); } } \
    else { _Pragma("unroll") for (int m = 0; m < 4; ++m) _Pragma("unroll") for (int k = 0; k < 2; ++k) dst[m][k] = *(const LAS bf16x8*)(lds + PG8_SA(b, h) + aoff + m * 2048 + k * 1024); } } while (0)
#define PG8_LDB(dst, b, h) do { if constexpr (F8) { _Pragma("unroll") for (int n = 0; n < 2; ++n) { dst##8[n].lo = *(const LAS i32x4_*)(lds + PG8_SB(b, h) + boff + n * 2048); dst##8[n].hi = *(const LAS i32x4_*)(lds + PG8_SB(b, h) + boff + n * 2048 + 1024); } } \
    else { _Pragma("unroll") for (int n = 0; n < 2; ++n) _Pragma("unroll") for (int k = 0; k < 2; ++k) dst[n][k] = *(const LAS bf16x8*)(lds + PG8_SB(b, h) + boff + n * 2048 + k * 1024); } } while (0)
#define PG8_MMA(ai, bj, At, Bt) do { __builtin_amdgcn_s_setprio(1); \
        if constexpr (F8) { _Pragma("unroll") for (int m = 0; m < 4; ++m) _Pragma("unroll") for (int n = 0; n < 2; ++n) \
            asm volatile("v_mfma_f32_16x16x128_f8f6f4 %0, %1, %2, %0" : "+v"(acc[ai][bj][m][n]) : "v"(Bt##8[n]), "v"(At##8[m])); } \
        else if constexpr (I8) { _Pragma("unroll") for (int m = 0; m < 4; ++m) _Pragma("unroll") for (int n = 0; n < 2; ++n) _Pragma("unroll") for (int k = 0; k < 2; ++k) \
            acc[ai][bj][m][n] = __builtin_bit_cast(f32x4, __builtin_amdgcn_mfma_i32_16x16x64_i8(__builtin_bit_cast(i32x4_, Bt[n][k]), __builtin_bit_cast(i32x4_, At[m][k]), __builtin_bit_cast(i32x4_, acc[ai][bj][m][n]), 0, 0, 0)); } \
        else { _Pragma("unroll") for (int m = 0; m < 4; ++m) _Pragma("unroll") for (int n = 0; n < 2; ++n) _Pragma("unroll") for (int k = 0; k < 2; ++k) \
            acc[ai][bj][m][n] = __builtin_amdgcn_mfma_f32_16x16x32_bf16(Bt[n][k], At[m][k], acc[ai][bj][m][n], 0, 0, 0); } \
        __builtin_amdgcn_s_setprio(0); } while (0)
#define PG8_WAIT_V(n) asm volatile("s_waitcnt vmcnt(" #n ")" ::: "memory")
#define PG8_WAIT_L(n) asm volatile("s_waitcnt lgkmcnt(" #n ")" ::: "memory")
#define PG8_BAR __builtin_amdgcn_s_barrier()
#define PG8_SCHED __builtin_amdgcn_sched_barrier(0)
#define PG8_UA(u) ((const char*)g.A + (size_t)(u).pm * 2 * hstepA + (size_t)(u).ka * EB)
#define PG8_UB(u) ((const char*)g.Bt + (size_t)(u).pn * 2 * hstepB + (size_t)(u).kb * EB)
    Unit cur, nxt; int ui = 0;
    if (!S.next(0, cur)) return;
    Acc acc;
#pragma unroll
    for (int a = 0; a < 2; ++a)
#pragma unroll
        for (int b = 0; b < 2; ++b)
#pragma unroll
            for (int m = 0; m < 4; ++m)
#pragma unroll
                for (int n = 0; n < 2; ++n) acc[a][b][m][n] = (f32x4){0.f, 0.f, 0.f, 0.f};
    bf16x8 At[4][2], B0[2][2], B1[2][2];
    i32x8 At8[4], B08[2], B18[2];
    const char* cA = PG8_UA(cur); const char* cB = PG8_UB(cur);
    PG8_STAGE(PG8_SB(0, 0), cB, voffB); PG8_STAGE(PG8_SB(0, 1), cB + hstepB, voffB); PG8_STAGE(PG8_SA(0, 0), cA, voffA); PG8_STAGE(PG8_SA(0, 1), cA + hstepA, voffA);
    if (wr == 1) PG8_BAR;
    PG8_WAIT_V(2); PG8_BAR;
    PG8_STAGE(PG8_SB(1, 0), cB + kstep, voffB); PG8_STAGE(PG8_SA(1, 0), cA + kstep, voffA); PG8_STAGE(PG8_SB(1, 1), cB + hstepB + kstep, voffB);
    PG8_WAIT_V(6); PG8_BAR;
    for (;;) {
        const bool has_next = S.next(ui + 1, nxt);
        const char* nA = has_next ? PG8_UA(nxt) : cA; const char* nB = has_next ? PG8_UB(nxt) : cB;
#pragma nounroll
        for (int t = 0; t < nt; t += 2) {
            const bool last = (t == nt - 2);
            const char* a1 = cA + (size_t)(t + 1) * kstep;
            const char* a2 = last ? nA : cA + (size_t)(t + 2) * kstep; const char* b2 = last ? nB : cB + (size_t)(t + 2) * kstep;
            const char* a3 = a2 + kstep; const char* b3 = b2 + kstep;
            PG8_LDB(B0, 0, 0); PG8_LDB(B1, 0, 1); PG8_SCHED; PG8_LDA(At, 0, 0); PG8_STAGE(PG8_SA(1, 1), a1 + hstepA, voffA);
            PG8_WAIT_V(8); PG8_WAIT_L(0); PG8_BAR; PG8_MMA(0, 0, At, B0); PG8_MMA(0, 1, At, B1); PG8_BAR; PG8_SCHED;
            PG8_LDA(At, 0, 1); PG8_STAGE(PG8_SB(0, 0), b2, voffB); PG8_STAGE(PG8_SB(0, 1), b2 + hstepB, voffB); PG8_STAGE(PG8_SA(0, 0), a2, voffA);
            PG8_WAIT_V(8); PG8_WAIT_L(0); PG8_BAR; PG8_MMA(1, 0, At, B0); PG8_MMA(1, 1, At, B1); PG8_BAR; PG8_SCHED;
            PG8_LDB(B0, 1, 0); PG8_LDB(B1, 1, 1); PG8_SCHED; PG8_LDA(At, 1, 0); PG8_STAGE(PG8_SA(0, 1), a2 + hstepA, voffA);
            PG8_WAIT_V(8); PG8_WAIT_L(0); PG8_BAR; PG8_MMA(0, 0, At, B0); PG8_MMA(0, 1, At, B1); PG8_BAR; PG8_SCHED;
            PG8_LDA(At, 1, 1); PG8_STAGE(PG8_SB(1, 0), b3, voffB); PG8_STAGE(PG8_SB(1, 1), b3 + hstepB, voffB); PG8_STAGE(PG8_SA(1, 0), a3, voffA);
            PG8_WAIT_V(8); PG8_WAIT_L(0); PG8_BAR; PG8_MMA(1, 0, At, B0); PG8_MMA(1, 1, At, B1); PG8_BAR; PG8_SCHED;
        }
        if (wr == 0) PG8_BAR;
        if constexpr (F8) asm volatile("s_nop 15\n\ts_nop 15" ::: "memory");
        E(acc, cur, wr, wc, fr, fq);
        if (!has_next) break;
        if (!Epi::keep(cur)) {
#pragma unroll
        for (int a = 0; a < 2; ++a)
#pragma unroll
            for (int b = 0; b < 2; ++b)
#pragma unroll
                for (int m = 0; m < 4; ++m)
#pragma unroll
                    for (int n = 0; n < 2; ++n) acc[a][b][m][n] = (f32x4){0.f, 0.f, 0.f, 0.f};
        }
        cur = nxt; cA = nA; cB = nB; ++ui;
        if (wr == 1) PG8_BAR;
    }
    PG8_WAIT_V(0);
    PG8_BAR;
#undef PG8_SA
#undef PG8_SB
#undef PG8_STAGE
#undef PG8_LDA
#undef PG8_LDB
#undef PG8_MMA
#undef PG8_WAIT_V
#undef PG8_WAIT_L
#undef PG8_BAR
#undef PG8_SCHED
#undef PG8_UA
#undef PG8_UB
}
}

namespace att {
constexpr int SHM_V = 64 * 128 * 2, OFF_K = 2 * SHM_V, OFF_WS = OFF_K + 2 * 3 * 8192, LDS_ATT = OFF_WS + NWAVES * 64 * 4;
static_assert(LDS_ATT <= RING_BYTES, "attention LDS");
__device__ __forceinline__ int crow(int r, int hi) { return (r & 3) + 8 * (r >> 2) + 4 * hi; }
__device__ __forceinline__ int v_st(int k, int c) { const int kk = (k & ~0xC) | ((k & 4) << 1) | ((k & 8) >> 1); return ((kk >> 3) * 4 + (c >> 5)) * 512 + ((kk & 7) * 32 + (c & 31)) * 2; }
__device__ __forceinline__ int v_rd_base(int lane) { return ((lane & 3) << 3) | (((lane >> 2) & 3) << 6) | (((lane >> 4) & 1) << 5) | (((lane >> 5) & 1) << 8); }
constexpr int v_rd_off(int d0, int ks, int half) { return d0 * 512 + ks * 4096 + half * 2048; }
template <int OFF> __device__ __forceinline__ s16x4 tr_read(int vb) { s16x4 r; asm volatile("ds_read_b64_tr_b16 %0, %1 offset:%2" : "=&v"(r) : "v"(vb), "i"(OFF) : "memory"); return r; }
#define ATT_SBAR() __builtin_amdgcn_sched_barrier(0)
#define ATT_SYNC() do { asm volatile("s_waitcnt lgkmcnt(0)" ::: "memory"); __builtin_amdgcn_s_barrier(); asm volatile("" ::: "memory"); } while (0)
struct VFrag { s16x4 l0, h0, l1, h1, l2, h2, l3, h3; };
template <int D0> __device__ __forceinline__ void v_reads(VFrag& f, int vb) {
    f.l0 = tr_read<v_rd_off(D0, 0, 0)>(vb); f.h0 = tr_read<v_rd_off(D0, 0, 1)>(vb); f.l1 = tr_read<v_rd_off(D0, 1, 0)>(vb); f.h1 = tr_read<v_rd_off(D0, 1, 1)>(vb);
    f.l2 = tr_read<v_rd_off(D0, 2, 0)>(vb); f.h2 = tr_read<v_rd_off(D0, 2, 1)>(vb); f.l3 = tr_read<v_rd_off(D0, 3, 0)>(vb); f.h3 = tr_read<v_rd_off(D0, 3, 1)>(vb);
}
__device__ __forceinline__ void pv_mma(f32x16& od, const VFrag& f, bf16x8 pa0, bf16x8 pa1, bf16x8 pa2, bf16x8 pa3) {
#define ATT_PK(L, H) (bf16x8){L[0], L[1], L[2], L[3], H[0], H[1], H[2], H[3]}
    od = __builtin_amdgcn_mfma_f32_32x32x16_bf16(pa0, ATT_PK(f.l0, f.h0), od, 0, 0, 0);
    od = __builtin_amdgcn_mfma_f32_32x32x16_bf16(pa1, ATT_PK(f.l1, f.h1), od, 0, 0, 0);
    od = __builtin_amdgcn_mfma_f32_32x32x16_bf16(pa2, ATT_PK(f.l2, f.h2), od, 0, 0, 0);
    od = __builtin_amdgcn_mfma_f32_32x32x16_bf16(pa3, ATT_PK(f.l3, f.h3), od, 0, 0, 0);
#undef ATT_PK
}
#define ATT_LWAIT(n) do { asm volatile("s_waitcnt lgkmcnt(" #n ")" ::: "memory"); ATT_SBAR(); } while (0)
__device__ __forceinline__ void pv_d0(f32x16* o, int vb, bf16x8 pa0, bf16x8 pa1, bf16x8 pa2, bf16x8 pa3) {
    VFrag fa, fb;
    v_reads<0>(fa, vb); v_reads<1>(fb, vb);
    ATT_LWAIT(8); pv_mma(o[0], fa, pa0, pa1, pa2, pa3); ATT_SBAR();
    v_reads<2>(fa, vb);
    ATT_LWAIT(8); pv_mma(o[1], fb, pa0, pa1, pa2, pa3); ATT_SBAR();
    v_reads<3>(fb, vb);
    ATT_LWAIT(8); pv_mma(o[2], fa, pa0, pa1, pa2, pa3); ATT_SBAR();
    ATT_LWAIT(0); pv_mma(o[3], fb, pa0, pa1, pa2, pa3);
}
__device__ __forceinline__ void exp16(f32x16& p) {
#pragma unroll
    for (int r = 0; r < 16; ++r) p[r] = __builtin_amdgcn_exp2f(p[r]);
}
__device__ __forceinline__ void finishSM(f32x16& p0, f32x16& p1, float& l_reg, bf16x8& pa0, bf16x8& pa1, bf16x8& pa2, bf16x8& pa3) {
    float ps = 0.f;
#pragma unroll
    for (int r = 0; r < 16; ++r) ps += p0[r];
#pragma unroll
    for (int r = 0; r < 16; ++r) ps += p1[r];
    l_reg += ps;
#define ATT_PK4(P, BASE, OUT) do { unsigned a0 = cvt_pk_bf16(P[BASE + 0], P[BASE + 1]), a1 = cvt_pk_bf16(P[BASE + 2], P[BASE + 3]);   \
    unsigned b0 = cvt_pk_bf16(P[BASE + 4], P[BASE + 5]), b1 = cvt_pk_bf16(P[BASE + 6], P[BASE + 7]);                              \
    auto r0 = __builtin_amdgcn_permlane32_swap(a0, b0, false, false); auto r1 = __builtin_amdgcn_permlane32_swap(a1, b1, false, false); \
    u32x4 w = {r0[0], r1[0], r0[1], r1[1]}; OUT = __builtin_bit_cast(bf16x8, w); } while (0)
    ATT_PK4(p0, 0, pa0); ATT_PK4(p0, 8, pa1); ATT_PK4(p1, 0, pa2); ATT_PK4(p1, 8, pa3);
#undef ATT_PK4
}
template <int NS, int SD>
__device__ __forceinline__ void attn_body(const bf16_t* __restrict__ Qb, int ldq, const bf16_t* __restrict__ Kh, int ldk, const bf16_t* __restrict__ Vh, int ldv,
                                          float negoff, LAS char* lds, f32x16 (&o)[4]) {
    constexpr int NQK = 4 * NS, KB = NS * 8192, NT = SEQ / 64;
    const int tid = opq(threadIdx.x), wid = tid >> 6, lane = tid & 63, r32 = lane & 31, hi = lane >> 5;
    LAS char* V_lds = lds; LAS char* K_lds = lds + OFF_K;
    LAS float* li_l = (LAS float*)(lds + OFF_WS) + wid * 64;
    float l_reg = 0.f;
#pragma unroll
    for (int d = 0; d < 4; ++d)
#pragma unroll
        for (int r = 0; r < 16; ++r) o[d][r] = 0.f;
    bf16x8 qr[NQK];
    { const bf16_t* Qw = Qb + (size_t)(wid * 32 + r32) * ldq + hi * 8;
#pragma unroll
      for (int d0 = 0; d0 < NQK; ++d0) qr[d0] = *(const bf16x8*)(Qw + d0 * 16); }
    const int vb0 = (int)(unsigned)(uintptr_t)V_lds + v_rd_base(lane);
    const int kxb = hi ^ ((r32 >> 1) & 7), krow = r32 * 128;
    struct Slot { bf16x8 vs0, vs1, ks[NS]; } sl[SD];
#define ATT_SLOAD(i, k0) do { const int t_ = opq(tid), vr = t_ >> 4, vc = (t_ & 15) * 8, kr = t_ >> 3, kc = t_ & 7; \
    const unsigned vof0 = (unsigned)(vr * ldv + vc) * 2u, vof1 = (unsigned)((32 + vr) * ldv + vc) * 2u, kof = (unsigned)(kr * ldk + kc * 8) * 2u; \
    const char* vt_ = (const char*)Vh + (size_t)(k0) * ldv * 2; const char* kt_ = (const char*)Kh + (size_t)(k0) * ldk * 2; \
    sl[i].vs0 = *(const bf16x8*)(vt_ + vof0); sl[i].vs1 = *(const bf16x8*)(vt_ + vof1); \
    _Pragma("unroll") for (int s_ = 0; s_ < NS; ++s_) sl[i].ks[s_] = *(const bf16x8*)(kt_ + kof + s_ * 128); } while (0)
#define ATT_SWRITE(b, i) do { const int t_ = opq(tid), vr = t_ >> 4, vc = (t_ & 15) * 8, vst0 = v_st(vr, vc), vst1 = v_st(32 + vr, vc), kr = t_ >> 3, kc = t_ & 7, kst = kr * 128 + ((kc ^ ((kr >> 1) & 7)) << 4); \
    *(LAS bf16x8*)(V_lds + (b) * SHM_V + vst0) = sl[i].vs0; *(LAS bf16x8*)(V_lds + (b) * SHM_V + vst1) = sl[i].vs1; \
    _Pragma("unroll") for (int s_ = 0; s_ < NS; ++s_) *(LAS bf16x8*)(K_lds + (b) * KB + s_ * 8192 + kst) = sl[i].ks[s_]; } while (0)
#define ATT_TILE(b) do { f32x16 p0_, p1_; bf16x8 pa0, pa1, pa2, pa3; \
    _Pragma("unroll") for (int r_ = 0; r_ < 16; ++r_) { p0_[r_] = 0.f; p1_[r_] = 0.f; } \
    _Pragma("unroll") for (int d0 = 0; d0 < NQK; ++d0) { const LAS char* kp_ = K_lds + (b) * KB + (d0 >> 2) * 8192 + krow + ((((d0 & 3) * 2) ^ kxb) << 4); \
        const bf16x8 b0_ = *(const LAS bf16x8*)kp_; const bf16x8 b1_ = *(const LAS bf16x8*)(kp_ + 4096); \
        p0_ = __builtin_amdgcn_mfma_f32_32x32x16_bf16(b0_, qr[d0], p0_, 0, 0, 0); p1_ = __builtin_amdgcn_mfma_f32_32x32x16_bf16(b1_, qr[d0], p1_, 0, 0, 0); } \
    _Pragma("unroll") for (int r_ = 0; r_ < 16; ++r_) { p0_[r_] = __builtin_amdgcn_exp2f(p0_[r_] + negoff); p1_[r_] = __builtin_amdgcn_exp2f(p1_[r_] + negoff); } \
    finishSM(p0_, p1_, l_reg, pa0, pa1, pa2, pa3); ATT_SBAR(); \
    pv_d0(o, vb0 + (b) * SHM_V, pa0, pa1, pa2, pa3); } while (0)
    constexpr int SE = 0, SO = SD - 1;
    ATT_SLOAD(SE, 0); ATT_SWRITE(0, SE); ATT_SLOAD(SO, 64); if constexpr (SD == 2) ATT_SLOAD(SE, 128); ATT_SYNC();
    for (int j = 0; j < NT; j += 2) {
        ATT_SWRITE(1, SO); if (j + 1 + SD < NT) ATT_SLOAD(SO, (j + 1 + SD) * 64); ATT_SBAR();
        ATT_TILE(0);
        ATT_SYNC();
        if (j + 2 < NT) ATT_SWRITE(0, SE); if (j + 2 + SD < NT) ATT_SLOAD(SE, (j + 2 + SD) * 64); ATT_SBAR();
        ATT_TILE(1);
        ATT_SYNC();
    }
    { auto rr = __builtin_amdgcn_permlane32_swap(__builtin_bit_cast(unsigned, l_reg), __builtin_bit_cast(unsigned, l_reg), false, false);
      l_reg = __builtin_bit_cast(float, rr[0]) + __builtin_bit_cast(float, rr[1]); }
    if (hi == 0) li_l[r32] = l_reg;
    LDS_WAIT();
#pragma unroll
    for (int r = 0; r < 16; ++r) { const float rl = __builtin_amdgcn_rcpf(li_l[crow(r, hi)]);
#pragma unroll
        for (int d0 = 0; d0 < 4; ++d0) o[d0][r] *= rl; }
    LDS_WAIT();
#undef ATT_SLOAD
#undef ATT_SWRITE
#undef ATT_TILE
}
constexpr int DMA_OFF_K = 3 * SHM_V, DMA_OFF_WS = DMA_OFF_K + 3 * 3 * 8192, DMA_LDS = DMA_OFF_WS + NWAVES * 64 * 4;
static_assert(DMA_LDS <= RING_BYTES && 4 * SHM_V + 3 * 3 * 8192 + NWAVES * 64 * 4 <= ATT_BYTES, "attention LDS");
template <int NS>
__device__ __forceinline__ void attn_body_dma(const bf16_t* __restrict__ Qb, int ldq, const bf16_t* __restrict__ Kh, int ldk, const bf16_t* __restrict__ Vh, int ldv,
                                              float negoff, LAS char* lds, f32x16 (&o)[4]) {
    constexpr int NQK = 4 * NS, KB = NS * 8192, NT = SEQ / 64;
    const int tid = opq(threadIdx.x), wid = __builtin_amdgcn_readfirstlane(tid >> 6), lane = tid & 63, r32 = lane & 31, hi = lane >> 5;
    LAS char* V_lds = lds; LAS char* K_lds = lds + DMA_OFF_K;
    LAS float* li_l = (LAS float*)(lds + DMA_OFF_WS) + wid * 64;
    float l_reg = 0.f;
#pragma unroll
    for (int d = 0; d < 4; ++d)
#pragma unroll
        for (int r = 0; r < 16; ++r) o[d][r] = 0.f;
    bf16x8 qr[NQK];
    { const bf16_t* Qw = Qb + (size_t)(wid * 32 + r32) * ldq + hi * 8;
#pragma unroll
      for (int d0 = 0; d0 < NQK; ++d0) qr[d0] = *(const bf16x8*)(Qw + d0 * 16); }
    const int vb0 = (int)(unsigned)(uintptr_t)V_lds + v_rd_base(lane);
    const int kxb = hi ^ ((r32 >> 1) & 7), krow = r32 * 128;
    f32x16 negv;
#pragma unroll
    for (int r = 0; r < 16; ++r) negv[r] = (NS == 1) ? negoff : 0.f;
    const float nadd = (NS == 1) ? 0.f : negoff;
    unsigned vsrc[2], ksrc;
#pragma unroll
    for (int i = 0; i < 2; ++i) { const int p = (2 * wid + i) * 64 + lane, sub = p >> 5, kk = (sub >> 2) * 8 + ((p & 31) >> 2), k = (kk & ~0xC) | ((kk & 4) << 1) | ((kk & 8) >> 1), c = (sub & 3) * 32 + (p & 3) * 8;
        vsrc[i] = (unsigned)(k * ldv + c) * 2u; }
    { const int p = wid * 64 + lane, row = p >> 3, chunk = (p & 7) ^ ((row >> 1) & 7); ksrc = (unsigned)(row * ldk + chunk * 8) * 2u; }
#define ATT_DMA(slot, k0) do { const char* vt_ = (const char*)Vh + (size_t)(k0) * ldv * 2; const char* kt_ = (const char*)Kh + (size_t)(k0) * ldk * 2; \
    _Pragma("unroll") for (int i_ = 0; i_ < 2; ++i_) __builtin_amdgcn_global_load_lds((const unsigned*)(vt_ + vsrc[i_]), (LAS unsigned*)(V_lds + (slot) * SHM_V + (2 * wid + i_) * 1024), 16, 0, 0); \
    _Pragma("unroll") for (int s_ = 0; s_ < NS; ++s_) __builtin_amdgcn_global_load_lds((const unsigned*)(kt_ + ksrc + s_ * 128), (LAS unsigned*)(K_lds + (slot) * KB + s_ * 8192 + wid * 1024), 16, 0, 0); } while (0)
#define ATT_LDK(buf, g, kb_) do { _Pragma("unroll") for (int q_ = 0; q_ < 2; ++q_) { const int d0_ = 2 * (g) + q_; \
        const LAS char* kp_ = (kb_) + (d0_ >> 2) * 8192 + ((((d0_ & 3) * 2) ^ kxb) << 4); kf[buf][2 * q_] = *(const LAS bf16x8*)kp_; kf[buf][2 * q_ + 1] = *(const LAS bf16x8*)(kp_ + 4096); } } while (0)
#define ATT_TILE_D(slot) do { f32x16 p0_, p1_; bf16x8 pa0, pa1, pa2, pa3; const LAS char* kb_ = K_lds + (slot) * KB + krow; bf16x8 kf[2][4]; \
    ATT_LDK(0, 0, kb_); ATT_SBAR(); \
    _Pragma("unroll") for (int g_ = 0; g_ < NQK / 2; ++g_) { \
        if (g_ + 1 < NQK / 2) ATT_LDK((g_ + 1) & 1, g_ + 1, kb_); ATT_SBAR(); \
        _Pragma("unroll") for (int q_ = 0; q_ < 2; ++q_) { \
            p0_ = __builtin_amdgcn_mfma_f32_32x32x16_bf16(kf[g_ & 1][2 * q_], qr[2 * g_ + q_], (g_ == 0 && q_ == 0) ? negv : p0_, 0, 0, 0); \
            p1_ = __builtin_amdgcn_mfma_f32_32x32x16_bf16(kf[g_ & 1][2 * q_ + 1], qr[2 * g_ + q_], (g_ == 0 && q_ == 0) ? negv : p1_, 0, 0, 0); } \
        ATT_SBAR(); } \
    if constexpr (NS == 1) { _Pragma("unroll") for (int r_ = 0; r_ < 16; ++r_) { p0_[r_] = __builtin_amdgcn_exp2f(p0_[r_]); p1_[r_] = __builtin_amdgcn_exp2f(p1_[r_]); } } \
    else { _Pragma("unroll") for (int r_ = 0; r_ < 16; ++r_) { p0_[r_] = __builtin_amdgcn_exp2f(p0_[r_] + nadd); p1_[r_] = __builtin_amdgcn_exp2f(p1_[r_] + nadd); } } \
    finishSM(p0_, p1_, l_reg, pa0, pa1, pa2, pa3); ATT_SBAR(); \
    pv_d0(o, vb0 + (slot) * SHM_V, pa0, pa1, pa2, pa3); } while (0)
    ATT_DMA(0, 0); ATT_DMA(1, 64);
    if constexpr (NS == 1) asm volatile("s_waitcnt vmcnt(3)" ::: "memory"); else asm volatile("s_waitcnt vmcnt(5)" ::: "memory");
    ATT_SYNC();
    int slot = 0;
    for (int j = 0; j < NT; ++j) {
        const int s2 = (slot == 0) ? 2 : slot - 1;
        if (j + 2 < NT) ATT_DMA(s2, (j + 2) * 64);
        ATT_SBAR();
        ATT_TILE_D(slot);
        if (j + 2 < NT) { if constexpr (NS == 1) asm volatile("s_waitcnt vmcnt(3)" ::: "memory"); else asm volatile("s_waitcnt vmcnt(5)" ::: "memory"); }
        else asm volatile("s_waitcnt vmcnt(0)" ::: "memory");
        ATT_SYNC();
        slot = (slot == 2) ? 0 : slot + 1;
    }
    { auto rr = __builtin_amdgcn_permlane32_swap(__builtin_bit_cast(unsigned, l_reg), __builtin_bit_cast(unsigned, l_reg), false, false);
      l_reg = __builtin_bit_cast(float, rr[0]) + __builtin_bit_cast(float, rr[1]); }
    if (hi == 0) li_l[r32] = l_reg;
    LDS_WAIT();
#pragma unroll
    for (int r = 0; r < 16; ++r) { const float rl = __builtin_amdgcn_rcpf(li_l[crow(r, hi)]);
#pragma unroll
        for (int d0 = 0; d0 < 4; ++d0) o[d0][r] *= rl; }
    LDS_WAIT();
#undef ATT_DMA
#undef ATT_TILE_D
#undef ATT_LDK
}
template <int NS>
__device__ __forceinline__ void attn_body_st(const bf16_t* __restrict__ Qb, int ldq, const bf16_t* __restrict__ Kh, int ldk, const bf16_t* __restrict__ Vh, int ldv,
                                             float negoff, LAS char* lds, f32x16 (&o)[4]) {
    constexpr int NQK = 4 * NS, KB = NS * 8192, NT = SEQ / 64;
    const int tid = opq(threadIdx.x), wid = __builtin_amdgcn_readfirstlane(tid >> 6), lane = tid & 63, r32 = lane & 31, hi = lane >> 5;
    LAS char* V_lds = lds; LAS char* K_lds = lds + 4 * SHM_V;
    LAS float* li_l = (LAS float*)(lds + 4 * SHM_V + 3 * 3 * 8192) + wid * 64;
    float l_reg = 0.f;
#pragma unroll
    for (int d = 0; d < 4; ++d)
#pragma unroll
        for (int r = 0; r < 16; ++r) o[d][r] = 0.f;
    bf16x8 qr[NQK];
    { const bf16_t* Qw = Qb + (size_t)(wid * 32 + r32) * ldq + hi * 8;
#pragma unroll
      for (int d0 = 0; d0 < NQK; ++d0) qr[d0] = *(const bf16x8*)(Qw + d0 * 16); }
    const int vb0 = (int)(unsigned)(uintptr_t)V_lds + v_rd_base(lane);
    const int kxb = hi ^ ((r32 >> 1) & 7), krow = r32 * 128;
    unsigned vsrc[2], ksrc;
#pragma unroll
    for (int i = 0; i < 2; ++i) { const int p = (2 * wid + i) * 64 + lane, sub = p >> 5, kk = (sub >> 2) * 8 + ((p & 31) >> 2), k = (kk & ~0xC) | ((kk & 4) << 1) | ((kk & 8) >> 1), c = (sub & 3) * 32 + (p & 3) * 8;
        vsrc[i] = (unsigned)(k * ldv + c) * 2u; }
    { const int p = wid * 64 + lane, row = p >> 3, chunk = (p & 7) ^ ((row >> 1) & 7); ksrc = (unsigned)(row * ldk + chunk * 8) * 2u; }
#define ATT_DMA(vslot, kslot, k0) do { const char* vt_ = (const char*)Vh + (size_t)(k0) * ldv * 2; const char* kt_ = (const char*)Kh + (size_t)(k0) * ldk * 2; \
    _Pragma("unroll") for (int i_ = 0; i_ < 2; ++i_) __builtin_amdgcn_global_load_lds((const unsigned*)(vt_ + vsrc[i_]), (LAS unsigned*)(V_lds + (vslot) * SHM_V + (2 * wid + i_) * 1024), 16, 0, 0); \
    _Pragma("unroll") for (int s_ = 0; s_ < NS; ++s_) __builtin_amdgcn_global_load_lds((const unsigned*)(kt_ + ksrc + s_ * 128), (LAS unsigned*)(K_lds + (kslot) * KB + s_ * 8192 + wid * 1024), 16, 0, 0); } while (0)
#define ATT_LDK(buf, g, kb_) do { _Pragma("unroll") for (int q_ = 0; q_ < 2; ++q_) { constexpr int dummy_ = 0; (void)dummy_; const int d0_ = 2 * (g) + q_; \
        const LAS char* kp_ = (kb_) + (d0_ >> 2) * 8192 + ((((d0_ & 3) * 2) ^ kxb) << 4); kf[buf][2 * q_] = *(const LAS bf16x8*)kp_; kf[buf][2 * q_ + 1] = *(const LAS bf16x8*)(kp_ + 4096); } } while (0)
#define ATT_QKSM(kslot) do { f32x16 p0_, p1_; const LAS char* kb_ = K_lds + (kslot) * KB + krow; bf16x8 kf[2][4]; \
    _Pragma("unroll") for (int r_ = 0; r_ < 16; ++r_) { p0_[r_] = 0.f; p1_[r_] = 0.f; } \
    ATT_LDK(0, 0, kb_); ATT_SBAR(); \
    _Pragma("unroll") for (int g_ = 0; g_ < NQK / 2; ++g_) { \
        if (g_ + 1 < NQK / 2) ATT_LDK((g_ + 1) & 1, g_ + 1, kb_); ATT_SBAR(); \
        _Pragma("unroll") for (int q_ = 0; q_ < 2; ++q_) { p0_ = __builtin_amdgcn_mfma_f32_32x32x16_bf16(kf[g_ & 1][2 * q_], qr[2 * g_ + q_], p0_, 0, 0, 0); p1_ = __builtin_amdgcn_mfma_f32_32x32x16_bf16(kf[g_ & 1][2 * q_ + 1], qr[2 * g_ + q_], p1_, 0, 0, 0); } \
        ATT_SBAR(); } \
    _Pragma("unroll") for (int r_ = 0; r_ < 16; ++r_) { p0_[r_] = __builtin_amdgcn_exp2f(p0_[r_] + negoff); p1_[r_] = __builtin_amdgcn_exp2f(p1_[r_] + negoff); } \
    finishSM(p0_, p1_, l_reg, pa0, pa1, pa2, pa3); } while (0)
#define ATT_ENDI(fly) do { if (fly) { if constexpr (NS == 1) asm volatile("s_waitcnt vmcnt(3)" ::: "memory"); else asm volatile("s_waitcnt vmcnt(5)" ::: "memory"); } else asm volatile("s_waitcnt vmcnt(0)" ::: "memory"); ATT_SYNC(); } while (0)
    bf16x8 pa0, pa1, pa2, pa3;
    ATT_DMA(0, 0, 0); ATT_DMA(1, 1, 64); ATT_ENDI(true);
    int vs = 0, ks = 0;
    if (wid < 4) {
        for (int j = 0; j < NT; ++j) {
            if (j + 2 < NT) ATT_DMA((vs + 2) & 3, (ks == 0) ? 2 : ks - 1, (j + 2) * 64);
            ATT_SBAR();
            ATT_QKSM(ks); ATT_SBAR();
            pv_d0(o, vb0 + vs * SHM_V, pa0, pa1, pa2, pa3);
            ATT_ENDI(j + 2 < NT);
            vs = (vs + 1) & 3; ks = (ks == 2) ? 0 : ks + 1;
        }
    } else {
        int vp = 0;
        for (int j = 0; j < NT; ++j) {
            if (j + 2 < NT) ATT_DMA((vs + 2) & 3, (ks == 0) ? 2 : ks - 1, (j + 2) * 64);
            ATT_SBAR();
            if (j > 0) pv_d0(o, vb0 + vp * SHM_V, pa0, pa1, pa2, pa3);
            ATT_SBAR();
            ATT_QKSM(ks);
            ATT_ENDI(j + 2 < NT);
            vp = vs; vs = (vs + 1) & 3; ks = (ks == 2) ? 0 : ks + 1;
        }
        ATT_SBAR();
        pv_d0(o, vb0 + vp * SHM_V, pa0, pa1, pa2, pa3);
    }
    ATT_SYNC();
    { auto rr = __builtin_amdgcn_permlane32_swap(__builtin_bit_cast(unsigned, l_reg), __builtin_bit_cast(unsigned, l_reg), false, false);
      l_reg = __builtin_bit_cast(float, rr[0]) + __builtin_bit_cast(float, rr[1]); }
    if (hi == 0) li_l[r32] = l_reg;
    LDS_WAIT();
#pragma unroll
    for (int r = 0; r < 16; ++r) { const float rl = __builtin_amdgcn_rcpf(li_l[crow(r, hi)]);
#pragma unroll
        for (int d0 = 0; d0 < 4; ++d0) o[d0][r] *= rl; }
    LDS_WAIT();
#undef ATT_DMA
#undef ATT_QKSM
#undef ATT_LDK
#undef ATT_ENDI
}
}

#define XB_TMO      128
#define XB_XCNT(j)  (256  + 64 * (j))
#define XB_XSUB(j)  (1280 + 64 * (j))
#define XB_XGEN(j)  (2304 + 64 * (j))
#define XB_TOP      3328
#define XB_TOPGEN   3392
#define XCD_BAR_WORDS 3456
#define XB_SPIN_CAP (1u << 22)
__device__ __forceinline__ unsigned xb_ld(unsigned* p)              { return __hip_atomic_load(p, __ATOMIC_RELAXED, __HIP_MEMORY_SCOPE_AGENT); }
__device__ __forceinline__ unsigned xb_add(unsigned* p, unsigned v) { return __hip_atomic_fetch_add(p, v, __ATOMIC_RELAXED, __HIP_MEMORY_SCOPE_AGENT); }
__device__ __forceinline__ unsigned xb_xcc_id() { return (unsigned)__builtin_amdgcn_s_getreg((3 << 11) | 20) & 0xFu; }
#define XB_SPIN(cond, bar) do { unsigned _sp = 0; while (cond) { __builtin_amdgcn_s_sleep(1); \
    if ((++_sp & 255u) == 0u) { if (xb_ld(&(bar)[XB_TMO])) break; if (_sp > XB_SPIN_CAP) { atomicAdd(&(bar)[XB_TMO], 1u); break; } } } } while (0)
struct XcdBarrier { unsigned* bar; unsigned x; volatile LAS unsigned* st; };
__device__ __forceinline__ XcdBarrier xcd_barrier_post(unsigned* bar, volatile LAS unsigned* st) {
    XcdBarrier b; b.bar = bar; b.x = xb_xcc_id(); b.st = st;
    if (threadIdx.x == 0) (void)xb_add(&bar[XB_XCNT(b.x)], 1u);
    return b;
}
__device__ __forceinline__ void xcd_barrier_complete(unsigned* bar, unsigned x, unsigned& nloc, unsigned& nx) {
    const unsigned G = gridDim.x * gridDim.y * gridDim.z;
    unsigned sum, cnt, mine, sp = 0u;
    for (;;) {
        sum = 0u; cnt = 0u; mine = 0u;
#pragma unroll
        for (unsigned j = 0; j < 16; ++j) { const unsigned c = xb_ld(&bar[XB_XCNT(j)]); sum += c; cnt += (c > 0u) ? 1u : 0u; mine = (j == x) ? c : mine; }
        if (sum == G) break;
        __builtin_amdgcn_s_sleep(1);
        if ((++sp & 255u) == 0u) { if (xb_ld(&bar[XB_TMO])) break; if (sp > XB_SPIN_CAP) { atomicAdd(&bar[XB_TMO], 1u); break; } }
    }
    nloc = mine > 0u ? mine : 1u; nx = cnt > 0u ? cnt : 1u;
}
__device__ __forceinline__ void xcd_barrier(const XcdBarrier& b) {
    asm volatile("s_waitcnt vmcnt(0)" ::: "memory");
    __syncthreads();
    if (threadIdx.x == 0) {
        unsigned* bar = b.bar;
        __builtin_amdgcn_s_waitcnt(0);
        unsigned nloc = b.st[0], nx = b.st[1];
        if (nloc == 0u) { xcd_barrier_complete(bar, b.x, nloc, nx); b.st[0] = nloc; b.st[1] = nx; }
        const unsigned old = xb_add(&bar[XB_XSUB(b.x)], 1u);
        const unsigned gen = old / nloc;
        if (old + 1u == (gen + 1u) * nloc) {
            __builtin_amdgcn_fence(__ATOMIC_RELEASE, "agent");
            asm volatile("s_waitcnt vmcnt(0)" ::: "memory");
            const unsigned og = xb_add(&bar[XB_TOP], 1u);
            const unsigned tg = og / nx;
            if (og + 1u == (tg + 1u) * nx) xb_add(&bar[XB_TOPGEN], 1u);
            else XB_SPIN(xb_ld(&bar[XB_TOPGEN]) == tg, bar);
            __builtin_amdgcn_fence(__ATOMIC_ACQUIRE, "agent");
            xb_add(&bar[XB_XGEN(b.x)], 1u);
            asm volatile("s_waitcnt vmcnt(0)" ::: "memory");
        } else {
            XB_SPIN(xb_ld(&bar[XB_XGEN(b.x)]) == gen, bar);
            __builtin_amdgcn_fence(__ATOMIC_ACQUIRE, "agent");
            asm volatile("s_waitcnt vmcnt(0)" ::: "memory");
        }
    }
    __syncthreads();
}

template <int MODE = 0>
__device__ __forceinline__ void tr_item(const float* W, size_t ldw, int k0, int n0, bf16_t* WT, size_t ldt, int drow0, int dcol0, LAS float* scr, int lane, float qinv = 1.f) {
    constexpr bool F8 = (MODE == 1);
    { f32x4 wv_[8];
#pragma unroll
      for (int i = 0; i < 8; ++i) wv_[i] = *(const f32x4*)(W + (size_t)(k0 + 8 * i + (lane >> 3)) * ldw + n0 + 4 * (lane & 7));
#pragma unroll
      for (int i = 0; i < 8; ++i) { LAS float* d_ = scr + (8 * i + (lane >> 3)) * 33 + 4 * (lane & 7); d_[0] = wv_[i].x; d_[1] = wv_[i].y; d_[2] = wv_[i].z; d_[3] = wv_[i].w; } }
    LDS_WAIT(); asm volatile("" ::: "memory");
    const int c = lane & 7;
#pragma unroll
    for (int j = 0; j < 4; ++j) { const int n = (lane >> 3) + 8 * j; const LAS float* s = scr + (8 * c) * 33 + n;
        if constexpr (MODE == 2) { u32x2 o; o.x = pk_i8x4(s[0 * 33] * qinv, s[1 * 33] * qinv, s[2 * 33] * qinv, s[3 * 33] * qinv); o.y = pk_i8x4(s[4 * 33] * qinv, s[5 * 33] * qinv, s[6 * 33] * qinv, s[7 * 33] * qinv);
            *(u32x2*)((unsigned char*)WT + (size_t)(drow0 + n) * ldt + dcol0 + 8 * c) = o; }
        else if constexpr (F8) { u32x2 o; o.x = pk_fp8x4(s[0 * 33] * W8_SCALE, s[1 * 33] * W8_SCALE, s[2 * 33] * W8_SCALE, s[3 * 33] * W8_SCALE); o.y = pk_fp8x4(s[4 * 33] * W8_SCALE, s[5 * 33] * W8_SCALE, s[6 * 33] * W8_SCALE, s[7 * 33] * W8_SCALE);
            *(u32x2*)((unsigned char*)WT + (size_t)(drow0 + n) * ldt + dcol0 + 8 * c) = o; }
        else { u32x4 o; o.x = pk2(s[0 * 33], s[1 * 33]); o.y = pk2(s[2 * 33], s[3 * 33]); o.z = pk2(s[4 * 33], s[5 * 33]); o.w = pk2(s[6 * 33], s[7 * 33]);
            *(u32x4*)(WT + (size_t)(drow0 + n) * ldt + dcol0 + 8 * c) = o; } }
    LDS_WAIT(); asm volatile("" ::: "memory");
}

struct Args { const void* in[27]; float* out; unsigned char* ws; int step_lo, step_hi; };
typedef const __attribute__((address_space(4))) Args CArgs;
__device__ __forceinline__ CArgs* opq_args() { CArgs* p = (CArgs*)__builtin_amdgcn_kernarg_segment_ptr(); asm volatile("" : "+s"(p)); return p; }

__global__ void __launch_bounds__(NWAVES * 64, 2) fwd(Args args) {
    extern __shared__ __attribute__((aligned(16))) unsigned char lds_raw[];
    LAS unsigned char* lds = (LAS unsigned char*)lds_raw;
    volatile LAS unsigned* MISC = (volatile LAS unsigned*)(lds + MISC_OFF);
    const int tid0 = threadIdx.x, wave = __builtin_amdgcn_readfirstlane(tid0 >> 6);
    const int G0 = gridDim.x, bx0 = blockIdx.x;
    const int vcu0 = (G0 % 8 == 0) ? (bx0 % 8) * (G0 / 8) + bx0 / 8 : bx0;
    const int gw0 = vcu0 * NWAVES + wave;
#define ws (A->ws)
    for (int u = tid0; u < (LDS_BYTES - LDSCTL_OFF) / 4; u += NWAVES * 64) ((LAS unsigned*)(lds + LDSCTL_OFF))[u] = 0u;
    __syncthreads();
    const int lo = args.step_lo, hi = args.step_hi;
    if (MK_ONE_LAUNCH) { CArgs* A = opq_args(); const int G = opqs(G0), bx = opqs(bx0), gw = opqs(gw0), NGW = G * NWAVES; (void)bx; (void)gw; (void)NGW; (void)xcd_barrier_post((unsigned*)(ws + WS_CTL) + CW_BAR, MISC + 8); }
#ifndef DISMASK
#define DISMASK 0
#endif
#define EN(p) (!((DISMASK >> (p)) & 1))
#ifndef P3MASK
#define P3MASK 0
#endif
#ifndef P5MASK
#define P5MASK 0
#endif
#define P5EN(p) (!((P5MASK >> (p)) & 1))
#define P3EN(p) (!((P3MASK >> (p)) & 1))
#ifndef DUPMASK
#define DUPMASK 0
#endif
#define NREP(p) ((((DUPMASK) >> (p)) & 1) ? 2 : 1)
#define IN(k) (lo <= (k) && (k) < hi)
#define SEAM(k) do { if ((k) + 1 < hi) { if (MK_ONE_LAUNCH) { XcdBarrier bar_; bar_.bar = (unsigned*)(ws + WS_CTL) + CW_BAR; bar_.x = xb_xcc_id(); bar_.st = (volatile LAS unsigned*)(lds + MISC_OFF) + 8; xcd_barrier(bar_); } } } while (0)

#define cosA ((float*)(ws + WS_COSA))
#define sinA ((float*)(ws + WS_SINA))
#define cosC ((float*)(ws + WS_COSC))
#define sinC ((float*)(ws + WS_SINC))
#define XN ((bf16_t*)(ws + WS_XN))
#define H ((bf16_t*)(ws + WS_H))
#define UC ((bf16_t*)(ws + WS_UC))
#define QM ((bf16_t*)(ws + WS_QM))
#define KV ((bf16_t*)(ws + WS_KV))
#define KM ((bf16_t*)(ws + WS_KM))
#define LAB ((unsigned*)(ws + WS_LAB))
#define AGP ((float*)(ws + WS_AGP))
#define AGH ((float*)(ws + WS_AGH))
#define GATES ((bf16_t*)(ws + WS_GATES))
#define DBUF ((float*)(ws + WS_DBUF))
#define OCAT ((bf16_t*)(ws + WS_OCAT))
#define TMP ((float*)(ws + WS_TMP))
#define YSUM ((bf16_t*)(ws + WS_YSUM))
#define HID ((bf16_t*)(ws + WS_HID))
#define x_in ((const float*)A->in[0])
#define out (A->out)

    auto conv_layer = [](CArgs* A, LAS unsigned char* lds, const int wave, const int lc, const int part, const int tid, const int lane, const int G, const int bx, const int gw, const int NGW) __attribute__((always_inline)) {
        if (part == 0) { const int l = lc;
            unsigned char* wlp = ws + WS_W + (size_t)l * WL_SIZE;
            const int esz_in = I8N(l) ? 1 : 2;
            u32x4* padp = (u32x4*)(wlp + WL_IN + (size_t)NIN * DM * esz_in);
            for (int i = bx * 512 + tid; i < (NINP - NIN) * DM * esz_in / 16; i += G * 512) padp[i] = (u32x4){0u, 0u, 0u, 0u};
            bf16_t* wlru = (bf16_t*)(wlp + WL_LRU); const float* gwsrc = (const float*)A->in[10] + (size_t)l * 2 * 2 * 8 * 128 * 128;
            (void)gwsrc;
            for (int i = bx * 512 + tid; i < 4096 * 16; i += G * 512) { const int R = i >> 4, c8 = i & 15, nb = R >> 9;
                *(u32x4*)(wlru + (size_t)R * 256 + (1 - (nb & 1)) * 128 + 8 * c8) = (u32x4){0u, 0u, 0u, 0u}; }
        }
        { LAS float* scr = (LAS float*)(lds + wave * 16384);
          constexpr int I_IN = 64 * 210, I_UQ = 12 * 48, I_UKV = 8 * 64, I_G = 4 * 384, I_BO = 3 * 16 * 128, I_OUT = 64 * 128, I_GA = 64 * 344, I_UP = I_GA, I_DN = 172 * 128, I_LRU = 32 * 8;
          constexpr int I_MIX = I_IN + I_UQ + I_UKV + I_G + I_BO + I_OUT + I_LRU, I_L = I_MIX + I_GA + I_UP + I_DN;
          const int IT0 = part ? I_MIX : 0, NIT = part ? I_L : I_MIX;
          float qsl = 1.f / ((const float*)(ws + WS_WSC))[lane & 15];
          asm volatile("s_waitcnt vmcnt(0)" : "+v"(qsl) :: "memory");
          auto dec = [&](int it, const float*& src, size_t& ldw, unsigned char*& dst, size_t& rsb, int& mode, float& q) {
              const int l = lc; int r = it;
              int kb, nb, drow, dcol; size_t ldt, woff; mode = 0; q = 1.f;
              if (r < I_IN) { kb = r / 210; nb = r - 210 * kb; src = (const float*)A->in[3] + (size_t)l * DM * NIN; ldw = NIN; woff = WL_IN; ldt = DM; drow = 32 * nb; dcol = 64 * kb;
                  if (I8N(l)) { mode = 2; q = __builtin_bit_cast(float, __builtin_amdgcn_readlane(__builtin_bit_cast(int, qsl), 8 + l)); } }
              else if ((r -= I_IN) < I_UQ) { kb = r / 48; nb = r - 48 * kb; src = (const float*)A->in[14] + (size_t)l * 768 * 1536; ldw = 1536; woff = WL_UQ; ldt = 768; drow = 32 * nb; dcol = 64 * kb; }
              else if ((r -= I_UQ) < I_UKV) { kb = r / 64; nb = r - 64 * kb; src = (const float*)A->in[16] + (size_t)l * 512 * 2048; ldw = 2048; woff = WL_UKV; ldt = 512; drow = 32 * nb; dcol = 64 * kb; }
              else if ((r -= I_UKV) < I_G) { kb = r / 384; nb = r - 384 * kb; src = (const float*)A->in[19] + (size_t)l * 256 * 12288; ldw = 12288; woff = WL_G; ldt = 256; drow = 32 * nb; dcol = 64 * kb; }
              else if ((r -= I_G) < I_BO) { const int n = r / (16 * 128), r2 = r - n * 16 * 128; kb = r2 / 128; nb = r2 - 128 * kb;
                  src = (const float*)A->in[21] + ((size_t)l * 3 + n) * 1024 * 4096; ldw = 4096; woff = WL_BO; ldt = 3072; drow = 32 * nb; dcol = 1024 * n + 64 * kb; }
              else if ((r -= I_BO) < I_OUT) { kb = r / 128; nb = r - 128 * kb; src = (const float*)A->in[22] + (size_t)l * DM * DM; ldw = DM; woff = WL_OUT; ldt = DM; drow = 32 * nb; dcol = 64 * kb; if (F8O(l)) { mode = 1; q = W8_SCALE; } }
              else if ((r -= I_OUT) < I_LRU) { const int blk = r >> 3, zg = blk >> 3, nbk = blk & 7; kb = (r >> 2) & 1; nb = r & 3;
                  src = (const float*)A->in[10] + ((size_t)l * 32 + blk) * 128 * 128; ldw = 128; woff = WL_LRU; ldt = 256; drow = (2 * nbk + (zg >> 1)) * 256 + (zg & 1) * 128 + 32 * nb; dcol = (nbk & 1) * 128 + 64 * kb; }
              else if ((r -= I_LRU) < I_GA + I_UP) { const int up = r >= I_GA; if (up) r -= I_GA; kb = r / 344; nb = r - 344 * kb; const int n0 = 32 * nb;
                  src = (const float*)A->in[up ? 25 : 24] + (size_t)l * DM * FFH; ldw = FFH; woff = WL_GU; ldt = DM; drow = 256 * (n0 >> 7) + 128 * up + (n0 & 127); dcol = 64 * kb;
                  if (I8U(l)) { mode = 2; q = __builtin_bit_cast(float, __builtin_amdgcn_readlane(__builtin_bit_cast(int, qsl), 2 * l + up)); } else if (F8U(l)) { mode = 1; q = W8_SCALE; } }
              else { r -= I_GA + I_UP; { kb = r / 128; nb = r - 128 * kb; src = (const float*)A->in[26] + (size_t)l * FFH * DM; ldw = DM; woff = WL_DN; ldt = FFH; drow = 32 * nb; dcol = 64 * kb; if (F8L(l)) { mode = 1; q = W8_SCALE; } } }
              src += (size_t)(64 * kb) * ldw + 32 * nb;
              const size_t esz = mode ? 1 : 2;
              dst = ws + WS_W + (size_t)l * WL_SIZE + woff + ((size_t)drow * ldt + dcol) * esz; rsb = ldt * esz; };
          auto LOAD = [&](int it_, f32x4 (&w)[8]) { const float* src; size_t ldw, rsb; unsigned char* dst; int mode; float q; dec(it_, src, ldw, dst, rsb, mode, q);
#pragma unroll
              for (int i = 0; i < 8; ++i) { const float* p_ = src + (size_t)(8 * i + (lane >> 3)) * ldw + 4 * (lane & 7);
                  w[i] = *(const f32x4*)p_; } };
#define TR_WAIT(N, w) do { } while (0)
          auto FIN = [&](int it_, f32x4 (&w)[8]) { const float* src; size_t ldw, rsb; unsigned char* dst; int mode; float q; dec(it_, src, ldw, dst, rsb, mode, q);
#pragma unroll
              for (int i = 0; i < 8; ++i) { LAS float* d_ = scr + (8 * i + (lane >> 3)) * 33 + 4 * (lane & 7); d_[0] = w[i].x; d_[1] = w[i].y; d_[2] = w[i].z; d_[3] = w[i].w; }
              LDS_WAIT(); asm volatile("" ::: "memory");
              const int c = lane & 7;
              if (mode == 0) {
#pragma unroll
                  for (int j = 0; j < 4; ++j) { const int n = (lane >> 3) + 8 * j; const LAS float* sp_ = scr + (8 * c) * 33 + n;
                      u32x4 o; o.x = pk2(sp_[0 * 33], sp_[1 * 33]); o.y = pk2(sp_[2 * 33], sp_[3 * 33]); o.z = pk2(sp_[4 * 33], sp_[5 * 33]); o.w = pk2(sp_[6 * 33], sp_[7 * 33]);
                      *(u32x4*)(dst + (size_t)n * rsb + 16 * c) = o; } }
              else if (mode == 1) {
#pragma unroll
                  for (int j = 0; j < 4; ++j) { const int n = (lane >> 3) + 8 * j; const LAS float* sp_ = scr + (8 * c) * 33 + n;
                      u32x2 o; o.x = pk_fp8x4(sp_[0 * 33] * q, sp_[1 * 33] * q, sp_[2 * 33] * q, sp_[3 * 33] * q); o.y = pk_fp8x4(sp_[4 * 33] * q, sp_[5 * 33] * q, sp_[6 * 33] * q, sp_[7 * 33] * q);
                      *(u32x2*)(dst + (size_t)n * rsb + 8 * c) = o; } }
              else {
#pragma unroll
                  for (int j = 0; j < 4; ++j) { const int n = (lane >> 3) + 8 * j; const LAS float* sp_ = scr + (8 * c) * 33 + n;
                      u32x2 o; o.x = pk_i8x4(sp_[0 * 33] * q, sp_[1 * 33] * q, sp_[2 * 33] * q, sp_[3 * 33] * q); o.y = pk_i8x4(sp_[4 * 33] * q, sp_[5 * 33] * q, sp_[6 * 33] * q, sp_[7 * 33] * q);
                      *(u32x2*)(dst + (size_t)n * rsb + 8 * c) = o; } }
              LDS_WAIT(); asm volatile("" ::: "memory"); };
          f32x4 wa[8], wb[8];
#pragma nounroll
          for (int it = IT0 + gw; it < NIT; it += 4 * NGW) {
              const int i1 = it + NGW, i2 = it + 2 * NGW, i3 = it + 3 * NGW;
              LOAD(it, wa); LOAD(i1 < NIT ? i1 : NIT - 1, wb);
              TR_WAIT(8, wa); FIN(it, wa);
              LOAD(i2 < NIT ? i2 : NIT - 1, wa);
              TR_WAIT(12, wb); if (i1 < NIT) FIN(i1, wb);
              LOAD(i3 < NIT ? i3 : NIT - 1, wb);
              TR_WAIT(12, wa); if (i2 < NIT) FIN(i2, wa);
              TR_WAIT(4, wb); if (i3 < NIT) FIN(i3, wb);
          }
          asm volatile("s_waitcnt vmcnt(0)" ::: "memory");
#undef TR_WAIT
        }
    };
    if (EN(12) && IN(0)) for (int rep_ = 0; rep_ < NREP(12); ++rep_) { const int tid = opq(tid0), lane = tid & 63; CArgs* A = opq_args(); const int G = opqs(G0), bx = opqs(bx0), gw = opqs(gw0), NGW = G * NWAVES; (void)bx; (void)gw; (void)NGW;
        if ((I8UP_LAYERS | I8IN_LAYERS) != 0) {
            if (bx < 3 * DEPTH && (bx < 2 * DEPTH ? I8U(bx >> 1) : I8N(bx - 2 * DEPTH))) {
                const bool wi = bx >= 2 * DEPTH;
                const float* Wt = wi ? (const float*)A->in[3] + (size_t)(bx - 2 * DEPTH) * DM * NIN : (const float*)A->in[(bx & 1) ? 25 : 24] + (size_t)(bx >> 1) * DM * FFH; float ssq = 0.f, amx = 0.f;
                const int rl4 = wi ? NIN / 4 : FFH / 4; const size_t rstr = wi ? (size_t)256 * NIN : (size_t)256 * FFH;
#pragma nounroll
                for (int r = 0; r < 16; ++r) {
                    const f32x4* rowp = (const f32x4*)(Wt + (size_t)r * rstr); f32x4 w[6];
#pragma unroll
                    for (int u = 0; u < 6; ++u) { const int i = tid + u * (NWAVES * 64); w[u] = rowp[i < rl4 ? i : 0]; if (i >= rl4) w[u] = (f32x4){0.f, 0.f, 0.f, 0.f}; }
#pragma unroll
                    for (int u = 0; u < 6; ++u) { ssq += (w[u].x * w[u].x + w[u].y * w[u].y) + (w[u].z * w[u].z + w[u].w * w[u].w); amx = fmaxf(fmaxf(amx, fmaxf(fabsf(w[u].x), fabsf(w[u].y))), fmaxf(fabsf(w[u].z), fabsf(w[u].w))); } }
                ssq = wave_sum(ssq); amx = wave_max(amx);
                LAS float* red = (LAS float*)(lds);
                if (lane == 0) { red[2 * wave] = ssq; red[2 * wave + 1] = amx; }
                __syncthreads();
                if (tid == 0) { float a = 0.f, b = 0.f;
                    for (int w = 0; w < NWAVES; ++w) { a += red[2 * w]; b = fmaxf(b, red[2 * w + 1]); }
                    const float rms = sqrtf(a / (64.f * (float)rl4)); float sc = fminf(4.2f * rms, b * 1.05f) * (1.f / 127.f); if (!(sc > 0.f)) sc = 1.f;
                    ((float*)(ws + WS_WSC))[bx] = sc; }
                __syncthreads();
            }
            if (MK_ONE_LAUNCH) { XcdBarrier bar_; bar_.bar = (unsigned*)(ws + WS_CTL) + CW_BAR; bar_.x = xb_xcc_id(); bar_.st = (volatile LAS unsigned*)(lds + MISC_OFF) + 8; xcd_barrier(bar_); }
        }
        { const int* pos = (const int*)A->in[1];
          for (int i = bx * 512 + tid; i < MT * 40; i += G * 512) { const int m = i / 40, f = i - 40 * m;
              float inv; float* cd; float* sd;
              if (f < 8) { inv = exp2f(-(float)(2 * f) / 16.f * 18.931568569324174f); cd = cosA + m * 8 + f; sd = sinA + m * 8 + f; }
              else { const int ff = f - 8; inv = exp2f(-(float)(2 * ff) / 64.f * 18.931568569324174f); cd = cosC + m * 32 + ff; sd = sinC + m * 32 + ff; }
              const float ang = (float)pos[m] * inv; float sv, cv; sincosf(ang, &sv, &cv); *cd = cv; *sd = sv; } }
        { const float* Lsrc = (const float*)A->in[12]; float* spt = (float*)(ws + WS_SPT);
          for (int i = bx * 512 + tid; i < DEPTH * 2048; i += G * 512) spt[i] = -8.f * log1pf(expf(-Lsrc[i])); }
        conv_layer(A, lds, wave, 0, 0, tid, lane, G, bx, gw, NGW);
        SEAM(0);
    }

    for (int l = 0; l < DEPTH; ++l) {
        const int s0 = 1 + 12 * l;
        if (s0 + 12 <= lo || s0 >= hi) continue;
#define wl (ws + WS_W + (size_t)l * WL_SIZE)
#define xcur ((l == 0) ? x_in : (const float*)out)

        if (EN(0) && IN(s0 + 0)) for (int rep_ = 0; rep_ < NREP(0); ++rep_) { const int tid = opq(tid0), lane = tid & 63; (void)tid; (void)lane; CArgs* A = opq_args(); const int G = opqs(G0), bx = opqs(bx0), gw = opqs(gw0), NGW = G * NWAVES; (void)bx; (void)gw; (void)NGW;
            const float* g = (const float*)A->in[2] + (size_t)l * DM;
            for (int m = gw; m < MT; m += NGW) {
                const f32x4* xr = (const f32x4*)(xcur + (size_t)m * DM) + lane;
                f32x4 v[16]; float ss = 0.f;
#pragma unroll
                for (int j = 0; j < 16; ++j) { v[j] = xr[64 * j]; ss += (v[j].x * v[j].x + v[j].y * v[j].y) + (v[j].z * v[j].z + v[j].w * v[j].w); }
                const float rs = rsqrtf(wave_sum(ss) * (1.f / DM) + EPS);
                const f32x4* gr = (const f32x4*)g + lane;
                if (I8N(l)) {
                    float amx = 0.f, ssy = 0.f;
#pragma unroll
                    for (int j = 0; j < 16; ++j) { const f32x4 gg = gr[64 * j]; v[j].x = v[j].x * rs * gg.x; v[j].y = v[j].y * rs * gg.y; v[j].z = v[j].z * rs * gg.z; v[j].w = v[j].w * rs * gg.w;
                        ssy += (v[j].x * v[j].x + v[j].y * v[j].y) + (v[j].z * v[j].z + v[j].w * v[j].w);
                        amx = fmaxf(fmaxf(amx, fmaxf(fabsf(v[j].x), fabsf(v[j].y))), fmaxf(fabsf(v[j].z), fabsf(v[j].w))); }
                    amx = wave_max(amx); const float clipv = fminf(amx, 4.2f * sqrtf(wave_sum(ssy) * (1.f / DM)));
                    const float sc = (clipv > 0.f) ? clipv * (1.f / 127.f) : 1.f, inv = 1.f / sc;
                    unsigned* o4 = (unsigned*)((unsigned char*)XN + (size_t)m * DM) + lane;
#pragma unroll
                    for (int j = 0; j < 16; ++j) o4[64 * j] = pk_i8x4(v[j].x * inv, v[j].y * inv, v[j].z * inv, v[j].w * inv);
                    if (lane == 0) ((float*)(ws + WS_XS))[m] = sc; }
                else { u32x2* o8 = (u32x2*)(XN + (size_t)m * DM) + lane;
#pragma unroll
                    for (int j = 0; j < 16; ++j) { const f32x4 gg = gr[64 * j]; u32x2 w; w.x = pk2(v[j].x * rs * gg.x, v[j].y * rs * gg.y); w.y = pk2(v[j].z * rs * gg.z, v[j].w * rs * gg.w); o8[64 * j] = w; } }
            }
            SEAM(s0 + 0);
        }
        if (EN(1) && IN(s0 + 1)) for (int rep_ = 0; rep_ < NREP(1); ++rep_) { const int tid = opq(tid0), lane = tid & 63; (void)tid; (void)lane; CArgs* A = opq_args(); const int G = opqs(G0), bx = opqs(bx0), gw = opqs(gw0), NGW = G * NWAVES; (void)bx; (void)gw; (void)NGW;
            pg8::Gemm g{XN, (const bf16_t*)(wl + WL_IN), DM, DM, DM}; pg8::SchedPlain S; S.init(MT / 256, NINP / 256 - 4, G, bx, C_BG / 256, 4);
            if (I8N(l)) { pg8::EpiBf16I8 E{H, NINP, (const float*)(ws + WS_XS), (const float*)(ws + WS_WSC) + 8 + l}; pg8::gemm_phase<pg8::EpiBf16I8, pg8::SchedPlain, 2>(lds, g, S, E); }
            else { pg8::EpiBf16 E{H, NINP}; pg8::gemm_phase(lds, g, S, E); }
            SEAM(s0 + 1);
        }
        if (EN(2) && IN(s0 + 2)) for (int rep_ = 0; rep_ < NREP(2); ++rep_) { const int tid = opq(tid0), lane = tid & 63; (void)tid; (void)lane; CArgs* A = opq_args(); const int G = opqs(G0), bx = opqs(bx0), gw = opqs(gw0), NGW = G * NWAVES; (void)bx; (void)gw; (void)NGW;
            const float* gq = (const float*)A->in[4] + l * 64; const float* gk = (const float*)A->in[5] + l * 64;
            const float* gqa = (const float*)A->in[13] + l * 768; const float* gkva = (const float*)A->in[15] + l * 512;
            const float* cw = (const float*)A->in[8] + l * 4096; const float* cb = (const float*)A->in[9] + l * 1024;
            const bool dry = (NREP(2) == 2) && (rep_ == 0);
            for (int m = gw; m < MT; m += NGW) {
                bf16_t* hr = H + (size_t)m * NINP; bf16_t* hw = dry ? (bf16_t*)TMP + (size_t)m * NINP : hr;
                const int t = m & (SEQ - 1);
                u32x4 rq[2][2], rc0, rc1 = {0u, 0u, 0u, 0u}, rkv, ru[4][2];
#pragma unroll
                for (int qk = 0; qk < 2; ++qk) { rq[qk][0] = *(const u32x4*)(hr + qk * 1024 + 16 * lane); rq[qk][1] = *(const u32x4*)(hr + qk * 1024 + 16 * lane + 8); }
                rc0 = *(const u32x4*)(hr + C_CQ + 8 * lane); if (lane < 32) rc1 = *(const u32x4*)(hr + C_CQ + 8 * (64 + lane));
                rkv = *(const u32x4*)(hr + C_CKV + 8 * lane);
#pragma unroll
                for (int j = 0; j < 4; ++j) { const int tt = t + j - 2; const bool ok = (tt >= 0 && tt < SEQ); const bf16_t* ur = H + (size_t)(ok ? m + j - 2 : m) * NINP + C_BX + 16 * lane;
                    ru[j][0] = *(const u32x4*)ur; ru[j][1] = *(const u32x4*)(ur + 8); }
                float ca[8], sa[8];
                { const f32x4 c0 = *(const f32x4*)(cosA + m * 8), c1 = *(const f32x4*)(cosA + m * 8 + 4), s0_ = *(const f32x4*)(sinA + m * 8), s1_ = *(const f32x4*)(sinA + m * 8 + 4);
#pragma unroll
                  for (int e = 0; e < 4; ++e) { ca[e] = c0[e]; ca[4 + e] = c1[e]; sa[e] = s0_[e]; sa[4 + e] = s1_[e]; } }
#pragma unroll
                for (int qk = 0; qk < 2; ++qk) {
                    bf16_t* p = hw + qk * 1024 + 16 * lane;
                    float v[16]; unpack8(rq[qk][0], v); unpack8(rq[qk][1], v + 8);
                    float ss = 0.f;
#pragma unroll
                    for (int e = 0; e < 16; ++e) ss += v[e] * v[e];
                    ss += __shfl_xor(ss, 1); ss += __shfl_xor(ss, 2);
                    const float rs = rsqrtf(ss * (1.f / 64.f) + EPS);
                    const float* gg = (qk ? gk : gq) + 16 * (lane & 3);
#pragma unroll
                    for (int e = 0; e < 16; ++e) v[e] = v[e] * rs * gg[e];
                    if ((lane & 3) == 0) {
#pragma unroll
                        for (int i = 0; i < 8; ++i) { const float c = ca[i], sn = sa[i], x1 = v[i], x2 = v[i + 8]; v[i] = x1 * c - x2 * sn; v[i + 8] = x2 * c + x1 * sn; } }
                    if (qk == 0) {
#pragma unroll
                        for (int e = 0; e < 16; ++e) v[e] *= CA; }
                    *(u32x4*)p = pack8(v); *(u32x4*)(p + 8) = pack8(v + 8);
                }
                { bf16_t* p = hw + C_CQ; float v0[8], v1[8]; unpack8(rc0, v0); unpack8(rc1, v1);
                  float ss = 0.f;
#pragma unroll
                  for (int e = 0; e < 8; ++e) ss += v0[e] * v0[e] + v1[e] * v1[e];
                  const float rs = rsqrtf(wave_sum(ss) * (1.f / 768.f) + EPS);
#pragma unroll
                  for (int e = 0; e < 8; ++e) { v0[e] = v0[e] * rs * gqa[8 * lane + e]; }
                  *(u32x4*)(p + 8 * lane) = pack8(v0);
                  if (lane < 32) {
#pragma unroll
                      for (int e = 0; e < 8; ++e) v1[e] = v1[e] * rs * gqa[8 * (64 + lane) + e];
                      *(u32x4*)(p + 8 * (64 + lane)) = pack8(v1); } }
                { bf16_t* p = hw + C_CKV + 8 * lane; float v0[8]; unpack8(rkv, v0);
                  float ss = 0.f;
#pragma unroll
                  for (int e = 0; e < 8; ++e) ss += v0[e] * v0[e];
                  const float rs = rsqrtf(wave_sum(ss) * (1.f / 512.f) + EPS);
#pragma unroll
                  for (int e = 0; e < 8; ++e) v0[e] = v0[e] * rs * gkva[8 * lane + e];
                  *(u32x4*)p = pack8(v0); }
                { float a[16];
#pragma unroll
                  for (int e = 0; e < 16; ++e) a[e] = cb[16 * lane + e];
#pragma unroll
                  for (int j = 0; j < 4; ++j) { const int tt = t + j - 2;
                      if (tt >= 0 && tt < SEQ) { float uv[16]; unpack8(ru[j][0], uv); unpack8(ru[j][1], uv + 8);
#pragma unroll
                          for (int e = 0; e < 16; ++e) a[e] += cw[j * 1024 + 16 * lane + e] * uv[e]; } }
                  bf16_t* up = (dry ? (bf16_t*)TMP : UC) + (size_t)m * 1024 + 16 * lane; *(u32x4*)up = pack8(a); *(u32x4*)(up + 8) = pack8(a + 8); }
            }
            SEAM(s0 + 2);
        }
        if (EN(3) && IN(s0 + 3)) for (int rep_ = 0; rep_ < NREP(3); ++rep_) { const int tid = opq(tid0), lane = tid & 63; (void)tid; (void)lane; CArgs* A = opq_args(); const int G = opqs(G0), bx = opqs(bx0), gw = opqs(gw0), NGW = G * NWAVES; (void)bx; (void)gw; (void)NGW;
            const int GA = G / 2, GB = G - GA, cA = (bx < GA) ? bx : -1, cB = (bx >= GA) ? bx - GA : -1;
            if (I8N(l)) { pg8::Gemm g{XN, (const bf16_t*)(wl + WL_IN + (size_t)C_BG * DM), DM, DM, DM}; pg8::SchedPlain S; S.init(MT / 256, 4, GA, cA);
                pg8::EpiBf16I8 E{H + C_BG, NINP, (const float*)(ws + WS_XS), (const float*)(ws + WS_WSC) + 8 + l}; pg8::gemm_phase<pg8::EpiBf16I8, pg8::SchedPlain, 2>(lds, g, S, E); }
            else { pg8::Gemm g{XN, (const bf16_t*)(wl + WL_IN) + (size_t)C_BG * DM, DM, DM, DM}; pg8::SchedPlain S; S.init(MT / 256, 4, GA, cA); pg8::EpiBf16 E{H + C_BG, NINP}; pg8::gemm_phase(lds, g, S, E); }
            if (P3EN(0)) { pg8::Gemm g{H + C_CQ, (const bf16_t*)(wl + WL_UQ), NINP, 768, 768}; pg8::SchedPlain S; S.init(MT / 256, 1536 / 256, GB, cB); pg8::EpiBf16 E{QM, 1536}; pg8::gemm_phase(lds, g, S, E); }
            if (P3EN(1)) { pg8::Gemm g{H + C_CKV, (const bf16_t*)(wl + WL_UKV), NINP, 512, 512}; pg8::SchedPlain S; S.init(MT / 256, 2048 / 256, GB, cB); pg8::EpiBf16 E{KV, 2048}; pg8::gemm_phase(lds, g, S, E); }
            if (P3EN(2)) { pg8::Gemm g{UC, (const bf16_t*)(wl + WL_LRU), 1024, 256, 256}; pg8::SchedSplit S; S.init(MT / 256, 16, GA, GB, bx, P3_LRU_A * GA < 512 ? P3_LRU_A * GA : 512, 1);
              pg8::EpiLru E{UC, (const float*)A->in[11] + (size_t)l * 4096, (const float*)(ws + WS_SPT) + (size_t)l * 2048, LAB}; pg8::gemm_phase(lds, g, S, E); }
            if (P3EN(3)) { pg8::Gemm g{H + C_GLR, (const bf16_t*)(wl + WL_G), NINP, 256, 256}; pg8::SchedSplit S; const int gateA = I8N(l) ? P3_GATE_A + 1 : P3_GATE_A;
              S.init(MT / 256, 12288 / 256, GA, GB, bx, gateA * GA < 1536 ? gateA * GA : 1536);
              pg8::EpiSig E{GATES, 12288, (const float*)A->in[20] + (size_t)l * 12288}; pg8::gemm_phase(lds, g, S, E); }
            SEAM(s0 + 3);
        }
        if (EN(4) && IN(s0 + 4)) for (int rep_ = 0; rep_ < NREP(4); ++rep_) { const int tid = opq(tid0), lane = tid & 63; (void)tid; (void)lane; CArgs* A = opq_args(); const int G = opqs(G0), bx = opqs(bx0), gw = opqs(gw0), NGW = G * NWAVES; (void)bx; (void)gw; (void)NGW;
            const float* gq = (const float*)A->in[17] + l * 192; const float* gk = (const float*)A->in[18] + l * 192;
            const int half = lane >> 5, j = lane & 31; const bool act = j < 24; const int jj = act ? j : 0;
            const bool dry = (NREP(4) == 2) && (rep_ == 0);
            for (int m = gw; m < MT; m += NGW) {
                u32x4 qraw[4], kraw[4];
                const bf16_t* qrow = QM + (size_t)m * 1536 + half * 192 + 8 * jj; const bf16_t* kvrow = KV + (size_t)m * 2048 + half * 256 + 8 * (jj < 8 ? 0 : jj - 8);
                const u32x4 kpe = *(const u32x4*)(H + (size_t)m * NINP + C_KPE + 8 * (jj & 7));
#pragma unroll
                for (int hp = 0; hp < 4; ++hp) { qraw[hp] = *(const u32x4*)(qrow + hp * 384); kraw[hp] = *(const u32x4*)(kvrow + hp * 512); }
                float cs[8], sn[8];
                { const f32x4 c0 = *(const f32x4*)(cosC + m * 32 + 8 * (jj & 3)), c1 = *(const f32x4*)(cosC + m * 32 + 8 * (jj & 3) + 4), s0_ = *(const f32x4*)(sinC + m * 32 + 8 * (jj & 3)), s1_ = *(const f32x4*)(sinC + m * 32 + 8 * (jj & 3) + 4);
#pragma unroll
                  for (int e = 0; e < 4; ++e) { cs[e] = c0[e]; cs[4 + e] = c1[e]; sn[e] = s0_[e]; sn[4 + e] = s1_[e]; } }
#pragma unroll
                for (int hp = 0; hp < 4; ++hp) {
#pragma unroll
                    for (int qk = 0; qk < 2; ++qk) {
                        float v[8]; unpack8(qk == 0 ? qraw[hp] : (j < 8 ? kpe : kraw[hp]), v);
                        if (!act) {
#pragma unroll
                            for (int e = 0; e < 8; ++e) v[e] = 0.f; }
                        float ss = 0.f;
#pragma unroll
                        for (int e = 0; e < 8; ++e) ss += v[e] * v[e];
#pragma unroll
                        for (int o = 1; o < 32; o <<= 1) ss += __shfl_xor(ss, o);
                        const float rs = rsqrtf(ss * (1.f / 192.f) + EPS);
                        const float* gg = (qk ? gk : gq) + 8 * jj;
#pragma unroll
                        for (int e = 0; e < 8; ++e) v[e] = v[e] * rs * gg[e];
                        float pr[8];
#pragma unroll
                        for (int e = 0; e < 8; ++e) pr[e] = __shfl_xor(v[e], 4);
                        if (j < 8) {
#pragma unroll
                            for (int e = 0; e < 8; ++e) v[e] = (j < 4) ? v[e] * cs[e] - pr[e] * sn[e] : v[e] * cs[e] + pr[e] * sn[e]; }
                        if (qk == 0) {
#pragma unroll
                            for (int e = 0; e < 8; ++e) v[e] *= CM; }
                        if (act) { bf16_t* dst = (dry ? (bf16_t*)TMP + (size_t)qk * MT * 1536 : (qk == 0 ? QM : KM)) + (size_t)m * 1536 + (2 * hp + half) * 192 + 8 * j; *(u32x4*)dst = pack8(v); }
                    }
                }
            }
            for (int it = gw; it < 2048; it += NGW) {
                const int cg = it & 3, k = (it >> 2) & 127, b = (it >> 9) & 1, z = it >> 10, c = 256 * cg + 4 * lane;
                const unsigned* ap = LAB + ((size_t)z * MT + b * SEQ + 32 * k) * 1024 + c;
                f32x4 P = {1.f, 1.f, 1.f, 1.f}, Hh = {0.f, 0.f, 0.f, 0.f};
#pragma unroll 8
                for (int s = 0; s < 32; ++s) { const int t = z ? 31 - s : s; const u32x4 w = *(const u32x4*)(ap + (size_t)t * 1024);
                    const f32x4 a = {1.f - bf_lo(w.x), 1.f - bf_lo(w.y), 1.f - bf_lo(w.z), 1.f - bf_lo(w.w)}, x = {bf_hi(w.x), bf_hi(w.y), bf_hi(w.z), bf_hi(w.w)}; Hh = a * Hh + x; P = P * a; }
                *(f32x4*)(AGP + ((size_t)(z * 2 + b) * 128 + k) * 1024 + c) = P; *(f32x4*)(AGH + ((size_t)(z * 2 + b) * 128 + k) * 1024 + c) = Hh;
            }
            SEAM(s0 + 4);
        }
        if (EN(5) && IN(s0 + 5)) for (int rep_ = 0; rep_ < NREP(5); ++rep_) { const int tid = opq(tid0), lane = tid & 63; (void)tid; (void)lane; CArgs* A = opq_args(); const int G = opqs(G0), bx = opqs(bx0), gw = opqs(gw0), NGW = G * NWAVES; (void)bx; (void)gw; (void)NGW;
            const int r32 = lane & 31, hh = lane >> 5;
            float negA, negC, lam;
            { const float* gq = (const float*)A->in[4] + l * 64; const float* gk = (const float*)A->in[5] + l * 64;
              const float mq = wave_max(fabsf(gq[lane])), mk = wave_max(fabsf(gk[lane]));
              negA = -(8.f * mq * mk * LOG2E * 1.01f);
              const float* gq2 = (const float*)A->in[17] + l * 192; const float* gk2 = (const float*)A->in[18] + l * 192;
              const float mq2 = wave_max(fmaxf(fmaxf(fabsf(gq2[lane]), fabsf(gq2[64 + lane])), fabsf(gq2[128 + lane])));
              const float mk2 = wave_max(fmaxf(fmaxf(fabsf(gk2[lane]), fabsf(gk2[64 + lane])), fabsf(gk2[128 + lane])));
              negC = -(13.856406460551018f * mq2 * mk2 * LOG2E * 1.01f);
              const float* lp = (const float*)A->in[6] + l * 256;
              const float s1 = wave_sum(lp[lane] * lp[64 + lane]), s2 = wave_sum(lp[128 + lane] * lp[192 + lane]);
              lam = expf(s1) - expf(s2) + (0.8f - 0.6f * expf(-0.3f * (float)l)); }
            const int cls = (bx >> 3) & 3;
            if (cls == 0) { asm volatile("s_waitcnt vmcnt(0) lgkmcnt(0)" ::: "memory"); __syncthreads(); { const int tidc = opq(tid0); CArgs* Ac = opq_args(); conv_layer(Ac, lds, wave, l, 1, tidc, tidc & 63, opqs(G0), opqs(bx0), opqs(gw0), opqs(G0) * NWAVES); if (l + 1 < DEPTH) conv_layer(Ac, lds, wave, l + 1, 0, tidc, tidc & 63, opqs(G0), opqs(bx0), opqs(gw0), opqs(G0) * NWAVES); } asm volatile("s_waitcnt vmcnt(0) lgkmcnt(0)" ::: "memory"); __syncthreads(); }
            for (int u = bx; u < 256; u += G) {
                const int jj = u >> 3, bh = 2 * (u & 7) + (jj >> 4), qb = jj & 15, b = bh >> 3, h = bh & 7;
                const size_t row0 = (size_t)b * SEQ + qb * 256, krow0 = (size_t)b * SEQ;
                f32x16 o[4];
                if (P5EN(0)) for (int n4_ = 0; n4_ < ((P5DUP & 1) ? 4 : 2); ++n4_) { const int n = n4_ & 1;
                    if (n4_ == 1) { if (cls == 1) { asm volatile("s_waitcnt vmcnt(0) lgkmcnt(0)" ::: "memory"); __syncthreads(); { const int tidc = opq(tid0); CArgs* Ac = opq_args(); conv_layer(Ac, lds, wave, l, 1, tidc, tidc & 63, opqs(G0), opqs(bx0), opqs(gw0), opqs(G0) * NWAVES); if (l + 1 < DEPTH) conv_layer(Ac, lds, wave, l + 1, 0, tidc, tidc & 63, opqs(G0), opqs(bx0), opqs(gw0), opqs(G0) * NWAVES); } asm volatile("s_waitcnt vmcnt(0) lgkmcnt(0)" ::: "memory"); __syncthreads(); } }
                    att::attn_body_dma<1>(H + row0 * NINP + C_AQ + h * 128 + n * 64, NINP, H + krow0 * NINP + C_AK + h * 128 + n * 64, NINP, H + krow0 * NINP + C_AV + h * 128, NINP, negA, (LAS char*)lds, o);
                    { const int le = opq(lane), r32e = le & 31, hhe = le >> 5;
                      float* dbase = DBUF + (row0 + wave * 32 + 4 * hhe) * 1024 + h * 128 + r32e;
                      if (n == 0) {
#pragma unroll
                          for (int r = 0; r < 16; ++r) { float* dp = dbase + ((r & 3) + 8 * (r >> 2)) * 1024;
#pragma unroll
                              for (int d0 = 0; d0 < 4; ++d0) dp[d0 * 32] = o[d0][r]; }
                      } else {
                          const float* sg = (const float*)A->in[7] + l * 128 + r32e; const float omli = 1.f - (0.8f - 0.6f * expf(-0.3f * (float)l));
                          const float g0 = sg[0] * omli, g1 = sg[32] * omli, g2 = sg[64] * omli, g3 = sg[96] * omli;
                          bf16_t* obase = OCAT + (row0 + wave * 32 + 4 * hhe) * 3072 + h * 128 + r32e;
#pragma unroll
                          for (int r = 0; r < 16; ++r) { const float* dp = dbase + ((r & 3) + 8 * (r >> 2)) * 1024;
                              const float e0 = dp[0] - lam * o[0][r], e1 = dp[32] - lam * o[1][r], e2 = dp[64] - lam * o[2][r], e3 = dp[96] - lam * o[3][r];
                              float ss = (e0 * e0 + e1 * e1) + (e2 * e2 + e3 * e3);
#pragma unroll
                              for (int of = 1; of < 32; of <<= 1) ss += __shfl_xor(ss, of);
                              const float rs = rsqrtf(ss * (1.f / 128.f) + EPS);
                              bf16_t* op = obase + ((r & 3) + 8 * (r >> 2)) * 3072;
                              op[0] = (bf16_t)f2bf(e0 * rs * g0); op[32] = (bf16_t)f2bf(e1 * rs * g1); op[64] = (bf16_t)f2bf(e2 * rs * g2); op[96] = (bf16_t)f2bf(e3 * rs * g3); }
                      } }
                }
                if (cls == 2) { asm volatile("s_waitcnt vmcnt(0) lgkmcnt(0)" ::: "memory"); __syncthreads(); { const int tidc = opq(tid0); CArgs* Ac = opq_args(); conv_layer(Ac, lds, wave, l, 1, tidc, tidc & 63, opqs(G0), opqs(bx0), opqs(gw0), opqs(G0) * NWAVES); if (l + 1 < DEPTH) conv_layer(Ac, lds, wave, l + 1, 0, tidc, tidc & 63, opqs(G0), opqs(bx0), opqs(gw0), opqs(G0) * NWAVES); } asm volatile("s_waitcnt vmcnt(0) lgkmcnt(0)" ::: "memory"); __syncthreads(); }
                for (int r5_ = 0; r5_ < ((P5DUP & 2) ? 2 : 1); ++r5_) {
                if (P5EN(1)) att::attn_body_dma<3>(QM + row0 * 1536 + h * 192, 1536, KM + krow0 * 1536 + h * 192, 1536, KV + krow0 * 2048 + h * 256 + 128, 2048, negC, (LAS char*)lds, o);
                if (P5EN(1)) { const int le = opq(lane), r32e = le & 31, hhe = le >> 5;
                  bf16_t* obase = OCAT + (row0 + wave * 32 + 4 * hhe) * 3072 + 2048 + h * 128 + r32e;
#pragma unroll
                  for (int r = 0; r < 16; ++r) { bf16_t* op = obase + ((r & 3) + 8 * (r >> 2)) * 3072;
#pragma unroll
                      for (int d0 = 0; d0 < 4; ++d0) op[d0 * 32] = (bf16_t)f2bf(o[d0][r]); } }
                }
            }
            if (cls == 3) { asm volatile("s_waitcnt vmcnt(0) lgkmcnt(0)" ::: "memory"); __syncthreads(); { const int tidc = opq(tid0); CArgs* Ac = opq_args(); conv_layer(Ac, lds, wave, l, 1, tidc, tidc & 63, opqs(G0), opqs(bx0), opqs(gw0), opqs(G0) * NWAVES); if (l + 1 < DEPTH) conv_layer(Ac, lds, wave, l + 1, 0, tidc, tidc & 63, opqs(G0), opqs(bx0), opqs(gw0), opqs(G0) * NWAVES); } asm volatile("s_waitcnt vmcnt(0) lgkmcnt(0)" ::: "memory"); __syncthreads(); }
            for (int r6_ = 0; r6_ < ((P5DUP & 4) ? 2 : 1); ++r6_)
            for (int it = gw; it < 4096; it += NGW) {
                const int cgp = it & 15, k = (it >> 4) & 127, b = it >> 11, c = 64 * cgp + lane;
                float cf = 0.f, cbk = 0.f;
                { const float* Pf = AGP + ((size_t)(0 * 2 + b) * 128) * 1024 + c; const float* Hf = AGH + ((size_t)(0 * 2 + b) * 128) * 1024 + c;
                  for (int j0 = 0; j0 < k; j0 += 32) {
                      float pp[32], hh[32];
#pragma unroll
                      for (int i = 0; i < 32; ++i) { const int j = (j0 + i < k) ? j0 + i : k - 1; pp[i] = Pf[(size_t)j * 1024]; hh[i] = Hf[(size_t)j * 1024]; }
#pragma unroll
                      for (int i = 0; i < 32; ++i) if (j0 + i < k) cf = pp[i] * cf + hh[i];
                  }
                  const float* Pb = AGP + ((size_t)(1 * 2 + b) * 128) * 1024 + c; const float* Hb = AGH + ((size_t)(1 * 2 + b) * 128) * 1024 + c;
                  for (int j0 = 127; j0 > k; j0 -= 32) {
                      float pp[32], hh[32];
#pragma unroll
                      for (int i = 0; i < 32; ++i) { const int j = (j0 - i > k) ? j0 - i : k + 1; pp[i] = Pb[(size_t)j * 1024]; hh[i] = Hb[(size_t)j * 1024]; }
#pragma unroll
                      for (int i = 0; i < 32; ++i) if (j0 - i > k) cbk = pp[i] * cbk + hh[i];
                  } }
                const size_t m0 = (size_t)b * SEQ + 32 * k;
                float hb[32]; float hcur = cbk;
#pragma unroll
                for (int s = 31; s >= 0; --s) { const unsigned w = LAB[((size_t)MT + m0 + s) * 1024 + c]; hcur = (1.f - bf_lo(w)) * hcur + bf_hi(w); hb[s] = hcur; }
                hcur = cf;
#pragma unroll
                for (int hf = 0; hf < 2; ++hf) {
                    float fa[16], fx[16], fg[16];
#pragma unroll
                    for (int s = 0; s < 16; ++s) { const size_t mm = m0 + 16 * hf + s; { const unsigned w = LAB[mm * 1024 + c]; fa[s] = 1.f - bf_lo(w); fx[s] = bf_hi(w); } fg[s] = bf2f(H[mm * NINP + C_BG + c]); }
#pragma unroll
                    for (int s = 0; s < 16; ++s) { hcur = fa[s] * hcur + fx[s];
                        OCAT[(m0 + 16 * hf + s) * 3072 + 1024 + c] = (bf16_t)f2bf((hcur + hb[16 * hf + s]) * gelu_tanh(fg[s])); }
                }
            }

            SEAM(s0 + 5);
        }
        if (EN(6) && IN(s0 + 6)) for (int rep_ = 0; rep_ < NREP(6); ++rep_) { const int tid = opq(tid0), lane = tid & 63; (void)tid; (void)lane; CArgs* A = opq_args(); const int G = opqs(G0), bx = opqs(bx0), gw = opqs(gw0), NGW = G * NWAVES; (void)bx; (void)gw; (void)NGW;
        }
        if (EN(7) && IN(s0 + 7)) for (int rep_ = 0; rep_ < NREP(7); ++rep_) { const int tid = opq(tid0), lane = tid & 63; (void)tid; (void)lane; CArgs* A = opq_args(); const int G = opqs(G0), bx = opqs(bx0), gw = opqs(gw0), NGW = G * NWAVES; (void)bx; (void)gw; (void)NGW;
            pg8::Gemm g{OCAT, (const bf16_t*)(wl + WL_BO), 3072, 3072, 1024}; pg8::SchedBo S; S.init(MT / 256, DM / 256, G, bx);
            pg8::EpiBo E{GATES, YSUM, F8O(l) ? 1 : 0};
            pg8::gemm_phase(lds, g, S, E);
            SEAM(s0 + 7);
        }
        if (EN(8) && IN(s0 + 8)) for (int rep_ = 0; rep_ < NREP(8); ++rep_) { const int tid = opq(tid0), lane = tid & 63; (void)tid; (void)lane; CArgs* A = opq_args(); const int G = opqs(G0), bx = opqs(bx0), gw = opqs(gw0), NGW = G * NWAVES; (void)bx; (void)gw; (void)NGW;
            pg8::Gemm g{YSUM, (const bf16_t*)(wl + WL_OUT), DM, DM, DM}; pg8::SchedPlain S; S.init(MT / 256, DM / 256, G, bx);
            if (F8O(l)) { pg8::EpiRes E{xcur, ((NREP(8) == 2) && (rep_ == 0)) ? TMP : out, W8_INV}; pg8::gemm_phase<pg8::EpiRes, pg8::SchedPlain, 1>(lds, g, S, E); }
            else { pg8::EpiRes E{xcur, ((NREP(8) == 2) && (rep_ == 0)) ? TMP : out, 1.f}; pg8::gemm_phase(lds, g, S, E); }
            SEAM(s0 + 8);
        }
        if (EN(9) && IN(s0 + 9)) for (int rep_ = 0; rep_ < NREP(9); ++rep_) { const int tid = opq(tid0), lane = tid & 63; (void)tid; (void)lane; CArgs* A = opq_args(); const int G = opqs(G0), bx = opqs(bx0), gw = opqs(gw0), NGW = G * NWAVES; (void)bx; (void)gw; (void)NGW;
            const float* g = (const float*)A->in[23] + (size_t)l * DM;
            for (int m = gw; m < MT; m += NGW) {
                const f32x4* xr = (const f32x4*)(out + (size_t)m * DM) + lane;
                f32x4 v[16]; float ss = 0.f;
#pragma unroll
                for (int j = 0; j < 16; ++j) { v[j] = xr[64 * j]; ss += (v[j].x * v[j].x + v[j].y * v[j].y) + (v[j].z * v[j].z + v[j].w * v[j].w); }
                const float rs = rsqrtf(wave_sum(ss) * (1.f / DM) + EPS);
                const f32x4* gr = (const f32x4*)g + lane;
                if (I8U(l)) {
                    float amx = 0.f, ssy = 0.f;
#pragma unroll
                    for (int j = 0; j < 16; ++j) { const f32x4 gg = gr[64 * j]; v[j].x = v[j].x * rs * gg.x; v[j].y = v[j].y * rs * gg.y; v[j].z = v[j].z * rs * gg.z; v[j].w = v[j].w * rs * gg.w;
                        ssy += (v[j].x * v[j].x + v[j].y * v[j].y) + (v[j].z * v[j].z + v[j].w * v[j].w);
                        amx = fmaxf(fmaxf(amx, fmaxf(fabsf(v[j].x), fabsf(v[j].y))), fmaxf(fabsf(v[j].z), fabsf(v[j].w))); }
                    amx = wave_max(amx); const float clipv = fminf(amx, 4.2f * sqrtf(wave_sum(ssy) * (1.f / DM)));
                    const float sc = (clipv > 0.f) ? clipv * (1.f / 127.f) : 1.f, inv = 1.f / sc;
                    unsigned* o4 = (unsigned*)((unsigned char*)XN + (size_t)m * DM) + lane;
#pragma unroll
                    for (int j = 0; j < 16; ++j) o4[64 * j] = pk_i8x4(v[j].x * inv, v[j].y * inv, v[j].z * inv, v[j].w * inv);
                    if (lane == 0) ((float*)(ws + WS_XS))[m] = sc; }
                else if (F8U(l)) { unsigned* o4 = (unsigned*)((unsigned char*)XN + (size_t)m * DM) + lane;
#pragma unroll
                    for (int j = 0; j < 16; ++j) { const f32x4 gg = gr[64 * j]; o4[64 * j] = pk_fp8x4(v[j].x * rs * gg.x, v[j].y * rs * gg.y, v[j].z * rs * gg.z, v[j].w * rs * gg.w); } }
                else { u32x2* o8 = (u32x2*)(XN + (size_t)m * DM) + lane;
#pragma unroll
                    for (int j = 0; j < 16; ++j) { const f32x4 gg = gr[64 * j]; u32x2 w; w.x = pk2(v[j].x * rs * gg.x, v[j].y * rs * gg.y); w.y = pk2(v[j].z * rs * gg.z, v[j].w * rs * gg.w); o8[64 * j] = w; } }
            }
            SEAM(s0 + 9);
        }
        if (EN(10) && IN(s0 + 10)) for (int rep_ = 0; rep_ < NREP(10); ++rep_) { const int tid = opq(tid0), lane = tid & 63; (void)tid; (void)lane; CArgs* A = opq_args(); const int G = opqs(G0), bx = opqs(bx0), gw = opqs(gw0), NGW = G * NWAVES; (void)bx; (void)gw; (void)NGW;
            pg8::Gemm g{XN, (const bf16_t*)(wl + WL_GU), DM, DM, DM}; pg8::SchedPlain S; S.init(MT / 256, 2 * FFH / 256, G, bx);
            if (I8U(l)) { pg8::EpiSwigluI8 E{(void*)HID, (const float*)(ws + WS_XS), (const float*)(ws + WS_WSC) + 2 * l, F8L(l) ? 1 : 0}; pg8::gemm_phase<pg8::EpiSwigluI8, pg8::SchedPlain, 2>(lds, g, S, E); }
            else if (F8U(l)) { pg8::EpiSwiglu<true> E{(void*)HID, W8_INV}; pg8::gemm_phase<pg8::EpiSwiglu<true>, pg8::SchedPlain, 1>(lds, g, S, E); }
            else if (F8L(l)) { pg8::EpiSwiglu<true> E{(void*)HID, 1.f}; pg8::gemm_phase(lds, g, S, E); }
            else { pg8::EpiSwiglu<false> E{(void*)HID, 1.f}; pg8::gemm_phase(lds, g, S, E); }
            SEAM(s0 + 10);
        }
        if (EN(11) && IN(s0 + 11)) for (int rep_ = 0; rep_ < NREP(11); ++rep_) { const int tid = opq(tid0), lane = tid & 63; (void)tid; (void)lane; CArgs* A = opq_args(); const int G = opqs(G0), bx = opqs(bx0), gw = opqs(gw0), NGW = G * NWAVES; (void)bx; (void)gw; (void)NGW;
            pg8::Gemm g{HID, (const bf16_t*)(wl + WL_DN), FFH, FFH, FFH}; pg8::SchedPlain S; S.init(MT / 256, DM / 256, G, bx);
            const bool dry11 = (NREP(11) == 2) && (rep_ == 0);
            if (F8L(l)) { pg8::EpiRes E{(const float*)out, dry11 ? TMP : out, W8_INV}; pg8::gemm_phase<pg8::EpiRes, pg8::SchedPlain, 1>(lds, g, S, E); }
            else { pg8::EpiRes E{(const float*)out, dry11 ? TMP : out, 1.f}; pg8::gemm_phase<pg8::EpiRes, pg8::SchedPlain, 0>(lds, g, S, E); }
            SEAM(s0 + 11);
        }
    }
#undef IN
#undef SEAM
#undef cosA
#undef sinA
#undef cosC
#undef sinC
#undef XN
#undef H
#undef UC
#undef QM
#undef KV
#undef KM
#undef LAB
#undef AGP
#undef AGH
#undef GATES
#undef DBUF
#undef OCAT
#undef TMP
#undef YSUM
#undef HID
#undef x_in
#undef out
#undef ws
#undef wl
#undef xcur
}


#ifdef PROBE_S
__global__ void probe_dump(const unsigned char* ws_, float* outp) {
    for (size_t i = (size_t)blockIdx.x * 256 + threadIdx.x; i < (size_t)MT * DM; i += (size_t)gridDim.x * 256) {
        const size_t m = i / DM, c = i % DM; float v = 0.f;
        const bf16_t* Hh = (const bf16_t*)(ws_ + WS_H); v += bf2f(Hh[m * NINP + c]) + bf2f(Hh[m * NINP + 2816 + c]);
        v += bf2f(((const bf16_t*)(ws_ + WS_UC))[m * 1024 + (c & 1023)]);
        v += bf2f(((const bf16_t*)(ws_ + WS_QM))[m * 1536 + (c % 1536)]) + bf2f(((const bf16_t*)(ws_ + WS_KM))[m * 1536 + (c % 1536)]) + bf2f(((const bf16_t*)(ws_ + WS_KV))[m * 2048 + (c & 2047)]);
        v += bf_hi(((const unsigned*)(ws_ + WS_LAB))[m * 1024 + (c & 1023)]) + bf_hi(((const unsigned*)(ws_ + WS_LAB))[((size_t)MT + m) * 1024 + (c & 1023)]);
        v += ((const float*)(ws_ + WS_AGP))[i % (2 * 2 * 128 * 1024)] + ((const float*)(ws_ + WS_AGH))[i % (2 * 2 * 128 * 1024)];
        const bf16_t* Gg = (const bf16_t*)(ws_ + WS_GATES); v += bf2f(Gg[m * 12288 + c]) + bf2f(Gg[m * 12288 + 4096 + c]) + bf2f(Gg[m * 12288 + 8192 + c]);
#if PROBE_S >= 7
        v += ((const float*)(ws_ + WS_DBUF))[m * 1024 + (c & 1023)];
        v += bf2f(((const bf16_t*)(ws_ + WS_OCAT))[m * 3072 + 2048 + (c & 1023)]);
#endif
#if PROBE_S >= 8
        v += bf2f(((const bf16_t*)(ws_ + WS_OCAT))[m * 3072 + (c % 3072)]);
#endif
#if PROBE_S >= 9
        v += bf2f(((const bf16_t*)(ws_ + WS_YSUM))[m * DM + c]);
#endif
        outp[i] = v;
    }
}
#endif

extern "C" void kernel_launch(void* const* d_in, const int* in_sizes, int n_in, void* d_out, int out_size, void* d_ws, size_t ws_size, hipStream_t stream) {
    static int grid = 0;
    if (grid == 0) {
        if (n_in != 27 || out_size != MT * DM || ws_size < WS_END) { fprintf(stderr, "kernel_launch: shape mismatch: n_in %d out %d ws %zu (need %zu)\n", n_in, out_size, ws_size, (size_t)WS_END); grid = -1; return; }
        int dev = 0, cus = 0, per_cu = 0;
        if (hipGetDevice(&dev) != hipSuccess || hipDeviceGetAttribute(&cus, hipDeviceAttributeMultiprocessorCount, dev) != hipSuccess) { grid = -1; return; }
        if (hipFuncSetAttribute((const void*)fwd, hipFuncAttributeMaxDynamicSharedMemorySize, LDS_BYTES) != hipSuccess) { fprintf(stderr, "kernel_launch: hipFuncSetAttribute failed\n"); grid = -1; return; }
        if (hipOccupancyMaxActiveBlocksPerMultiprocessor(&per_cu, (const void*)fwd, NWAVES * 64, LDS_BYTES) != hipSuccess || per_cu < 1) { fprintf(stderr, "kernel_launch: occupancy query says %d\n", per_cu); }
        (void)hipGetLastError();
        grid = cus;
    }
    if (grid < 0) return;
    if (hipMemsetAsync((char*)d_ws + WS_CTL, 0, CTL_BYTES, stream) != hipSuccess) return;
    Args a{};
    for (int i = 0; i < 27; ++i) a.in[i] = d_in[i];
    a.out = (float*)d_out; a.ws = (unsigned char*)d_ws;
#if MK_ONE_LAUNCH
    a.step_lo = 0; a.step_hi = NSTEP;
    hipLaunchKernelGGL(fwd, dim3(grid), dim3(NWAVES * 64), LDS_BYTES, stream, a);
#else
#ifdef PROBE_S
    for (int s = 0; s < PROBE_S; ++s) { a.step_lo = s; a.step_hi = s + 1; hipLaunchKernelGGL(fwd, dim3(grid), dim3(NWAVES * 64), LDS_BYTES, stream, a); }
    hipLaunchKernelGGL(probe_dump, dim3(2048), dim3(256), 0, stream, (const unsigned char*)d_ws, (float*)d_out);
#else
    for (int s = 0; s < NSTEP; ++s) { a.step_lo = s; a.step_hi = s + 1; hipLaunchKernelGGL(fwd, dim3(grid), dim3(NWAVES * 64), LDS_BYTES, stream, a); }
#endif
#endif
    const hipError_t le = hipPeekAtLastError();
    if (le != hipSuccess) fprintf(stderr, "kernel_launch: launch failed: %s\n", hipGetErrorName(le));
}
```

```cpp
#include <hip/hip_runtime.h>
#include <cstdio>
#include <cstdint>

#ifndef P3_LRU_A
#define P3_LRU_A 1
#endif
#ifndef P3_GATE_A
#define P3_GATE_A 7
#endif
#ifndef P5DUP
#define P5DUP 0
#endif
#ifndef F8_LAYERS
#define F8_LAYERS 0xE
#endif
#define F8L(l) ((((F8_LAYERS) >> (l)) & 1) != 0)
#ifndef F8UP_LAYERS
#define F8UP_LAYERS 0x8
#endif
#ifndef I8UP_LAYERS
#define I8UP_LAYERS 0xF
#endif
#define I8U(l) ((((I8UP_LAYERS) >> (l)) & 1) != 0)
#ifndef I8IN_LAYERS
#define I8IN_LAYERS 0x8
#endif
#define I8N(l) ((((I8IN_LAYERS) >> (l)) & 1) != 0)
#define F8U(l) ((((F8UP_LAYERS) & (F8_LAYERS) & ~(I8UP_LAYERS)) >> (l)) & 1)
#ifndef F8OUT_LAYERS
#define F8OUT_LAYERS 0x0
#endif
#define F8O(l) ((((F8OUT_LAYERS) >> (l)) & 1) != 0)
#ifndef MK_ONE_LAUNCH
#define MK_ONE_LAUNCH 1
#endif

#define LAS __attribute__((address_space(3)))
#define GAS __attribute__((address_space(1)))
typedef unsigned short bf16_t;
typedef short bf16x8 __attribute__((ext_vector_type(8)));
typedef short s16x4 __attribute__((ext_vector_type(4)));
typedef float f32x2 __attribute__((ext_vector_type(2)));
typedef float f32x4 __attribute__((ext_vector_type(4)));
typedef float f32x16 __attribute__((ext_vector_type(16)));
typedef unsigned u32x2 __attribute__((ext_vector_type(2)));
typedef unsigned u32x4 __attribute__((ext_vector_type(4)));
typedef GAS unsigned gu32;

constexpr int DM = 4096, BATCH = 2, SEQ = 4096, MT = BATCH * SEQ, DEPTH = 4;
constexpr int NIN = 6720, NINP = 6912, FFH = 11008;
constexpr int C_AQ = 0, C_AK = 1024, C_AV = 2048, C_BG = 3072, C_BX = 4096, C_CQ = 5120, C_CKV = 5888, C_KPE = 6400, C_GLR = 6464;
constexpr float EPS = 1e-6f;
constexpr float LOG2E = 1.4426950408889634f;
constexpr float CA = 0.125f * LOG2E;
constexpr float CM = 0.07216878364870323f * LOG2E;
constexpr int NSTEP = 1 + 12 * DEPTH;

constexpr size_t WS_CTL = 0, CTL_BYTES = 1u << 20;
constexpr size_t WS_COSA = CTL_BYTES;
constexpr size_t WS_SINA = WS_COSA + (size_t)MT * 8 * 4;
constexpr size_t WS_COSC = WS_SINA + (size_t)MT * 8 * 4;
constexpr size_t WS_SINC = WS_COSC + (size_t)MT * 32 * 4;
constexpr size_t WS_SPT  = WS_SINC + (size_t)MT * 32 * 4;
constexpr size_t WS_XS   = WS_SPT  + (size_t)DEPTH * 2048 * 4;
constexpr size_t WS_WSC  = WS_XS   + (size_t)MT * 4;
constexpr size_t WS_XN   = WS_WSC  + 256;
constexpr size_t WS_H    = WS_XN   + (size_t)MT * DM * 2;
constexpr size_t WS_UC   = WS_H    + (size_t)MT * NINP * 2;
constexpr size_t WS_QM   = WS_UC   + (size_t)MT * 1024 * 2;
constexpr size_t WS_KV   = WS_QM   + (size_t)MT * 1536 * 2;
constexpr size_t WS_KM   = WS_KV   + (size_t)MT * 2048 * 2;
constexpr size_t WS_LAB  = WS_KM   + (size_t)MT * 1536 * 2;
constexpr size_t WS_AGP  = WS_LAB  + (size_t)2 * MT * 1024 * 4;
constexpr size_t WS_AGH  = WS_AGP  + (size_t)2 * 2 * 128 * 1024 * 4;
constexpr size_t WS_GATES= WS_AGH  + (size_t)2 * 2 * 128 * 1024 * 4;
constexpr size_t WS_DBUF = WS_GATES+ (size_t)MT * 12288 * 2;
constexpr size_t WS_OCAT = WS_DBUF + (size_t)MT * 1024 * 4;
constexpr size_t WS_TMP  = WS_OCAT + (size_t)MT * 3072 * 2;
constexpr size_t WS_YSUM = WS_TMP  + (size_t)MT * DM * 4;
constexpr size_t WS_HID  = WS_YSUM + (size_t)MT * DM * 2;
constexpr size_t WS_W    = WS_HID  + (size_t)MT * FFH * 2;
constexpr size_t WL_IN = 0;
constexpr size_t WL_UQ = WL_IN + (size_t)NINP * DM * 2;
constexpr size_t WL_UKV= WL_UQ + (size_t)1536 * 768 * 2;
constexpr size_t WL_LRU= WL_UKV+ (size_t)2048 * 512 * 2;
constexpr size_t WL_G  = WL_LRU+ (size_t)4096 * 256 * 2;
constexpr size_t WL_BO = WL_G  + (size_t)12288 * 256 * 2;
constexpr size_t WL_OUT= WL_BO + (size_t)4096 * 3072 * 2;
constexpr size_t WL_GU = WL_OUT+ (size_t)4096 * 4096 * 2;
constexpr size_t WL_DN = WL_GU + (size_t)22016 * 4096 * 2;
constexpr size_t WL_SIZE = WL_DN + (size_t)4096 * FFH * 2;
constexpr size_t WS_END = WS_W + DEPTH * WL_SIZE;
static_assert(WS_XN % 256 == 0 && WS_W % 256 == 0 && WL_SIZE % 256 == 0, "alignment");

constexpr int CW_TMO = 0, CW_BAR = 4096;

constexpr int RING_BYTES = 131072, ATT_BYTES = 141312  , LDSCTL_OFF = ATT_BYTES, MISC_OFF = LDSCTL_OFF + 320, LDS_BYTES = 147456;
constexpr int NWAVES = 8;

__device__ __forceinline__ unsigned f2bf(float f) { unsigned u = __builtin_bit_cast(unsigned, f); return (u + 0x7fffu + ((u >> 16) & 1u)) >> 16; }
__device__ __forceinline__ unsigned pk2(float lo, float hi) { return f2bf(lo) | (f2bf(hi) << 16); }
typedef __bf16 bf16x2_t __attribute__((ext_vector_type(2)));
__device__ __forceinline__ unsigned cvt_pk_bf16(float lo, float hi) { f32x2 v = {lo, hi}; bf16x2_t b = __builtin_convertvector(v, bf16x2_t); return __builtin_bit_cast(unsigned, b); }
__device__ __forceinline__ float bf_lo(unsigned w) { return __builtin_bit_cast(float, w << 16); }
__device__ __forceinline__ float bf_hi(unsigned w) { return __builtin_bit_cast(float, w & 0xffff0000u); }
__device__ __forceinline__ float bf2f(bf16_t b) { return __builtin_bit_cast(float, (unsigned)b << 16); }
__device__ __forceinline__ void unpack8(u32x4 w, float* v) { v[0] = bf_lo(w.x); v[1] = bf_hi(w.x); v[2] = bf_lo(w.y); v[3] = bf_hi(w.y); v[4] = bf_lo(w.z); v[5] = bf_hi(w.z); v[6] = bf_lo(w.w); v[7] = bf_hi(w.w); }
__device__ __forceinline__ u32x4 pack8(const float* v) { u32x4 w; w.x = pk2(v[0], v[1]); w.y = pk2(v[2], v[3]); w.z = pk2(v[4], v[5]); w.w = pk2(v[6], v[7]); return w; }
__device__ __forceinline__ float wave_sum(float v) {
#pragma unroll
    for (int o = 1; o < 64; o <<= 1) v += __shfl_xor(v, o);
    return v;
}
__device__ __forceinline__ float wave_max(float v) {
#pragma unroll
    for (int o = 1; o < 64; o <<= 1) v = fmaxf(v, __shfl_xor(v, o));
    return v;
}
__device__ __forceinline__ float sigmoidf_(float x) { return __builtin_amdgcn_rcpf(1.f + __builtin_amdgcn_exp2f(-1.4426950408889634f * x)); }
__device__ __forceinline__ float gelu_tanh(float x) { const float y = 0.7978845608028654f * (x + 0.044715f * x * x * x); const float t = 1.f - 2.f / (__expf(2.f * y) + 1.f); return 0.5f * x * (1.f + t); }
__device__ __forceinline__ int opq(int x) { asm volatile("" : "+v"(x)); return x; }
__device__ __forceinline__ int opqs(int x) { asm volatile("" : "+s"(x)); return x; }
__device__ __forceinline__ float clamp_f8(float x) { return __builtin_amdgcn_fmed3f(x, -448.f, 448.f); }
__device__ __forceinline__ unsigned pk_fp8x4(float a, float b, float c, float d) { int w = 0; w = __builtin_amdgcn_cvt_pk_fp8_f32(clamp_f8(a), clamp_f8(b), w, false); w = __builtin_amdgcn_cvt_pk_fp8_f32(clamp_f8(c), clamp_f8(d), w, true); return (unsigned)w; }
__device__ __forceinline__ unsigned q8(float x) { return (unsigned)(int)__builtin_amdgcn_fmed3f(__builtin_rintf(x), -127.f, 127.f) & 0xffu; }
__device__ __forceinline__ unsigned pk_i8x4(float a, float b, float c, float d) { return q8(a) | (q8(b) << 8) | (q8(c) << 16) | (q8(d) << 24); }
constexpr float W8_SCALE = 64.f, W8_INV = 1.f / 64.f;
#define LDS_WAIT() asm volatile("s_waitcnt lgkmcnt(0)" ::: "memory")

namespace pg8 {
constexpr int BM = 256, BK = 64, HALF = 128, HTB = HALF * BK * 2, NXCD = 8, WGM = 8;
__host__ __device__ __forceinline__ int lds_byte(int r, int c) { const int st = (r >> 4) * 2 + (c >> 5), rr = r & 15, cc = c & 31, ob = rr * 64 + cc * 2; return st * 1024 + (ob ^ (((ob >> 9) & 1) << 5)); }
__host__ __device__ __forceinline__ void stage_rc(int b, int& R, int& C) { const int st = b / 1024, sb = b % 1024, swz = sb ^ (((sb >> 9) & 1) << 5); R = (st >> 1) * 16 + swz / 64; C = (st & 1) * 32 + (swz % 64) / 2; }
__host__ __device__ __forceinline__ int perm32(int rho) { const int n = rho >> 4, i = rho & 15; return 8 * (i >> 2) + 4 * n + (i & 3); }

struct Unit { int pm, pn, ka, kb, aux; };
struct Gemm { const bf16_t* A; const bf16_t* Bt; int lda, ldb, K; };

struct TileOrder {
    int nM, nN, nwg;
    __device__ __forceinline__ void init(int nM_, int nN_) { nM = nM_; nN = nN_; nwg = nM * nN; }
    __device__ __forceinline__ void tile(int L, int& pm, int& pn) const {
        int wgid = L; { const int q = nwg / NXCD, r = nwg % NXCD, xcd = wgid % NXCD, off = wgid / NXCD; wgid = (xcd < r ? xcd * (q + 1) : r * (q + 1) + (xcd - r) * q) + off; }
        const int nig = WGM * nN, gid = wgid / nig, fm = gid * WGM, gsz = (nM - fm) < WGM ? (nM - fm) : WGM;
        pm = fm + ((wgid % nig) % gsz); pn = (wgid % nig) / gsz;
    }
};
struct SchedPlain {
    TileOrder T; int G, c, sk0, skn;
    __device__ __forceinline__ void init(int nM, int nN, int G_, int c_, int sk0_ = 1 << 30, int skn_ = 0) { T.init(nM, nN); G = G_; c = c_; sk0 = sk0_; skn = skn_; }
    __device__ __forceinline__ bool next(int i, Unit& u) const { if (c < 0) return false; const long L = (long)i * G + c; if (L >= T.nwg) return false; T.tile((int)L, u.pm, u.pn); if (u.pn >= sk0) u.pn += skn; u.ka = 0; u.kb = 0; u.aux = 0; return true; }
};
struct SchedSplit {
    TileOrder T; int GA, GB, c, n0, lru;
    __device__ __forceinline__ void init(int nM, int nN, int GA_, int GB_, int c_, int n0_, int lru_ = 0) { T.init(nM, nN); GA = GA_; GB = GB_; c = c_; n0 = n0_; lru = lru_; }
    __device__ __forceinline__ bool next(int i, Unit& u) const { const bool a = c < GA; const long L = a ? (long)i * GA + c : (long)n0 + (long)i * GB + (c - GA); if (L >= (a ? n0 : T.nwg)) return false;
        T.tile((int)L, u.pm, u.pn); u.ka = lru ? 256 * (u.pn >> 2) : 0; u.kb = 0; u.aux = 0; return true; }
};
struct SchedLru {
    TileOrder T; int G, c;
    __device__ __forceinline__ void init(int nM, int nN, int G_, int c_) { T.init(nM, nN); G = G_; c = c_; }
    __device__ __forceinline__ bool next(int i, Unit& u) const { if (c < 0) return false; const long L = (long)i * G + c; if (L >= T.nwg) return false; T.tile((int)L, u.pm, u.pn); u.ka = 256 * (u.pn >> 2); u.kb = 0; u.aux = 0; return true; }
};
struct SchedBo {
    TileOrder T; int G, c;
    __device__ __forceinline__ void init(int nM, int nN, int G_, int c_) { T.init(nM, nN); G = G_; c = c_; }
    __device__ __forceinline__ bool next(int i, Unit& u) const { const int it = i / 3, n = i - 3 * it; const long L = (long)it * G + c; if (L >= T.nwg) return false; T.tile((int)L, u.pm, u.pn); u.ka = 1024 * n; u.kb = 1024 * n; u.aux = n; return true; }
};

typedef f32x4 Acc[2][2][4][2];

struct EpiBf16 {
    bf16_t* O; int ldc;
    static __device__ __forceinline__ bool keep(const Unit&) { return false; }
    __device__ __forceinline__ void operator()(const Acc& acc, const Unit& u, int wr, int wc, int fr_, int fq_) const {
        const int fr = opq(fr_), fq = opq(fq_);
        const int row0 = u.pm * BM + wr * 64 + fr, col0 = u.pn * BM + wc * 32 + 8 * fq;
#pragma unroll
        for (int ai = 0; ai < 2; ++ai)
#pragma unroll
            for (int m = 0; m < 4; ++m) { bf16_t* rowp = O + (size_t)(row0 + ai * HALF + m * 16) * ldc + col0;
#pragma unroll
                for (int bj = 0; bj < 2; ++bj) { const f32x4 v0 = acc[ai][bj][m][0], v1 = acc[ai][bj][m][1];
                    u32x4 w; w.x = cvt_pk_bf16(v0[0], v0[1]); w.y = cvt_pk_bf16(v0[2], v0[3]); w.z = cvt_pk_bf16(v1[0], v1[1]); w.w = cvt_pk_bf16(v1[2], v1[3]);
                    *(u32x4*)(rowp + bj * HALF) = w; } }
    }
};
struct EpiSig {
    bf16_t* O; int ldc; const float* bias;
    static __device__ __forceinline__ bool keep(const Unit&) { return false; }
    __device__ __forceinline__ void operator()(const Acc& acc, const Unit& u, int wr, int wc, int fr_, int fq_) const {
        const int fr = opq(fr_), fq = opq(fq_);
        const int row0 = u.pm * BM + wr * 64 + fr, col0 = u.pn * BM + wc * 32 + 8 * fq;
#pragma unroll
        for (int bj = 0; bj < 2; ++bj) {
            const f32x4 bv0 = *(const f32x4*)(bias + col0 + bj * HALF), bv1 = *(const f32x4*)(bias + col0 + bj * HALF + 4);
#pragma unroll
            for (int ai = 0; ai < 2; ++ai)
#pragma unroll
                for (int m = 0; m < 4; ++m) { bf16_t* rowp = O + (size_t)(row0 + ai * HALF + m * 16) * ldc + col0 + bj * HALF;
                    f32x4 v0 = acc[ai][bj][m][0] + bv0, v1 = acc[ai][bj][m][1] + bv1;
#pragma unroll
                    for (int i = 0; i < 4; ++i) { v0[i] = sigmoidf_(v0[i]); v1[i] = sigmoidf_(v1[i]); }
                    u32x4 w; w.x = cvt_pk_bf16(v0[0], v0[1]); w.y = cvt_pk_bf16(v0[2], v0[3]); w.z = cvt_pk_bf16(v1[0], v1[1]); w.w = cvt_pk_bf16(v1[2], v1[3]);
                    *(u32x4*)rowp = w; __builtin_amdgcn_sched_barrier(0); } }
    }
};
struct EpiRes {
    const float* Xin; float* Out; float sc;
    static __device__ __forceinline__ bool keep(const Unit&) { return false; }
    __device__ __forceinline__ void operator()(const Acc& acc, const Unit& u, int wr, int wc, int fr_, int fq_) const {
        const int fr = opq(fr_), fq = opq(fq_);
        const int row0 = u.pm * BM + wr * 64 + fr, col0 = u.pn * BM + wc * 32 + 8 * fq;
#pragma unroll
        for (int ai = 0; ai < 2; ++ai)
#pragma unroll
            for (int m = 0; m < 4; ++m) { const size_t off = (size_t)(row0 + ai * HALF + m * 16) * DM + col0;
#pragma unroll
                for (int bj = 0; bj < 2; ++bj) {
                    const f32x4 x0 = *(const f32x4*)(Xin + off + bj * HALF), x1 = *(const f32x4*)(Xin + off + bj * HALF + 4);
                    *(f32x4*)(Out + off + bj * HALF) = x0 + acc[ai][bj][m][0] * sc; *(f32x4*)(Out + off + bj * HALF + 4) = x1 + acc[ai][bj][m][1] * sc; } }
    }
};
template <bool F8OUT> struct EpiSwiglu {
    void* Ov; float sc;
    static __device__ __forceinline__ bool keep(const Unit&) { return false; }
    __device__ __forceinline__ void operator()(const Acc& acc, const Unit& u, int wr, int wc, int fr_, int fq_) const {
        const int fr = opq(fr_), fq = opq(fq_);
        const int row0 = u.pm * BM + wr * 64 + fr, col0 = u.pn * HALF + wc * 32 + 8 * fq;
#pragma unroll
        for (int ai = 0; ai < 2; ++ai)
#pragma unroll
            for (int m = 0; m < 4; ++m) { const size_t eo = (size_t)(row0 + ai * HALF + m * 16) * FFH + col0;
                f32x4 r0, r1;
#pragma unroll
                for (int i = 0; i < 4; ++i) { const float g0 = acc[ai][0][m][0][i] * sc, g1 = acc[ai][0][m][1][i] * sc;
                    r0[i] = g0 * sigmoidf_(g0) * (acc[ai][1][m][0][i] * sc); r1[i] = g1 * sigmoidf_(g1) * (acc[ai][1][m][1][i] * sc); }
                if constexpr (F8OUT) { u32x2 w; w.x = pk_fp8x4(r0[0], r0[1], r0[2], r0[3]); w.y = pk_fp8x4(r1[0], r1[1], r1[2], r1[3]); *(u32x2*)((unsigned char*)Ov + eo) = w; }
                else { u32x4 w; w.x = cvt_pk_bf16(r0[0], r0[1]); w.y = cvt_pk_bf16(r0[2], r0[3]); w.z = cvt_pk_bf16(r1[0], r1[1]); w.w = cvt_pk_bf16(r1[2], r1[3]); *(u32x4*)((bf16_t*)Ov + eo) = w; } }
    }
};
__device__ __forceinline__ float i2f_acc(float bits) { return (float)__builtin_bit_cast(int, bits); }
struct EpiBf16I8 {
    bf16_t* O; int ldc; const float* xs; const float* wsc;
    static __device__ __forceinline__ bool keep(const Unit&) { return false; }
    __device__ __forceinline__ void operator()(const Acc& acc, const Unit& u, int wr, int wc, int fr_, int fq_) const {
        const int fr = opq(fr_), fq = opq(fq_);
        const int row0 = u.pm * BM + wr * 64 + fr, col0 = u.pn * BM + wc * 32 + 8 * fq;
        const float sw = wsc[0]; float rsv[2][4];
#pragma unroll
        for (int ai = 0; ai < 2; ++ai)
#pragma unroll
            for (int m = 0; m < 4; ++m) rsv[ai][m] = xs[row0 + ai * HALF + m * 16] * sw;
#pragma unroll
        for (int ai = 0; ai < 2; ++ai)
#pragma unroll
            for (int m = 0; m < 4; ++m) { bf16_t* rowp = O + (size_t)(row0 + ai * HALF + m * 16) * ldc + col0; const float c = rsv[ai][m];
#pragma unroll
                for (int bj = 0; bj < 2; ++bj) { const f32x4 v0 = acc[ai][bj][m][0], v1 = acc[ai][bj][m][1];
                    u32x4 w; w.x = cvt_pk_bf16(i2f_acc(v0[0]) * c, i2f_acc(v0[1]) * c); w.y = cvt_pk_bf16(i2f_acc(v0[2]) * c, i2f_acc(v0[3]) * c);
                    w.z = cvt_pk_bf16(i2f_acc(v1[0]) * c, i2f_acc(v1[1]) * c); w.w = cvt_pk_bf16(i2f_acc(v1[2]) * c, i2f_acc(v1[3]) * c);
                    *(u32x4*)(rowp + bj * HALF) = w; } }
    }
};
struct EpiSwigluI8 {
    void* Ov; const float* xs; const float* wsc; int f8out;
    static __device__ __forceinline__ bool keep(const Unit&) { return false; }
    __device__ __forceinline__ void operator()(const Acc& acc, const Unit& u, int wr, int wc, int fr_, int fq_) const {
        const int fr = opq(fr_), fq = opq(fq_);
        const int row0 = u.pm * BM + wr * 64 + fr, col0 = u.pn * HALF + wc * 32 + 8 * fq;
        const float sg = wsc[0], su = wsc[1];
        float rsv[2][4];
#pragma unroll
        for (int ai = 0; ai < 2; ++ai)
#pragma unroll
            for (int m = 0; m < 4; ++m) rsv[ai][m] = xs[row0 + ai * HALF + m * 16];
#pragma unroll
        for (int ai = 0; ai < 2; ++ai)
#pragma unroll
            for (int m = 0; m < 4; ++m) { const int row = row0 + ai * HALF + m * 16; const size_t eo = (size_t)row * FFH + col0; const float rsA = rsv[ai][m], cg = rsA * sg, cu = rsA * su;
                f32x4 r0, r1;
#pragma unroll
                for (int i = 0; i < 4; ++i) { const float g0 = i2f_acc(acc[ai][0][m][0][i]) * cg, g1 = i2f_acc(acc[ai][0][m][1][i]) * cg;
                    r0[i] = g0 * sigmoidf_(g0) * (i2f_acc(acc[ai][1][m][0][i]) * cu); r1[i] = g1 * sigmoidf_(g1) * (i2f_acc(acc[ai][1][m][1][i]) * cu); }
                if (f8out) { u32x2 w; w.x = pk_fp8x4(r0[0], r0[1], r0[2], r0[3]); w.y = pk_fp8x4(r1[0], r1[1], r1[2], r1[3]); *(u32x2*)((unsigned char*)Ov + eo) = w; }
                else { u32x4 w; w.x = cvt_pk_bf16(r0[0], r0[1]); w.y = cvt_pk_bf16(r0[2], r0[3]); w.z = cvt_pk_bf16(r1[0], r1[1]); w.w = cvt_pk_bf16(r1[2], r1[3]); *(u32x4*)((bf16_t*)Ov + eo) = w; } }
    }
};
struct EpiBo {
    const bf16_t* gates; bf16_t* ysum; int f8;
    static __device__ __forceinline__ bool keep(const Unit& u) { return u.aux < 2; }
    __device__ __forceinline__ void operator()(Acc& acc, const Unit& u, int wr, int wc, int fr_, int fq_) const {
        const int fr = opq(fr_), fq = opq(fq_);
        const int row0 = u.pm * BM + wr * 64 + fr, col0 = u.pn * BM + wc * 32 + 8 * fq, n = u.aux;
#pragma unroll
        for (int ai = 0; ai < 2; ++ai)
#pragma unroll
            for (int m = 0; m < 4; ++m) { const size_t row = (size_t)(row0 + ai * HALF + m * 16);
#pragma unroll
                for (int bj = 0; bj < 2; ++bj) { const int col = col0 + bj * HALF;
                    const bf16_t* gp = gates + row * 12288 + (size_t)n * 4096 + col;
                    float gn[8]; unpack8(*(const u32x4*)gp, gn);
#pragma unroll
                    for (int i = 0; i < 8; ++i) gn[i] = fmaxf(gn[i], 1e-18f);
                    if (n < 2) { float gd[8]; unpack8(*(const u32x4*)(gp + 4096), gd);
#pragma unroll
                        for (int i = 0; i < 8; ++i) gn[i] *= __builtin_amdgcn_rcpf(fmaxf(gd[i], 1e-18f)); }
                    f32x4 v0 = acc[ai][bj][m][0], v1 = acc[ai][bj][m][1];
#pragma unroll
                    for (int i = 0; i < 4; ++i) { v0[i] *= gn[i]; v1[i] *= gn[4 + i]; }
                    if (n < 2) { acc[ai][bj][m][0] = v0; acc[ai][bj][m][1] = v1; }
                    else { u32x4 w; w.x = cvt_pk_bf16(v0[0], v0[1]); w.y = cvt_pk_bf16(v0[2], v0[3]); w.z = cvt_pk_bf16(v1[0], v1[1]); w.w = cvt_pk_bf16(v1[2], v1[3]);
                        if (f8) { u32x2 w8; w8.x = pk_fp8x4(v0[0], v0[1], v0[2], v0[3]); w8.y = pk_fp8x4(v1[0], v1[1], v1[2], v1[3]); *(u32x2*)((unsigned char*)ysum + row * DM + col) = w8; }
                        else *(u32x4*)(ysum + row * DM + col) = w; } } }
    }
};
struct EpiLru {
    const bf16_t* uc; const float* gb; const float* Lp; unsigned* LAB;
    static __device__ __forceinline__ bool keep(const Unit&) { return false; }
    __device__ __forceinline__ void operator()(const Acc& acc, const Unit& u, int wr, int wc, int fr_, int fq_) const {
        const int fr = opq(fr_), fq = opq(fq_);
        const int row0 = u.pm * BM + wr * 64 + fr;
        const int z = u.pn & 1, nb = u.pn >> 1, ch0 = 128 * nb + 32 * wc + 8 * fq;
#pragma unroll
        for (int n = 0; n < 2; ++n) { const int ch = ch0 + 4 * n;
            const f32x4 br = *(const f32x4*)(gb + (z * 2 + 0) * 1024 + ch), bi = *(const f32x4*)(gb + (z * 2 + 1) * 1024 + ch);
            const f32x4 sp = *(const f32x4*)(Lp + z * 1024 + ch);
            __builtin_amdgcn_sched_barrier(0);
#pragma unroll
            for (int ai = 0; ai < 2; ++ai)
#pragma unroll
                for (int m = 0; m < 4; ++m) { const size_t row = (size_t)(row0 + ai * HALF + m * 16);
                    const u32x2 uw = *(const u32x2*)(uc + row * 1024 + ch);
                    const float uv[4] = {bf_lo(uw.x), bf_hi(uw.x), bf_lo(uw.y), bf_hi(uw.y)};
                    u32x4 w;
#pragma unroll
                    for (int i = 0; i < 4; ++i) { const float r = sigmoidf_(acc[ai][0][m][n][i] + br[i]), ig = sigmoidf_(acc[ai][1][m][n][i] + bi[i]);
                        const float la = r * sp[i], av = __builtin_amdgcn_exp2f(1.4426950408889634f * la);
                        const float t = -la;
                        const float ser = t * (1.f - t * 0.5f * (1.f - t * (1.f / 3.f) * (1.f - t * 0.25f * (1.f - t * 0.2f * (1.f - t * (1.f / 6.f) * (1.f - t * (1.f / 7.f)))))));
                        const float oma = (t < 0.25f) ? ser : (1.f - av);
                        const float bx = __builtin_amdgcn_sqrtf(oma * (1.f + av)) * ig * uv[i];
                        w[i] = cvt_pk_bf16(oma, bx); }
                    *(u32x4*)(LAB + ((size_t)z * MT + row) * 1024 + ch) = w; __builtin_amdgcn_sched_barrier(0); } }
    }
};

typedef int i32x8 __attribute__((ext_vector_type(8)));
typedef int i32x4_ __attribute__((ext_vector_type(4)));
template <class Epi, class Sched, int MODE = 0>
__device__ __forceinline__ void gemm_phase(LAS unsigned char* lds, const Gemm g, const Sched& S, const Epi& E) {
    constexpr bool F8 = (MODE == 1), I8 = (MODE == 2);
    const int tid = opq(threadIdx.x), wid = __builtin_amdgcn_readfirstlane(tid >> 6), lane = tid & 63, wr = wid >> 2, wc = wid & 3, fr = lane & 15, fq = lane >> 4;
    constexpr int EB = (MODE == 0) ? 2 : 1;
    const int K = g.K, nt = K * EB / (BK * 2);
    unsigned voffA[2], voffB[2];
#pragma unroll
    for (int i = 0; i < 2; ++i) { int R, C; stage_rc(tid * 16 + i * 8192, R, C); const int Rb = (R & ~31) + perm32(R & 31);
        voffA[i] = (unsigned)(R * g.lda * EB + C * 2); voffB[i] = (unsigned)(Rb * g.ldb * EB + C * 2); }
    const size_t kstep = (size_t)(BK * 2);
    const size_t hstepA = (size_t)HALF * g.lda * EB, hstepB = (size_t)HALF * g.ldb * EB;
    const unsigned ldsw = (unsigned)wid * 1024u;
    const int aoff = lds_byte(wr * 64 + fr, fq * 8), boff = lds_byte(wc * 32 + fr, fq * 8);
#define PG8_SA(b, h) (((b) * 2 + (h)) * HTB)
#define PG8_SB(b, h) ((4 + (b) * 2 + (h)) * HTB)
#define PG8_STAGE(bufoff, gbase, voff) do { _Pragma("unroll") for (int _i = 0; _i < 2; ++_i) \
        __builtin_amdgcn_global_load_lds((const unsigned*)((const char*)(gbase) + (voff)[_i]), (LAS unsigned*)(lds + (bufoff) + ldsw + _i * 8192), 16, 0, 0); } while (0)
#define PG8_LDA(dst, b, h) do { if constexpr (F8) { _Pragma("unroll") for (int m = 0; m < 4; ++m) { dst##8[m].lo = *(const LAS i32x4_*)(lds + PG8_SA(b, h) + aoff + m * 2048); dst##8[m].hi = *(const LAS i32x4_*)(lds + PG8_SA(b, h) + aoff + m * 2048 + 1024); } } \
    else { _Pragma("unroll") for (int m = 0; m < 4; ++m) _Pragma("unroll") for (int k = 0; k < 2; ++k) dst[m][k] = *(const LAS bf16x8*)(lds + PG8_SA(b, h) + aoff + m * 2048 + k * 1024); } } while (0)
#define PG8_LDB(dst, b, h) do { if constexpr (F8) { _Pragma("unroll") for (int n = 0; n < 2; ++n) { dst##8[n].lo = *(const LAS i32x4_*)(lds + PG8_SB(b, h) + boff + n * 2048); dst##8[n].hi = *(const LAS i32x4_*)(lds + PG8_SB(b, h) + boff + n * 2048 + 1024); } } \
    else { _Pragma("unroll") for (int n = 0; n < 2; ++n) _Pragma("unroll") for (int k = 0; k < 2; ++k) dst[n][k] = *(const LAS bf16x8*)(lds + PG8_SB(b, h) + boff + n * 2048 + k * 1024); } } while (0)
#define PG8_MMA(ai, bj, At, Bt) do { __builtin_amdgcn_s_setprio(1); \
        if constexpr (F8) { _Pragma("unroll") for (int m = 0; m < 4; ++m) _Pragma("unroll") for (int n = 0; n < 2; ++n) \
            asm volatile("v_mfma_f32_16x16x128_f8f6f4 %0, %1, %2, %0" : "+v"(acc[ai][bj][m][n]) : "v"(Bt##8[n]), "v"(At##8[m])); } \
        else if constexpr (I8) { _Pragma("unroll") for (int m = 0; m < 4; ++m) _Pragma("unroll") for (int n = 0; n < 2; ++n) _Pragma("unroll") for (int k = 0; k < 2; ++k) \
            acc[ai][bj][m][n] = __builtin_bit_cast(f32x4, __builtin_amdgcn_mfma_i32_16x16x64_i8(__builtin_bit_cast(i32x4_, Bt[n][k]), __builtin_bit_cast(i32x4_, At[m][k]), __builtin_bit_cast(i32x4_, acc[ai][bj][m][n]), 0, 0, 0)); } \
        else { _Pragma("unroll") for (int m = 0; m < 4; ++m) _Pragma("unroll") for (int n = 0; n < 2; ++n) _Pragma("unroll") for (int k = 0; k < 2; ++k) \
            acc[ai][bj][m][n] = __builtin_amdgcn_mfma_f32_16x16x32_bf16(Bt[n][k], At[m][k], acc[ai][bj][m][n], 0, 0, 0); } \
        __builtin_amdgcn_s_setprio(0); } while (0)
#define PG8_WAIT_V(n) asm volatile("s_waitcnt vmcnt(" #n ")" ::: "memory")
#define PG8_WAIT_L(n) asm volatile("s_waitcnt lgkmcnt(" #n ")" ::: "memory")
#define PG8_BAR __builtin_amdgcn_s_barrier()
#define PG8_SCHED __builtin_amdgcn_sched_barrier(0)
#define PG8_UA(u) ((const char*)g.A + (size_t)(u).pm * 2 * hstepA + (size_t)(u).ka * EB)
#define PG8_UB(u) ((const char*)g.Bt + (size_t)(u).pn * 2 * hstepB + (size_t)(u).kb * EB)
    Unit cur, nxt; int ui = 0;
    if (!S.next(0, cur)) return;
    Acc acc;
#pragma unroll
    for (int a = 0; a < 2; ++a)
#pragma unroll
        for (int b = 0; b < 2; ++b)
#pragma unroll
            for (int m = 0; m < 4; ++m)
#pragma unroll
                for (int n = 0; n < 2; ++n) acc[a][b][m][n] = (f32x4){0.f, 0.f, 0.f, 0.f};
    bf16x8 At[4][2], B0[2][2], B1[2][2];
    i32x8 At8[4], B08[2], B18[2];
    const char* cA = PG8_UA(cur); const char* cB = PG8_UB(cur);
    PG8_STAGE(PG8_SB(0, 0), cB, voffB); PG8_STAGE(PG8_SB(0, 1), cB + hstepB, voffB); PG8_STAGE(PG8_SA(0, 0), cA, voffA); PG8_STAGE(PG8_SA(0, 1), cA + hstepA, voffA);
    if (wr == 1) PG8_BAR;
    PG8_WAIT_V(2); PG8_BAR;
    PG8_STAGE(PG8_SB(1, 0), cB + kstep, voffB); PG8_STAGE(PG8_SA(1, 0), cA + kstep, voffA); PG8_STAGE(PG8_SB(1, 1), cB + hstepB + kstep, voffB);
    PG8_WAIT_V(6); PG8_BAR;
    for (;;) {
        const bool has_next = S.next(ui + 1, nxt);
        const char* nA = has_next ? PG8_UA(nxt) : cA; const char* nB = has_next ? PG8_UB(nxt) : cB;
#pragma nounroll
        for (int t = 0; t < nt; t += 2) {
            const bool last = (t == nt - 2);
            const char* a1 = cA + (size_t)(t + 1) * kstep;
            const char* a2 = last ? nA : cA + (size_t)(t + 2) * kstep; const char* b2 = last ? nB : cB + (size_t)(t + 2) * kstep;
            const char* a3 = a2 + kstep; const char* b3 = b2 + kstep;
            PG8_LDB(B0, 0, 0); PG8_LDB(B1, 0, 1); PG8_SCHED; PG8_LDA(At, 0, 0); PG8_STAGE(PG8_SA(1, 1), a1 + hstepA, voffA);
            PG8_WAIT_V(8); PG8_WAIT_L(0); PG8_BAR; PG8_MMA(0, 0, At, B0); PG8_MMA(0, 1, At, B1); PG8_BAR; PG8_SCHED;
            PG8_LDA(At, 0, 1); PG8_STAGE(PG8_SB(0, 0), b2, voffB); PG8_STAGE(PG8_SB(0, 1), b2 + hstepB, voffB); PG8_STAGE(PG8_SA(0, 0), a2, voffA);
            PG8_WAIT_V(8); PG8_WAIT_L(0); PG8_BAR; PG8_MMA(1, 0, At, B0); PG8_MMA(1, 1, At, B1); PG8_BAR; PG8_SCHED;
            PG8_LDB(B0, 1, 0); PG8_LDB(B1, 1, 1); PG8_SCHED; PG8_LDA(At, 1, 0); PG8_STAGE(PG8_SA(0, 1), a2 + hstepA, voffA);
            PG8_WAIT_V(8); PG8_WAIT_L(0); PG8_BAR; PG8_MMA(0, 0, At, B0); PG8_MMA(0, 1, At, B1); PG8_BAR; PG8_SCHED;
            PG8_LDA(At, 1, 1); PG8_STAGE(PG8_SB(1, 0), b3, voffB); PG8_STAGE(PG8_SB(1, 1), b3 + hstepB, voffB); PG8_STAGE(PG8_SA(1, 0), a3, voffA);
            PG8_WAIT_V(8); PG8_WAIT_L(0); PG8_BAR; PG8_MMA(1, 0, At, B0); PG8_MMA(1, 1, At, B1); PG8_BAR; PG8_SCHED;
        }
        if (wr == 0) PG8_BAR;
        if constexpr (F8) asm volatile("s_nop 15\n\ts_nop 15" ::: "memory");
        E(acc, cur, wr, wc, fr, fq);
        if (!has_next) break;
        if (!Epi::keep(cur)) {
#pragma unroll
        for (int a = 0; a < 2; ++a)
#pragma unroll
            for (int b = 0; b < 2; ++b)
#pragma unroll
                for (int m = 0; m < 4; ++m)
#pragma unroll
                    for (int n = 0; n < 2; ++n) acc[a][b][m][n] = (f32x4){0.f, 0.f, 0.f, 0.f};
        }
        cur = nxt; cA = nA; cB = nB; ++ui;
        if (wr == 1) PG8_BAR;
    }
    PG8_WAIT_V(0);
    PG8_BAR;
#undef PG8_SA
#undef PG8_SB
#undef PG8_STAGE
#undef PG8_LDA
#undef PG8_LDB
#undef PG8_MMA
#undef PG8_WAIT_V
#undef PG8_WAIT_L
#undef PG8_BAR
#undef PG8_SCHED
#undef PG8_UA
#undef PG8_UB
}
}

namespace att {
constexpr int SHM_V = 64 * 128 * 2, OFF_K = 2 * SHM_V, OFF_WS = OFF_K + 2 * 3 * 8192, LDS_ATT = OFF_WS + NWAVES * 64 * 4;
static_assert(LDS_ATT <= RING_BYTES, "attention LDS");
__device__ __forceinline__ int crow(int r, int hi) { return (r & 3) + 8 * (r >> 2) + 4 * hi; }
__device__ __forceinline__ int v_st(int k, int c) { const int kk = (k & ~0xC) | ((k & 4) << 1) | ((k & 8) >> 1); return ((kk >> 3) * 4 + (c >> 5)) * 512 + ((kk & 7) * 32 + (c & 31)) * 2; }
__device__ __forceinline__ int v_rd_base(int lane) { return ((lane & 3) << 3) | (((lane >> 2) & 3) << 6) | (((lane >> 4) & 1) << 5) | (((lane >> 5) & 1) << 8); }
constexpr int v_rd_off(int d0, int ks, int half) { return d0 * 512 + ks * 4096 + half * 2048; }
template <int OFF> __device__ __forceinline__ s16x4 tr_read(int vb) { s16x4 r; asm volatile("ds_read_b64_tr_b16 %0, %1 offset:%2" : "=&v"(r) : "v"(vb), "i"(OFF) : "memory"); return r; }
#define ATT_SBAR() __builtin_amdgcn_sched_barrier(0)
#define ATT_SYNC() do { asm volatile("s_waitcnt lgkmcnt(0)" ::: "memory"); __builtin_amdgcn_s_barrier(); asm volatile("" ::: "memory"); } while (0)
struct VFrag { s16x4 l0, h0, l1, h1, l2, h2, l3, h3; };
template <int D0> __device__ __forceinline__ void v_reads(VFrag& f, int vb) {
    f.l0 = tr_read<v_rd_off(D0, 0, 0)>(vb); f.h0 = tr_read<v_rd_off(D0, 0, 1)>(vb); f.l1 = tr_read<v_rd_off(D0, 1, 0)>(vb); f.h1 = tr_read<v_rd_off(D0, 1, 1)>(vb);
    f.l2 = tr_read<v_rd_off(D0, 2, 0)>(vb); f.h2 = tr_read<v_rd_off(D0, 2, 1)>(vb); f.l3 = tr_read<v_rd_off(D0, 3, 0)>(vb); f.h3 = tr_read<v_rd_off(D0, 3, 1)>(vb);
}
__device__ __forceinline__ void pv_mma(f32x16& od, const VFrag& f, bf16x8 pa0, bf16x8 pa1, bf16x8 pa2, bf16x8 pa3) {
#define ATT_PK(L, H) (bf16x8){L[0], L[1], L[2], L[3], H[0], H[1], H[2], H[3]}
    od = __builtin_amdgcn_mfma_f32_32x32x16_bf16(pa0, ATT_PK(f.l0, f.h0), od, 0, 0, 0);
    od = __builtin_amdgcn_mfma_f32_32x32x16_bf16(pa1, ATT_PK(f.l1, f.h1), od, 0, 0, 0);
    od = __builtin_amdgcn_mfma_f32_32x32x16_bf16(pa2, ATT_PK(f.l2, f.h2), od, 0, 0, 0);
    od = __builtin_amdgcn_mfma_f32_32x32x16_bf16(pa3, ATT_PK(f.l3, f.h3), od, 0, 0, 0);
#undef ATT_PK
}
#define ATT_LWAIT(n) do { asm volatile("s_waitcnt lgkmcnt(" #n ")" ::: "memory"); ATT_SBAR(); } while (0)
__device__ __forceinline__ void pv_d0(f32x16* o, int vb, bf16x8 pa0, bf16x8 pa1, bf16x8 pa2, bf16x8 pa3) {
    VFrag fa, fb;
    v_reads<0>(fa, vb); v_reads<1>(fb, vb);
    ATT_LWAIT(8); pv_mma(o[0], fa, pa0, pa1, pa2, pa3); ATT_SBAR();
    v_reads<2>(fa, vb);
    ATT_LWAIT(8); pv_mma(o[1], fb, pa0, pa1, pa2, pa3); ATT_SBAR();
    v_reads<3>(fb, vb);
    ATT_LWAIT(8); pv_mma(o[2], fa, pa0, pa1, pa2, pa3); ATT_SBAR();
    ATT_LWAIT(0); pv_mma(o[3], fb, pa0, pa1, pa2, pa3);
}
__device__ __forceinline__ void exp16(f32x16& p) {
#pragma unroll
    for (int r = 0; r < 16; ++r) p[r] = __builtin_amdgcn_exp2f(p[r]);
}
__device__ __forceinline__ void finishSM(f32x16& p0, f32x16& p1, float& l_reg, bf16x8& pa0, bf16x8& pa1, bf16x8& pa2, bf16x8& pa3) {
    float ps = 0.f;
#pragma unroll
    for (int r = 0; r < 16; ++r) ps += p0[r];
#pragma unroll
    for (int r = 0; r < 16; ++r) ps += p1[r];
    l_reg += ps;
#define ATT_PK4(P, BASE, OUT) do { unsigned a0 = cvt_pk_bf16(P[BASE + 0], P[BASE + 1]), a1 = cvt_pk_bf16(P[BASE + 2], P[BASE + 3]);   \
    unsigned b0 = cvt_pk_bf16(P[BASE + 4], P[BASE + 5]), b1 = cvt_pk_bf16(P[BASE + 6], P[BASE + 7]);                              \
    auto r0 = __builtin_amdgcn_permlane32_swap(a0, b0, false, false); auto r1 = __builtin_amdgcn_permlane32_swap(a1, b1, false, false); \
    u32x4 w = {r0[0], r1[0], r0[1], r1[1]}; OUT = __builtin_bit_cast(bf16x8, w); } while (0)
    ATT_PK4(p0, 0, pa0); ATT_PK4(p0, 8, pa1); ATT_PK4(p1, 0, pa2); ATT_PK4(p1, 8, pa3);
#undef ATT_PK4
}
template <int NS, int SD>
__device__ __forceinline__ void attn_body(const bf16_t* __restrict__ Qb, int ldq, const bf16_t* __restrict__ Kh, int ldk, const bf16_t* __restrict__ Vh, int ldv,
                                          float negoff, LAS char* lds, f32x16 (&o)[4]) {
    constexpr int NQK = 4 * NS, KB = NS * 8192, NT = SEQ / 64;
    const int tid = opq(threadIdx.x), wid = tid >> 6, lane = tid & 63, r32 = lane & 31, hi = lane >> 5;
    LAS char* V_lds = lds; LAS char* K_lds = lds + OFF_K;
    LAS float* li_l = (LAS float*)(lds + OFF_WS) + wid * 64;
    float l_reg = 0.f;
#pragma unroll
    for (int d = 0; d < 4; ++d)
#pragma unroll
        for (int r = 0; r < 16; ++r) o[d][r] = 0.f;
    bf16x8 qr[NQK];
    { const bf16_t* Qw = Qb + (size_t)(wid * 32 + r32) * ldq + hi * 8;
#pragma unroll
      for (int d0 = 0; d0 < NQK; ++d0) qr[d0] = *(const bf16x8*)(Qw + d0 * 16); }
    const int vb0 = (int)(unsigned)(uintptr_t)V_lds + v_rd_base(lane);
    const int kxb = hi ^ ((r32 >> 1) & 7), krow = r32 * 128;
    struct Slot { bf16x8 vs0, vs1, ks[NS]; } sl[SD];
#define ATT_SLOAD(i, k0) do { const int t_ = opq(tid), vr = t_ >> 4, vc = (t_ & 15) * 8, kr = t_ >> 3, kc = t_ & 7; \
    const unsigned vof0 = (unsigned)(vr * ldv + vc) * 2u, vof1 = (unsigned)((32 + vr) * ldv + vc) * 2u, kof = (unsigned)(kr * ldk + kc * 8) * 2u; \
    const char* vt_ = (const char*)Vh + (size_t)(k0) * ldv * 2; const char* kt_ = (const char*)Kh + (size_t)(k0) * ldk * 2; \
    sl[i].vs0 = *(const bf16x8*)(vt_ + vof0); sl[i].vs1 = *(const bf16x8*)(vt_ + vof1); \
    _Pragma("unroll") for (int s_ = 0; s_ < NS; ++s_) sl[i].ks[s_] = *(const bf16x8*)(kt_ + kof + s_ * 128); } while (0)
#define ATT_SWRITE(b, i) do { const int t_ = opq(tid), vr = t_ >> 4, vc = (t_ & 15) * 8, vst0 = v_st(vr, vc), vst1 = v_st(32 + vr, vc), kr = t_ >> 3, kc = t_ & 7, kst = kr * 128 + ((kc ^ ((kr >> 1) & 7)) << 4); \
    *(LAS bf16x8*)(V_lds + (b) * SHM_V + vst0) = sl[i].vs0; *(LAS bf16x8*)(V_lds + (b) * SHM_V + vst1) = sl[i].vs1; \
    _Pragma("unroll") for (int s_ = 0; s_ < NS; ++s_) *(LAS bf16x8*)(K_lds + (b) * KB + s_ * 8192 + kst) = sl[i].ks[s_]; } while (0)
#define ATT_TILE(b) do { f32x16 p0_, p1_; bf16x8 pa0, pa1, pa2, pa3; \
    _Pragma("unroll") for (int r_ = 0; r_ < 16; ++r_) { p0_[r_] = 0.f; p1_[r_] = 0.f; } \
    _Pragma("unroll") for (int d0 = 0; d0 < NQK; ++d0) { const LAS char* kp_ = K_lds + (b) * KB + (d0 >> 2) * 8192 + krow + ((((d0 & 3) * 2) ^ kxb) << 4); \
        const bf16x8 b0_ = *(const LAS bf16x8*)kp_; const bf16x8 b1_ = *(const LAS bf16x8*)(kp_ + 4096); \
        p0_ = __builtin_amdgcn_mfma_f32_32x32x16_bf16(b0_, qr[d0], p0_, 0, 0, 0); p1_ = __builtin_amdgcn_mfma_f32_32x32x16_bf16(b1_, qr[d0], p1_, 0, 0, 0); } \
    _Pragma("unroll") for (int r_ = 0; r_ < 16; ++r_) { p0_[r_] = __builtin_amdgcn_exp2f(p0_[r_] + negoff); p1_[r_] = __builtin_amdgcn_exp2f(p1_[r_] + negoff); } \
    finishSM(p0_, p1_, l_reg, pa0, pa1, pa2, pa3); ATT_SBAR(); \
    pv_d0(o, vb0 + (b) * SHM_V, pa0, pa1, pa2, pa3); } while (0)
    constexpr int SE = 0, SO = SD - 1;
    ATT_SLOAD(SE, 0); ATT_SWRITE(0, SE); ATT_SLOAD(SO, 64); if constexpr (SD == 2) ATT_SLOAD(SE, 128); ATT_SYNC();
    for (int j = 0; j < NT; j += 2) {
        ATT_SWRITE(1, SO); if (j + 1 + SD < NT) ATT_SLOAD(SO, (j + 1 + SD) * 64); ATT_SBAR();
        ATT_TILE(0);
        ATT_SYNC();
        if (j + 2 < NT) ATT_SWRITE(0, SE); if (j + 2 + SD < NT) ATT_SLOAD(SE, (j + 2 + SD) * 64); ATT_SBAR();
        ATT_TILE(1);
        ATT_SYNC();
    }
    { auto rr = __builtin_amdgcn_permlane32_swap(__builtin_bit_cast(unsigned, l_reg), __builtin_bit_cast(unsigned, l_reg), false, false);
      l_reg = __builtin_bit_cast(float, rr[0]) + __builtin_bit_cast(float, rr[1]); }
    if (hi == 0) li_l[r32] = l_reg;
    LDS_WAIT();
#pragma unroll
    for (int r = 0; r < 16; ++r) { const float rl = __builtin_amdgcn_rcpf(li_l[crow(r, hi)]);
#pragma unroll
        for (int d0 = 0; d0 < 4; ++d0) o[d0][r] *= rl; }
    LDS_WAIT();
#undef ATT_SLOAD
#undef ATT_SWRITE
#undef ATT_TILE
}
constexpr int DMA_OFF_K = 3 * SHM_V, DMA_OFF_WS = DMA_OFF_K + 3 * 3 * 8192, DMA_LDS = DMA_OFF_WS + NWAVES * 64 * 4;
static_assert(DMA_LDS <= RING_BYTES && 4 * SHM_V + 3 * 3 * 8192 + NWAVES * 64 * 4 <= ATT_BYTES, "attention LDS");
template <int NS>
__device__ __forceinline__ void attn_body_dma(const bf16_t* __restrict__ Qb, int ldq, const bf16_t* __restrict__ Kh, int ldk, const bf16_t* __restrict__ Vh, int ldv,
                                              float negoff, LAS char* lds, f32x16 (&o)[4]) {
    constexpr int NQK = 4 * NS, KB = NS * 8192, NT = SEQ / 64;
    const int tid = opq(threadIdx.x), wid = __builtin_amdgcn_readfirstlane(tid >> 6), lane = tid & 63, r32 = lane & 31, hi = lane >> 5;
    LAS char* V_lds = lds; LAS char* K_lds = lds + DMA_OFF_K;
    LAS float* li_l = (LAS float*)(lds + DMA_OFF_WS) + wid * 64;
    float l_reg = 0.f;
#pragma unroll
    for (int d = 0; d < 4; ++d)
#pragma unroll
        for (int r = 0; r < 16; ++r) o[d][r] = 0.f;
    bf16x8 qr[NQK];
    { const bf16_t* Qw = Qb + (size_t)(wid * 32 + r32) * ldq + hi * 8;
#pragma unroll
      for (int d0 = 0; d0 < NQK; ++d0) qr[d0] = *(const bf16x8*)(Qw + d0 * 16); }
    const int vb0 = (int)(unsigned)(uintptr_t)V_lds + v_rd_base(lane);
    const int kxb = hi ^ ((r32 >> 1) & 7), krow = r32 * 128;
    f32x16 negv;
#pragma unroll
    for (int r = 0; r < 16; ++r) negv[r] = (NS == 1) ? negoff : 0.f;
    const float nadd = (NS == 1) ? 0.f : negoff;
    unsigned vsrc[2], ksrc;
#pragma unroll
    for (int i = 0; i < 2; ++i) { const int p = (2 * wid + i) * 64 + lane, sub = p >> 5, kk = (sub >> 2) * 8 + ((p & 31) >> 2), k = (kk & ~0xC) | ((kk & 4) << 1) | ((kk & 8) >> 1), c = (sub & 3) * 32 + (p & 3) * 8;
        vsrc[i] = (unsigned)(k * ldv + c) * 2u; }
    { const int p = wid * 64 + lane, row = p >> 3, chunk = (p & 7) ^ ((row >> 1) & 7); ksrc = (unsigned)(row * ldk + chunk * 8) * 2u; }
#define ATT_DMA(slot, k0) do { const char* vt_ = (const char*)Vh + (size_t)(k0) * ldv * 2; const char* kt_ = (const char*)Kh + (size_t)(k0) * ldk * 2; \
    _Pragma("unroll") for (int i_ = 0; i_ < 2; ++i_) __builtin_amdgcn_global_load_lds((const unsigned*)(vt_ + vsrc[i_]), (LAS unsigned*)(V_lds + (slot) * SHM_V + (2 * wid + i_) * 1024), 16, 0, 0); \
    _Pragma("unroll") for (int s_ = 0; s_ < NS; ++s_) __builtin_amdgcn_global_load_lds((const unsigned*)(kt_ + ksrc + s_ * 128), (LAS unsigned*)(K_lds + (slot) * KB + s_ * 8192 + wid * 1024), 16, 0, 0); } while (0)
#define ATT_LDK(buf, g, kb_) do { _Pragma("unroll") for (int q_ = 0; q_ < 2; ++q_) { const int d0_ = 2 * (g) + q_; \
        const LAS char* kp_ = (kb_) + (d0_ >> 2) * 8192 + ((((d0_ & 3) * 2) ^ kxb) << 4); kf[buf][2 * q_] = *(const LAS bf16x8*)kp_; kf[buf][2 * q_ + 1] = *(const LAS bf16x8*)(kp_ + 4096); } } while (0)
#define ATT_TILE_D(slot) do { f32x16 p0_, p1_; bf16x8 pa0, pa1, pa2, pa3; const LAS char* kb_ = K_lds + (slot) * KB + krow; bf16x8 kf[2][4]; \
    ATT_LDK(0, 0, kb_); ATT_SBAR(); \
    _Pragma("unroll") for (int g_ = 0; g_ < NQK / 2; ++g_) { \
        if (g_ + 1 < NQK / 2) ATT_LDK((g_ + 1) & 1, g_ + 1, kb_); ATT_SBAR(); \
        _Pragma("unroll") for (int q_ = 0; q_ < 2; ++q_) { \
            p0_ = __builtin_amdgcn_mfma_f32_32x32x16_bf16(kf[g_ & 1][2 * q_], qr[2 * g_ + q_], (g_ == 0 && q_ == 0) ? negv : p0_, 0, 0, 0); \
            p1_ = __builtin_amdgcn_mfma_f32_32x32x16_bf16(kf[g_ & 1][2 * q_ + 1], qr[2 * g_ + q_], (g_ == 0 && q_ == 0) ? negv : p1_, 0, 0, 0); } \
        ATT_SBAR(); } \
    if constexpr (NS == 1) { _Pragma("unroll") for (int r_ = 0; r_ < 16; ++r_) { p0_[r_] = __builtin_amdgcn_exp2f(p0_[r_]); p1_[r_] = __builtin_amdgcn_exp2f(p1_[r_]); } } \
    else { _Pragma("unroll") for (int r_ = 0; r_ < 16; ++r_) { p0_[r_] = __builtin_amdgcn_exp2f(p0_[r_] + nadd); p1_[r_] = __builtin_amdgcn_exp2f(p1_[r_] + nadd); } } \
    finishSM(p0_, p1_, l_reg, pa0, pa1, pa2, pa3); ATT_SBAR(); \
    pv_d0(o, vb0 + (slot) * SHM_V, pa0, pa1, pa2, pa3); } while (0)
    ATT_DMA(0, 0); ATT_DMA(1, 64);
    if constexpr (NS == 1) asm volatile("s_waitcnt vmcnt(3)" ::: "memory"); else asm volatile("s_waitcnt vmcnt(5)" ::: "memory");
    ATT_SYNC();
    int slot = 0;
    for (int j = 0; j < NT; ++j) {
        const int s2 = (slot == 0) ? 2 : slot - 1;
        if (j + 2 < NT) ATT_DMA(s2, (j + 2) * 64);
        ATT_SBAR();
        ATT_TILE_D(slot);
        if (j + 2 < NT) { if constexpr (NS == 1) asm volatile("s_waitcnt vmcnt(3)" ::: "memory"); else asm volatile("s_waitcnt vmcnt(5)" ::: "memory"); }
        else asm volatile("s_waitcnt vmcnt(0)" ::: "memory");
        ATT_SYNC();
        slot = (slot == 2) ? 0 : slot + 1;
    }
    { auto rr = __builtin_amdgcn_permlane32_swap(__builtin_bit_cast(unsigned, l_reg), __builtin_bit_cast(unsigned, l_reg), false, false);
      l_reg = __builtin_bit_cast(float, rr[0]) + __builtin_bit_cast(float, rr[1]); }
    if (hi == 0) li_l[r32] = l_reg;
    LDS_WAIT();
#pragma unroll
    for (int r = 0; r < 16; ++r) { const float rl = __builtin_amdgcn_rcpf(li_l[crow(r, hi)]);
#pragma unroll
        for (int d0 = 0; d0 < 4; ++d0) o[d0][r] *= rl; }
    LDS_WAIT();
#undef ATT_DMA
#undef ATT_TILE_D
#undef ATT_LDK
}
template <int NS>
__device__ __forceinline__ void attn_body_st(const bf16_t* __restrict__ Qb, int ldq, const bf16_t* __restrict__ Kh, int ldk, const bf16_t* __restrict__ Vh, int ldv,
                                             float negoff, LAS char* lds, f32x16 (&o)[4]) {
    constexpr int NQK = 4 * NS, KB = NS * 8192, NT = SEQ / 64;
    const int tid = opq(threadIdx.x), wid = __builtin_amdgcn_readfirstlane(tid >> 6), lane = tid & 63, r32 = lane & 31, hi = lane >> 5;
    LAS char* V_lds = lds; LAS char* K_lds = lds + 4 * SHM_V;
    LAS float* li_l = (LAS float*)(lds + 4 * SHM_V + 3 * 3 * 8192) + wid * 64;
    float l_reg = 0.f;
#pragma unroll
    for (int d = 0; d < 4; ++d)
#pragma unroll
        for (int r = 0; r < 16; ++r) o[d][r] = 0.f;
    bf16x8 qr[NQK];
    { const bf16_t* Qw = Qb + (size_t)(wid * 32 + r32) * ldq + hi * 8;
#pragma unroll
      for (int d0 = 0; d0 < NQK; ++d0) qr[d0] = *(const bf16x8*)(Qw + d0 * 16); }
    const int vb0 = (int)(unsigned)(uintptr_t)V_lds + v_rd_base(lane);
    const int kxb = hi ^ ((r32 >> 1) & 7), krow = r32 * 128;
    unsigned vsrc[2], ksrc;
#pragma unroll
    for (int i = 0; i < 2; ++i) { const int p = (2 * wid + i) * 64 + lane, sub = p >> 5, kk = (sub >> 2) * 8 + ((p & 31) >> 2), k = (kk & ~0xC) | ((kk & 4) << 1) | ((kk & 8) >> 1), c = (sub & 3) * 32 + (p & 3) * 8;
        vsrc[i] = (unsigned)(k * ldv + c) * 2u; }
    { const int p = wid * 64 + lane, row = p >> 3, chunk = (p & 7) ^ ((row >> 1) & 7); ksrc = (unsigned)(row * ldk + chunk * 8) * 2u; }
#define ATT_DMA(vslot, kslot, k0) do { const char* vt_ = (const char*)Vh + (size_t)(k0) * ldv * 2; const char* kt_ = (const char*)Kh + (size_t)(k0) * ldk * 2; \
    _Pragma("unroll") for (int i_ = 0; i_ < 2; ++i_) __builtin_amdgcn_global_load_lds((const unsigned*)(vt_ + vsrc[i_]), (LAS unsigned*)(V_lds + (vslot) * SHM_V + (2 * wid + i_) * 1024), 16, 0, 0); \
    _Pragma("unroll") for (int s_ = 0; s_ < NS; ++s_) __builtin_amdgcn_global_load_lds((const unsigned*)(kt_ + ksrc + s_ * 128), (LAS unsigned*)(K_lds + (kslot) * KB + s_ * 8192 + wid * 1024), 16, 0, 0); } while (0)
#define ATT_LDK(buf, g, kb_) do { _Pragma("unroll") for (int q_ = 0; q_ < 2; ++q_) { constexpr int dummy_ = 0; (void)dummy_; const int d0_ = 2 * (g) + q_; \
        const LAS char* kp_ = (kb_) + (d0_ >> 2) * 8192 + ((((d0_ & 3) * 2) ^ kxb) << 4); kf[buf][2 * q_] = *(const LAS bf16x8*)kp_; kf[buf][2 * q_ + 1] = *(const LAS bf16x8*)(kp_ + 4096); } } while (0)
#define ATT_QKSM(kslot) do { f32x16 p0_, p1_; const LAS char* kb_ = K_lds + (kslot) * KB + krow; bf16x8 kf[2][4]; \
    _Pragma("unroll") for (int r_ = 0; r_ < 16; ++r_) { p0_[r_] = 0.f; p1_[r_] = 0.f; } \
    ATT_LDK(0, 0, kb_); ATT_SBAR(); \
    _Pragma("unroll") for (int g_ = 0; g_ < NQK / 2; ++g_) { \
        if (g_ + 1 < NQK / 2) ATT_LDK((g_ + 1) & 1, g_ + 1, kb_); ATT_SBAR(); \
        _Pragma("unroll") for (int q_ = 0; q_ < 2; ++q_) { p0_ = __builtin_amdgcn_mfma_f32_32x32x16_bf16(kf[g_ & 1][2 * q_], qr[2 * g_ + q_], p0_, 0, 0, 0); p1_ = __builtin_amdgcn_mfma_f32_32x32x16_bf16(kf[g_ & 1][2 * q_ + 1], qr[2 * g_ + q_], p1_, 0, 0, 0); } \
        ATT_SBAR(); } \
    _Pragma("unroll") for (int r_ = 0; r_ < 16; ++r_) { p0_[r_] = __builtin_amdgcn_exp2f(p0_[r_] + negoff); p1_[r_] = __builtin_amdgcn_exp2f(p1_[r_] + negoff); } \
    finishSM(p0_, p1_, l_reg, pa0, pa1, pa2, pa3); } while (0)
#define ATT_ENDI(fly) do { if (fly) { if constexpr (NS == 1) asm volatile("s_waitcnt vmcnt(3)" ::: "memory"); else asm volatile("s_waitcnt vmcnt(5)" ::: "memory"); } else asm volatile("s_waitcnt vmcnt(0)" ::: "memory"); ATT_SYNC(); } while (0)
    bf16x8 pa0, pa1, pa2, pa3;
    ATT_DMA(0, 0, 0); ATT_DMA(1, 1, 64); ATT_ENDI(true);
    int vs = 0, ks = 0;
    if (wid < 4) {
        for (int j = 0; j < NT; ++j) {
            if (j + 2 < NT) ATT_DMA((vs + 2) & 3, (ks == 0) ? 2 : ks - 1, (j + 2) * 64);
            ATT_SBAR();
            ATT_QKSM(ks); ATT_SBAR();
            pv_d0(o, vb0 + vs * SHM_V, pa0, pa1, pa2, pa3);
            ATT_ENDI(j + 2 < NT);
            vs = (vs + 1) & 3; ks = (ks == 2) ? 0 : ks + 1;
        }
    } else {
        int vp = 0;
        for (int j = 0; j < NT; ++j) {
            if (j + 2 < NT) ATT_DMA((vs + 2) & 3, (ks == 0) ? 2 : ks - 1, (j + 2) * 64);
            ATT_SBAR();
            if (j > 0) pv_d0(o, vb0 + vp * SHM_V, pa0, pa1, pa2, pa3);
            ATT_SBAR();
            ATT_QKSM(ks);
            ATT_ENDI(j + 2 < NT);
            vp = vs; vs = (vs + 1) & 3; ks = (ks == 2) ? 0 : ks + 1;
        }
        ATT_SBAR();
        pv_d0(o, vb0 + vp * SHM_V, pa0, pa1, pa2, pa3);
    }
    ATT_SYNC();
    { auto rr = __builtin_amdgcn_permlane32_swap(__builtin_bit_cast(unsigned, l_reg), __builtin_bit_cast(unsigned, l_reg), false, false);
      l_reg = __builtin_bit_cast(float, rr[0]) + __builtin_bit_cast(float, rr[1]); }
    if (hi == 0) li_l[r32] = l_reg;
    LDS_WAIT();
#pragma unroll
    for (int r = 0; r < 16; ++r) { const float rl = __builtin_amdgcn_rcpf(li_l[crow(r, hi)]);
#pragma unroll
        for (int d0 = 0; d0 < 4; ++d0) o[d0][r] *= rl; }
    LDS_WAIT();
#undef ATT_DMA
#undef ATT_QKSM
#undef ATT_LDK
#undef ATT_ENDI
}
}

#define XB_TMO      128
#define XB_XCNT(j)  (256  + 64 * (j))
#define XB_XSUB(j)  (1280 + 64 * (j))
#define XB_XGEN(j)  (2304 + 64 * (j))
#define XB_TOP      3328
#define XB_TOPGEN   3392
#define XCD_BAR_WORDS 3456
#define XB_SPIN_CAP (1u << 22)
__device__ __forceinline__ unsigned xb_ld(unsigned* p)              { return __hip_atomic_load(p, __ATOMIC_RELAXED, __HIP_MEMORY_SCOPE_AGENT); }
__device__ __forceinline__ unsigned xb_add(unsigned* p, unsigned v) { return __hip_atomic_fetch_add(p, v, __ATOMIC_RELAXED, __HIP_MEMORY_SCOPE_AGENT); }
__device__ __forceinline__ unsigned xb_xcc_id() { return (unsigned)__builtin_amdgcn_s_getreg((3 << 11) | 20) & 0xFu; }
#define XB_SPIN(cond, bar) do { unsigned _sp = 0; while (cond) { __builtin_amdgcn_s_sleep(1); \
    if ((++_sp & 255u) == 0u) { if (xb_ld(&(bar)[XB_TMO])) break; if (_sp > XB_SPIN_CAP) { atomicAdd(&(bar)[XB_TMO], 1u); break; } } } } while (0)
struct XcdBarrier { unsigned* bar; unsigned x; volatile LAS unsigned* st; };
__device__ __forceinline__ XcdBarrier xcd_barrier_post(unsigned* bar, volatile LAS unsigned* st) {
    XcdBarrier b; b.bar = bar; b.x = xb_xcc_id(); b.st = st;
    if (threadIdx.x == 0) (void)xb_add(&bar[XB_XCNT(b.x)], 1u);
    return b;
}
__device__ __forceinline__ void xcd_barrier_complete(unsigned* bar, unsigned x, unsigned& nloc, unsigned& nx) {
    const unsigned G = gridDim.x * gridDim.y * gridDim.z;
    unsigned sum, cnt, mine, sp = 0u;
    for (;;) {
        sum = 0u; cnt = 0u; mine = 0u;
#pragma unroll
        for (unsigned j = 0; j < 16; ++j) { const unsigned c = xb_ld(&bar[XB_XCNT(j)]); sum += c; cnt += (c > 0u) ? 1u : 0u; mine = (j == x) ? c : mine; }
        if (sum == G) break;
        __builtin_amdgcn_s_sleep(1);
        if ((++sp & 255u) == 0u) { if (xb_ld(&bar[XB_TMO])) break; if (sp > XB_SPIN_CAP) { atomicAdd(&bar[XB_TMO], 1u); break; } }
    }
    nloc = mine > 0u ? mine : 1u; nx = cnt > 0u ? cnt : 1u;
}
__device__ __forceinline__ void xcd_barrier(const XcdBarrier& b) {
    asm volatile("s_waitcnt vmcnt(0)" ::: "memory");
    __syncthreads();
    if (threadIdx.x == 0) {
        unsigned* bar = b.bar;
        __builtin_amdgcn_s_waitcnt(0);
        unsigned nloc = b.st[0], nx = b.st[1];
        if (nloc == 0u) { xcd_barrier_complete(bar, b.x, nloc, nx); b.st[0] = nloc; b.st[1] = nx; }
        const unsigned old = xb_add(&bar[XB_XSUB(b.x)], 1u);
        const unsigned gen = old / nloc;
        if (old + 1u == (gen + 1u) * nloc) {
            __builtin_amdgcn_fence(__ATOMIC_RELEASE, "agent");
            asm volatile("s_waitcnt vmcnt(0)" ::: "memory");
            const unsigned og = xb_add(&bar[XB_TOP], 1u);
            const unsigned tg = og / nx;
            if (og + 1u == (tg + 1u) * nx) xb_add(&bar[XB_TOPGEN], 1u);
            else XB_SPIN(xb_ld(&bar[XB_TOPGEN]) == tg, bar);
            __builtin_amdgcn_fence(__ATOMIC_ACQUIRE, "agent");
            xb_add(&bar[XB_XGEN(b.x)], 1u);
            asm volatile("s_waitcnt vmcnt(0)" ::: "memory");
        } else {
            XB_SPIN(xb_ld(&bar[XB_XGEN(b.x)]) == gen, bar);
            __builtin_amdgcn_fence(__ATOMIC_ACQUIRE, "agent");
            asm volatile("s_waitcnt vmcnt(0)" ::: "memory");
        }
    }
    __syncthreads();
}

template <int MODE = 0>
__device__ __forceinline__ void tr_item(const float* W, size_t ldw, int k0, int n0, bf16_t* WT, size_t ldt, int drow0, int dcol0, LAS float* scr, int lane, float qinv = 1.f) {
    constexpr bool F8 = (MODE == 1);
    { f32x4 wv_[8];
#pragma unroll
      for (int i = 0; i < 8; ++i) wv_[i] = *(const f32x4*)(W + (size_t)(k0 + 8 * i + (lane >> 3)) * ldw + n0 + 4 * (lane & 7));
#pragma unroll
      for (int i = 0; i < 8; ++i) { LAS float* d_ = scr + (8 * i + (lane >> 3)) * 33 + 4 * (lane & 7); d_[0] = wv_[i].x; d_[1] = wv_[i].y; d_[2] = wv_[i].z; d_[3] = wv_[i].w; } }
    LDS_WAIT(); asm volatile("" ::: "memory");
    const int c = lane & 7;
#pragma unroll
    for (int j = 0; j < 4; ++j) { const int n = (lane >> 3) + 8 * j; const LAS float* s = scr + (8 * c) * 33 + n;
        if constexpr (MODE == 2) { u32x2 o; o.x = pk_i8x4(s[0 * 33] * qinv, s[1 * 33] * qinv, s[2 * 33] * qinv, s[3 * 33] * qinv); o.y = pk_i8x4(s[4 * 33] * qinv, s[5 * 33] * qinv, s[6 * 33] * qinv, s[7 * 33] * qinv);
            *(u32x2*)((unsigned char*)WT + (size_t)(drow0 + n) * ldt + dcol0 + 8 * c) = o; }
        else if constexpr (F8) { u32x2 o; o.x = pk_fp8x4(s[0 * 33] * W8_SCALE, s[1 * 33] * W8_SCALE, s[2 * 33] * W8_SCALE, s[3 * 33] * W8_SCALE); o.y = pk_fp8x4(s[4 * 33] * W8_SCALE, s[5 * 33] * W8_SCALE, s[6 * 33] * W8_SCALE, s[7 * 33] * W8_SCALE);
            *(u32x2*)((unsigned char*)WT + (size_t)(drow0 + n) * ldt + dcol0 + 8 * c) = o; }
        else { u32x4 o; o.x = pk2(s[0 * 33], s[1 * 33]); o.y = pk2(s[2 * 33], s[3 * 33]); o.z = pk2(s[4 * 33], s[5 * 33]); o.w = pk2(s[6 * 33], s[7 * 33]);
            *(u32x4*)(WT + (size_t)(drow0 + n) * ldt + dcol0 + 8 * c) = o; } }
    LDS_WAIT(); asm volatile("" ::: "memory");
}

struct Args { const void* in[27]; float* out; unsigned char* ws; int step_lo, step_hi; };
typedef const __attribute__((address_space(4))) Args CArgs;
__device__ __forceinline__ CArgs* opq_args() { CArgs* p = (CArgs*)__builtin_amdgcn_kernarg_segment_ptr(); asm volatile("" : "+s"(p)); return p; }

__global__ void __launch_bounds__(NWAVES * 64, 2) fwd(Args args) {
    extern __shared__ __attribute__((aligned(16))) unsigned char lds_raw[];
    LAS unsigned char* lds = (LAS unsigned char*)lds_raw;
    volatile LAS unsigned* MISC = (volatile LAS unsigned*)(lds + MISC_OFF);
    const int tid0 = threadIdx.x, wave = __builtin_amdgcn_readfirstlane(tid0 >> 6);
    const int G0 = gridDim.x, bx0 = blockIdx.x;
    const int vcu0 = (G0 % 8 == 0) ? (bx0 % 8) * (G0 / 8) + bx0 / 8 : bx0;
    const int gw0 = vcu0 * NWAVES + wave;
#define ws (A->ws)
    for (int u = tid0; u < (LDS_BYTES - LDSCTL_OFF) / 4; u += NWAVES * 64) ((LAS unsigned*)(lds + LDSCTL_OFF))[u] = 0u;
    __syncthreads();
    const int lo = args.step_lo, hi = args.step_hi;
    if (MK_ONE_LAUNCH) { CArgs* A = opq_args(); const int G = opqs(G0), bx = opqs(bx0), gw = opqs(gw0), NGW = G * NWAVES; (void)bx; (void)gw; (void)NGW; (void)xcd_barrier_post((unsigned*)(ws + WS_CTL) + CW_BAR, MISC + 8); }
#ifndef DISMASK
#define DISMASK 0
#endif
#define EN(p) (!((DISMASK >> (p)) & 1))
#ifndef P3MASK
#define P3MASK 0
#endif
#ifndef P5MASK
#define P5MASK 0
#endif
#define P5EN(p) (!((P5MASK >> (p)) & 1))
#define P3EN(p) (!((P3MASK >> (p)) & 1))
#ifndef DUPMASK
#define DUPMASK 0
#endif
#define NREP(p) ((((DUPMASK) >> (p)) & 1) ? 2 : 1)
#define IN(k) (lo <= (k) && (k) < hi)
#define SEAM(k) do { if ((k) + 1 < hi) { if (MK_ONE_LAUNCH) { XcdBarrier bar_; bar_.bar = (unsigned*)(ws + WS_CTL) + CW_BAR; bar_.x = xb_xcc_id(); bar_.st = (volatile LAS unsigned*)(lds + MISC_OFF) + 8; xcd_barrier(bar_); } } } while (0)

#define cosA ((float*)(ws + WS_COSA))
#define sinA ((float*)(ws + WS_SINA))
#define cosC ((float*)(ws + WS_COSC))
#define sinC ((float*)(ws + WS_SINC))
#define XN ((bf16_t*)(ws + WS_XN))
#define H ((bf16_t*)(ws + WS_H))
#define UC ((bf16_t*)(ws + WS_UC))
#define QM ((bf16_t*)(ws + WS_QM))
#define KV ((bf16_t*)(ws + WS_KV))
#define KM ((bf16_t*)(ws + WS_KM))
#define LAB ((unsigned*)(ws + WS_LAB))
#define AGP ((float*)(ws + WS_AGP))
#define AGH ((float*)(ws + WS_AGH))
#define GATES ((bf16_t*)(ws + WS_GATES))
#define DBUF ((float*)(ws + WS_DBUF))
#define OCAT ((bf16_t*)(ws + WS_OCAT))
#define TMP ((float*)(ws + WS_TMP))
#define YSUM ((bf16_t*)(ws + WS_YSUM))
#define HID ((bf16_t*)(ws + WS_HID))
#define x_in ((const float*)A->in[0])
#define out (A->out)

    auto conv_layer = [](CArgs* A, LAS unsigned char* lds, const int wave, const int lc, const int part, const int tid, const int lane, const int G, const int bx, const int gw, const int NGW) __attribute__((always_inline)) {
        if (part == 0) { const int l = lc;
            unsigned char* wlp = ws + WS_W + (size_t)l * WL_SIZE;
            const int esz_in = I8N(l) ? 1 : 2;
            u32x4* padp = (u32x4*)(wlp + WL_IN + (size_t)NIN * DM * esz_in);
            for (int i = bx * 512 + tid; i < (NINP - NIN) * DM * esz_in / 16; i += G * 512) padp[i] = (u32x4){0u, 0u, 0u, 0u};
            bf16_t* wlru = (bf16_t*)(wlp + WL_LRU); const float* gwsrc = (const float*)A->in[10] + (size_t)l * 2 * 2 * 8 * 128 * 128;
            (void)gwsrc;
            for (int i = bx * 512 + tid; i < 4096 * 16; i += G * 512) { const int R = i >> 4, c8 = i & 15, nb = R >> 9;
                *(u32x4*)(wlru + (size_t)R * 256 + (1 - (nb & 1)) * 128 + 8 * c8) = (u32x4){0u, 0u, 0u, 0u}; }
        }
        { LAS float* scr = (LAS float*)(lds + wave * 16384);
          constexpr int I_IN = 64 * 210, I_UQ = 12 * 48, I_UKV = 8 * 64, I_G = 4 * 384, I_BO = 3 * 16 * 128, I_OUT = 64 * 128, I_GA = 64 * 344, I_UP = I_GA, I_DN = 172 * 128, I_LRU = 32 * 8;
          constexpr int I_MIX = I_IN + I_UQ + I_UKV + I_G + I_BO + I_OUT + I_LRU, I_L = I_MIX + I_GA + I_UP + I_DN;
          const int IT0 = part ? I_MIX : 0, NIT = part ? I_L : I_MIX;
          float qsl = 1.f / ((const float*)(ws + WS_WSC))[lane & 15];
          asm volatile("s_waitcnt vmcnt(0)" : "+v"(qsl) :: "memory");
          auto dec = [&](int it, const float*& src, size_t& ldw, unsigned char*& dst, size_t& rsb, int& mode, float& q) {
              const int l = lc; int r = it;
              int kb, nb, drow, dcol; size_t ldt, woff; mode = 0; q = 1.f;
              if (r < I_IN) { kb = r / 210; nb = r - 210 * kb; src = (const float*)A->in[3] + (size_t)l * DM * NIN; ldw = NIN; woff = WL_IN; ldt = DM; drow = 32 * nb; dcol = 64 * kb;
                  if (I8N(l)) { mode = 2; q = __builtin_bit_cast(float, __builtin_amdgcn_readlane(__builtin_bit_cast(int, qsl), 8 + l)); } }
              else if ((r -= I_IN) < I_UQ) { kb = r / 48; nb = r - 48 * kb; src = (const float*)A->in[14] + (size_t)l * 768 * 1536; ldw = 1536; woff = WL_UQ; ldt = 768; drow = 32 * nb; dcol = 64 * kb; }
              else if ((r -= I_UQ) < I_UKV) { kb = r / 64; nb = r - 64 * kb; src = (const float*)A->in[16] + (size_t)l * 512 * 2048; ldw = 2048; woff = WL_UKV; ldt = 512; drow = 32 * nb; dcol = 64 * kb; }
              else if ((r -= I_UKV) < I_G) { kb = r / 384; nb = r - 384 * kb; src = (const float*)A->in[19] + (size_t)l * 256 * 12288; ldw = 12288; woff = WL_G; ldt = 256; drow = 32 * nb; dcol = 64 * kb; }
              else if ((r -= I_G) < I_BO) { const int n = r / (16 * 128), r2 = r - n * 16 * 128; kb = r2 / 128; nb = r2 - 128 * kb;
                  src = (const float*)A->in[21] + ((size_t)l * 3 + n) * 1024 * 4096; ldw = 4096; woff = WL_BO; ldt = 3072; drow = 32 * nb; dcol = 1024 * n + 64 * kb; }
              else if ((r -= I_BO) < I_OUT) { kb = r / 128; nb = r - 128 * kb; src = (const float*)A->in[22] + (size_t)l * DM * DM; ldw = DM; woff = WL_OUT; ldt = DM; drow = 32 * nb; dcol = 64 * kb; if (F8O(l)) { mode = 1; q = W8_SCALE; } }
              else if ((r -= I_OUT) < I_LRU) { const int blk = r >> 3, zg = blk >> 3, nbk = blk & 7; kb = (r >> 2) & 1; nb = r & 3;
                  src = (const float*)A->in[10] + ((size_t)l * 32 + blk) * 128 * 128; ldw = 128; woff = WL_LRU; ldt = 256; drow = (2 * nbk + (zg >> 1)) * 256 + (zg & 1) * 128 + 32 * nb; dcol = (nbk & 1) * 128 + 64 * kb; }
              else if ((r -= I_LRU) < I_GA + I_UP) { const int up = r >= I_GA; if (up) r -= I_GA; kb = r / 344; nb = r - 344 * kb; const int n0 = 32 * nb;
                  src = (const float*)A->in[up ? 25 : 24] + (size_t)l * DM * FFH; ldw = FFH; woff = WL_GU; ldt = DM; drow = 256 * (n0 >> 7) + 128 * up + (n0 & 127); dcol = 64 * kb;
                  if (I8U(l)) { mode = 2; q = __builtin_bit_cast(float, __builtin_amdgcn_readlane(__builtin_bit_cast(int, qsl), 2 * l + up)); } else if (F8U(l)) { mode = 1; q = W8_SCALE; } }
              else { r -= I_GA + I_UP; { kb = r / 128; nb = r - 128 * kb; src = (const float*)A->in[26] + (size_t)l * FFH * DM; ldw = DM; woff = WL_DN; ldt = FFH; drow = 32 * nb; dcol = 64 * kb; if (F8L(l)) { mode = 1; q = W8_SCALE; } } }
              src += (size_t)(64 * kb) * ldw + 32 * nb;
              const size_t esz = mode ? 1 : 2;
              dst = ws + WS_W + (size_t)l * WL_SIZE + woff + ((size_t)drow * ldt + dcol) * esz; rsb = ldt * esz; };
          auto LOAD = [&](int it_, f32x4 (&w)[8]) { const float* src; size_t ldw, rsb; unsigned char* dst; int mode; float q; dec(it_, src, ldw, dst, rsb, mode, q);
#pragma unroll
              for (int i = 0; i < 8; ++i) { const float* p_ = src + (size_t)(8 * i + (lane >> 3)) * ldw + 4 * (lane & 7);
                  w[i] = *(const f32x4*)p_; } };
#define TR_WAIT(N, w) do { } while (0)
          auto FIN = [&](int it_, f32x4 (&w)[8]) { const float* src; size_t ldw, rsb; unsigned char* dst; int mode; float q; dec(it_, src, ldw, dst, rsb, mode, q);
#pragma unroll
              for (int i = 0; i < 8; ++i) { LAS float* d_ = scr + (8 * i + (lane >> 3)) * 33 + 4 * (lane & 7); d_[0] = w[i].x; d_[1] = w[i].y; d_[2] = w[i].z; d_[3] = w[i].w; }
              LDS_WAIT(); asm volatile("" ::: "memory");
              const int c = lane & 7;
              if (mode == 0) {
#pragma unroll
                  for (int j = 0; j < 4; ++j) { const int n = (lane >> 3) + 8 * j; const LAS float* sp_ = scr + (8 * c) * 33 + n;
                      u32x4 o; o.x = pk2(sp_[0 * 33], sp_[1 * 33]); o.y = pk2(sp_[2 * 33], sp_[3 * 33]); o.z = pk2(sp_[4 * 33], sp_[5 * 33]); o.w = pk2(sp_[6 * 33], sp_[7 * 33]);
                      *(u32x4*)(dst + (size_t)n * rsb + 16 * c) = o; } }
              else if (mode == 1) {
#pragma unroll
                  for (int j = 0; j < 4; ++j) { const int n = (lane >> 3) + 8 * j; const LAS float* sp_ = scr + (8 * c) * 33 + n;
                      u32x2 o; o.x = pk_fp8x4(sp_[0 * 33] * q, sp_[1 * 33] * q, sp_[2 * 33] * q, sp_[3 * 33] * q); o.y = pk_fp8x4(sp_[4 * 33] * q, sp_[5 * 33] * q, sp_[6 * 33] * q, sp_[7 * 33] * q);
                      *(u32x2*)(dst + (size_t)n * rsb + 8 * c) = o; } }
              else {
#pragma unroll
                  for (int j = 0; j < 4; ++j) { const int n = (lane >> 3) + 8 * j; const LAS float* sp_ = scr + (8 * c) * 33 + n;
                      u32x2 o; o.x = pk_i8x4(sp_[0 * 33] * q, sp_[1 * 33] * q, sp_[2 * 33] * q, sp_[3 * 33] * q); o.y = pk_i8x4(sp_[4 * 33] * q, sp_[5 * 33] * q, sp_[6 * 33] * q, sp_[7 * 33] * q);
                      *(u32x2*)(dst + (size_t)n * rsb + 8 * c) = o; } }
              LDS_WAIT(); asm volatile("" ::: "memory"); };
          f32x4 wa[8], wb[8];
#pragma nounroll
          for (int it = IT0 + gw; it < NIT; it += 4 * NGW) {
              const int i1 = it + NGW, i2 = it + 2 * NGW, i3 = it + 3 * NGW;
              LOAD(it, wa); LOAD(i1 < NIT ? i1 : NIT - 1, wb);
              TR_WAIT(8, wa); FIN(it, wa);
              LOAD(i2 < NIT ? i2 : NIT - 1, wa);
              TR_WAIT(12, wb); if (i1 < NIT) FIN(i1, wb);
              LOAD(i3 < NIT ? i3 : NIT - 1, wb);
              TR_WAIT(12, wa); if (i2 < NIT) FIN(i2, wa);
              TR_WAIT(4, wb); if (i3 < NIT) FIN(i3, wb);
          }
          asm volatile("s_waitcnt vmcnt(0)" ::: "memory");
#undef TR_WAIT
        }
    };
    if (EN(12) && IN(0)) for (int rep_ = 0; rep_ < NREP(12); ++rep_) { const int tid = opq(tid0), lane = tid & 63; CArgs* A = opq_args(); const int G = opqs(G0), bx = opqs(bx0), gw = opqs(gw0), NGW = G * NWAVES; (void)bx; (void)gw; (void)NGW;
        if ((I8UP_LAYERS | I8IN_LAYERS) != 0) {
            if (bx < 3 * DEPTH && (bx < 2 * DEPTH ? I8U(bx >> 1) : I8N(bx - 2 * DEPTH))) {
                const bool wi = bx >= 2 * DEPTH;
                const float* Wt = wi ? (const float*)A->in[3] + (size_t)(bx - 2 * DEPTH) * DM * NIN : (const float*)A->in[(bx & 1) ? 25 : 24] + (size_t)(bx >> 1) * DM * FFH; float ssq = 0.f, amx = 0.f;
                const int rl4 = wi ? NIN / 4 : FFH / 4; const size_t rstr = wi ? (size_t)256 * NIN : (size_t)256 * FFH;
#pragma nounroll
                for (int r = 0; r < 16; ++r) {
                    const f32x4* rowp = (const f32x4*)(Wt + (size_t)r * rstr); f32x4 w[6];
#pragma unroll
                    for (int u = 0; u < 6; ++u) { const int i = tid + u * (NWAVES * 64); w[u] = rowp[i < rl4 ? i : 0]; if (i >= rl4) w[u] = (f32x4){0.f, 0.f, 0.f, 0.f}; }
#pragma unroll
                    for (int u = 0; u < 6; ++u) { ssq += (w[u].x * w[u].x + w[u].y * w[u].y) + (w[u].z * w[u].z + w[u].w * w[u].w); amx = fmaxf(fmaxf(amx, fmaxf(fabsf(w[u].x), fabsf(w[u].y))), fmaxf(fabsf(w[u].z), fabsf(w[u].w))); } }
                ssq = wave_sum(ssq); amx = wave_max(amx);
                LAS float* red = (LAS float*)(lds);
                if (lane == 0) { red[2 * wave] = ssq; red[2 * wave + 1] = amx; }
                __syncthreads();
                if (tid == 0) { float a = 0.f, b = 0.f;
                    for (int w = 0; w < NWAVES; ++w) { a += red[2 * w]; b = fmaxf(b, red[2 * w + 1]); }
                    const float rms = sqrtf(a / (64.f * (float)rl4)); float sc = fminf(4.2f * rms, b * 1.05f) * (1.f / 127.f); if (!(sc > 0.f)) sc = 1.f;
                    ((float*)(ws + WS_WSC))[bx] = sc; }
                __syncthreads();
            }
            if (MK_ONE_LAUNCH) { XcdBarrier bar_; bar_.bar = (unsigned*)(ws + WS_CTL) + CW_BAR; bar_.x = xb_xcc_id(); bar_.st = (volatile LAS unsigned*)(lds + MISC_OFF) + 8; xcd_barrier(bar_); }
        }
        { const int* pos = (const int*)A->in[1];
          for (int i = bx * 512 + tid; i < MT * 40; i += G * 512) { const int m = i / 40, f = i - 40 * m;
              float inv; float* cd; float* sd;
              if (f < 8) { inv = exp2f(-(float)(2 * f) / 16.f * 18.931568569324174f); cd = cosA + m * 8 + f; sd = sinA + m * 8 + f; }
              else { const int ff = f - 8; inv = exp2f(-(float)(2 * ff) / 64.f * 18.931568569324174f); cd = cosC + m * 32 + ff; sd = sinC + m * 32 + ff; }
              const float ang = (float)pos[m] * inv; float sv, cv; sincosf(ang, &sv, &cv); *cd = cv; *sd = sv; } }
        { const float* Lsrc = (const float*)A->in[12]; float* spt = (float*)(ws + WS_SPT);
          for (int i = bx * 512 + tid; i < DEPTH * 2048; i += G * 512) spt[i] = -8.f * log1pf(expf(-Lsrc[i])); }
        conv_layer(A, lds, wave, 0, 0, tid, lane, G, bx, gw, NGW);
        SEAM(0);
    }

    for (int l = 0; l < DEPTH; ++l) {
        const int s0 = 1 + 12 * l;
        if (s0 + 12 <= lo || s0 >= hi) continue;
#define wl (ws + WS_W + (size_t)l * WL_SIZE)
#define xcur ((l == 0) ? x_in : (const float*)out)

        if (EN(0) && IN(s0 + 0)) for (int rep_ = 0; rep_ < NREP(0); ++rep_) { const int tid = opq(tid0), lane = tid & 63; (void)tid; (void)lane; CArgs* A = opq_args(); const int G = opqs(G0), bx = opqs(bx0), gw = opqs(gw0), NGW = G * NWAVES; (void)bx; (void)gw; (void)NGW;
            const float* g = (const float*)A->in[2] + (size_t)l * DM;
            for (int m = gw; m < MT; m += NGW) {
                const f32x4* xr = (const f32x4*)(xcur + (size_t)m * DM) + lane;
                f32x4 v[16]; float ss = 0.f;
#pragma unroll
                for (int j = 0; j < 16; ++j) { v[j] = xr[64 * j]; ss += (v[j].x * v[j].x + v[j].y * v[j].y) + (v[j].z * v[j].z + v[j].w * v[j].w); }
                const float rs = rsqrtf(wave_sum(ss) * (1.f / DM) + EPS);
                const f32x4* gr = (const f32x4*)g + lane;
                if (I8N(l)) {
                    float amx = 0.f, ssy = 0.f;
#pragma unroll
                    for (int j = 0; j < 16; ++j) { const f32x4 gg = gr[64 * j]; v[j].x = v[j].x * rs * gg.x; v[j].y = v[j].y * rs * gg.y; v[j].z = v[j].z * rs * gg.z; v[j].w = v[j].w * rs * gg.w;
                        ssy += (v[j].x * v[j].x + v[j].y * v[j].y) + (v[j].z * v[j].z + v[j].w * v[j].w);
                        amx = fmaxf(fmaxf(amx, fmaxf(fabsf(v[j].x), fabsf(v[j].y))), fmaxf(fabsf(v[j].z), fabsf(v[j].w))); }
                    amx = wave_max(amx); const float clipv = fminf(amx, 4.2f * sqrtf(wave_sum(ssy) * (1.f / DM)));
                    const float sc = (clipv > 0.f) ? clipv * (1.f / 127.f) : 1.f, inv = 1.f / sc;
                    unsigned* o4 = (unsigned*)((unsigned char*)XN + (size_t)m * DM) + lane;
#pragma unroll
                    for (int j = 0; j < 16; ++j) o4[64 * j] = pk_i8x4(v[j].x * inv, v[j].y * inv, v[j].z * inv, v[j].w * inv);
                    if (lane == 0) ((float*)(ws + WS_XS))[m] = sc; }
                else { u32x2* o8 = (u32x2*)(XN + (size_t)m * DM) + lane;
#pragma unroll
                    for (int j = 0; j < 16; ++j) { const f32x4 gg = gr[64 * j]; u32x2 w; w.x = pk2(v[j].x * rs * gg.x, v[j].y * rs * gg.y); w.y = pk2(v[j].z * rs * gg.z, v[j].w * rs * gg.w); o8[64 * j] = w; } }
            }
            SEAM(s0 + 0);
        }
        if (EN(1) && IN(s0 + 1)) for (int rep_ = 0; rep_ < NREP(1); ++rep_) { const int tid = opq(tid0), lane = tid & 63; (void)tid; (void)lane; CArgs* A = opq_args(); const int G = opqs(G0), bx = opqs(bx0), gw = opqs(gw0), NGW = G * NWAVES; (void)bx; (void)gw; (void)NGW;
            pg8::Gemm g{XN, (const bf16_t*)(wl + WL_IN), DM, DM, DM}; pg8::SchedPlain S; S.init(MT / 256, NINP / 256 - 4, G, bx, C_BG / 256, 4);
            if (I8N(l)) { pg8::EpiBf16I8 E{H, NINP, (const float*)(ws + WS_XS), (const float*)(ws + WS_WSC) + 8 + l}; pg8::gemm_phase<pg8::EpiBf16I8, pg8::SchedPlain, 2>(lds, g, S, E); }
            else { pg8::EpiBf16 E{H, NINP}; pg8::gemm_phase(lds, g, S, E); }
            SEAM(s0 + 1);
        }
        if (EN(2) && IN(s0 + 2)) for (int rep_ = 0; rep_ < NREP(2); ++rep_) { const int tid = opq(tid0), lane = tid & 63; (void)tid; (void)lane; CArgs* A = opq_args(); const int G = opqs(G0), bx = opqs(bx0), gw = opqs(gw0), NGW = G * NWAVES; (void)bx; (void)gw; (void)NGW;
            const float* gq = (const float*)A->in[4] + l * 64; const float* gk = (const float*)A->in[5] + l * 64;
            const float* gqa = (const float*)A->in[13] + l * 768; const float* gkva = (const float*)A->in[15] + l * 512;
            const float* cw = (const float*)A->in[8] + l * 4096; const float* cb = (const float*)A->in[9] + l * 1024;
            const bool dry = (NREP(2) == 2) && (rep_ == 0);
            for (int m = gw; m < MT; m += NGW) {
                bf16_t* hr = H + (size_t)m * NINP; bf16_t* hw = dry ? (bf16_t*)TMP + (size_t)m * NINP : hr;
                const int t = m & (SEQ - 1);
                u32x4 rq[2][2], rc0, rc1 = {0u, 0u, 0u, 0u}, rkv, ru[4][2];
#pragma unroll
                for (int qk = 0; qk < 2; ++qk) { rq[qk][0] = *(const u32x4*)(hr + qk * 1024 + 16 * lane); rq[qk][1] = *(const u32x4*)(hr + qk * 1024 + 16 * lane + 8); }
                rc0 = *(const u32x4*)(hr + C_CQ + 8 * lane); if (lane < 32) rc1 = *(const u32x4*)(hr + C_CQ + 8 * (64 + lane));
                rkv = *(const u32x4*)(hr + C_CKV + 8 * lane);
#pragma unroll
                for (int j = 0; j < 4; ++j) { const int tt = t + j - 2; const bool ok = (tt >= 0 && tt < SEQ); const bf16_t* ur = H + (size_t)(ok ? m + j - 2 : m) * NINP + C_BX + 16 * lane;
                    ru[j][0] = *(const u32x4*)ur; ru[j][1] = *(const u32x4*)(ur + 8); }
                float ca[8], sa[8];
                { const f32x4 c0 = *(const f32x4*)(cosA + m * 8), c1 = *(const f32x4*)(cosA + m * 8 + 4), s0_ = *(const f32x4*)(sinA + m * 8), s1_ = *(const f32x4*)(sinA + m * 8 + 4);
#pragma unroll
                  for (int e = 0; e < 4; ++e) { ca[e] = c0[e]; ca[4 + e] = c1[e]; sa[e] = s0_[e]; sa[4 + e] = s1_[e]; } }
#pragma unroll
                for (int qk = 0; qk < 2; ++qk) {
                    bf16_t* p = hw + qk * 1024 + 16 * lane;
                    float v[16]; unpack8(rq[qk][0], v); unpack8(rq[qk][1], v + 8);
                    float ss = 0.f;
#pragma unroll
                    for (int e = 0; e < 16; ++e) ss += v[e] * v[e];
                    ss += __shfl_xor(ss, 1); ss += __shfl_xor(ss, 2);
                    const float rs = rsqrtf(ss * (1.f / 64.f) + EPS);
                    const float* gg = (qk ? gk : gq) + 16 * (lane & 3);
#pragma unroll
                    for (int e = 0; e < 16; ++e) v[e] = v[e] * rs * gg[e];
                    if ((lane & 3) == 0) {
#pragma unroll
                        for (int i = 0; i < 8; ++i) { const float c = ca[i], sn = sa[i], x1 = v[i], x2 = v[i + 8]; v[i] = x1 * c - x2 * sn; v[i + 8] = x2 * c + x1 * sn; } }
                    if (qk == 0) {
#pragma unroll
                        for (int e = 0; e < 16; ++e) v[e] *= CA; }
                    *(u32x4*)p = pack8(v); *(u32x4*)(p + 8) = pack8(v + 8);
                }
                { bf16_t* p = hw + C_CQ; float v0[8], v1[8]; unpack8(rc0, v0); unpack8(rc1, v1);
                  float ss = 0.f;
#pragma unroll
                  for (int e = 0; e < 8; ++e) ss += v0[e] * v0[e] + v1[e] * v1[e];
                  const float rs = rsqrtf(wave_sum(ss) * (1.f / 768.f) + EPS);
#pragma unroll
                  for (int e = 0; e < 8; ++e) { v0[e] = v0[e] * rs * gqa[8 * lane + e]; }
                  *(u32x4*)(p + 8 * lane) = pack8(v0);
                  if (lane < 32) {
#pragma unroll
                      for (int e = 0; e < 8; ++e) v1[e] = v1[e] * rs * gqa[8 * (64 + lane) + e];
                      *(u32x4*)(p + 8 * (64 + lane)) = pack8(v1); } }
                { bf16_t* p = hw + C_CKV + 8 * lane; float v0[8]; unpack8(rkv, v0);
                  float ss = 0.f;
#pragma unroll
                  for (int e = 0; e < 8; ++e) ss += v0[e] * v0[e];
                  const float rs = rsqrtf(wave_sum(ss) * (1.f / 512.f) + EPS);
#pragma unroll
                  for (int e = 0; e < 8; ++e) v0[e] = v0[e] * rs * gkva[8 * lane + e];
                  *(u32x4*)p = pack8(v0); }
                { float a[16];
#pragma unroll
                  for (int e = 0; e < 16; ++e) a[e] = cb[16 * lane + e];
#pragma unroll
                  for (int j = 0; j < 4; ++j) { const int tt = t + j - 2;
                      if (tt >= 0 && tt < SEQ) { float uv[16]; unpack8(ru[j][0], uv); unpack8(ru[j][1], uv + 8);
#pragma unroll
                          for (int e = 0; e < 16; ++e) a[e] += cw[j * 1024 + 16 * lane + e] * uv[e]; } }
                  bf16_t* up = (dry ? (bf16_t*)TMP : UC) + (size_t)m * 1024 + 16 * lane; *(u32x4*)up = pack8(a); *(u32x4*)(up + 8) = pack8(a + 8); }
            }
            SEAM(s0 + 2);
        }
        if (EN(3) && IN(s0 + 3)) for (int rep_ = 0; rep_ < NREP(3); ++rep_) { const int tid = opq(tid0), lane = tid & 63; (void)tid; (void)lane; CArgs* A = opq_args(); const int G = opqs(G0), bx = opqs(bx0), gw = opqs(gw0), NGW = G * NWAVES; (void)bx; (void)gw; (void)NGW;
            const int GA = G / 2, GB = G - GA, cA = (bx < GA) ? bx : -1, cB = (bx >= GA) ? bx - GA : -1;
            if (I8N(l)) { pg8::Gemm g{XN, (const bf16_t*)(wl + WL_IN + (size_t)C_BG * DM), DM, DM, DM}; pg8::SchedPlain S; S.init(MT / 256, 4, GA, cA);
                pg8::EpiBf16I8 E{H + C_BG, NINP, (const float*)(ws + WS_XS), (const float*)(ws + WS_WSC) + 8 + l}; pg8::gemm_phase<pg8::EpiBf16I8, pg8::SchedPlain, 2>(lds, g, S, E); }
            else { pg8::Gemm g{XN, (const bf16_t*)(wl + WL_IN) + (size_t)C_BG * DM, DM, DM, DM}; pg8::SchedPlain S; S.init(MT / 256, 4, GA, cA); pg8::EpiBf16 E{H + C_BG, NINP}; pg8::gemm_phase(lds, g, S, E); }
            if (P3EN(0)) { pg8::Gemm g{H + C_CQ, (const bf16_t*)(wl + WL_UQ), NINP, 768, 768}; pg8::SchedPlain S; S.init(MT / 256, 1536 / 256, GB, cB); pg8::EpiBf16 E{QM, 1536}; pg8::gemm_phase(lds, g, S, E); }
            if (P3EN(1)) { pg8::Gemm g{H + C_CKV, (const bf16_t*)(wl + WL_UKV), NINP, 512, 512}; pg8::SchedPlain S; S.init(MT / 256, 2048 / 256, GB, cB); pg8::EpiBf16 E{KV, 2048}; pg8::gemm_phase(lds, g, S, E); }
            if (P3EN(2)) { pg8::Gemm g{UC, (const bf16_t*)(wl + WL_LRU), 1024, 256, 256}; pg8::SchedSplit S; S.init(MT / 256, 16, GA, GB, bx, P3_LRU_A * GA < 512 ? P3_LRU_A * GA : 512, 1);
              pg8::EpiLru E{UC, (const float*)A->in[11] + (size_t)l * 4096, (const float*)(ws + WS_SPT) + (size_t)l * 2048, LAB}; pg8::gemm_phase(lds, g, S, E); }
            if (P3EN(3)) { pg8::Gemm g{H + C_GLR, (const bf16_t*)(wl + WL_G), NINP, 256, 256}; pg8::SchedSplit S; const int gateA = I8N(l) ? P3_GATE_A + 1 : P3_GATE_A;
              S.init(MT / 256, 12288 / 256, GA, GB, bx, gateA * GA < 1536 ? gateA * GA : 1536);
              pg8::EpiSig E{GATES, 12288, (const float*)A->in[20] + (size_t)l * 12288}; pg8::gemm_phase(lds, g, S, E); }
            SEAM(s0 + 3);
        }
        if (EN(4) && IN(s0 + 4)) for (int rep_ = 0; rep_ < NREP(4); ++rep_) { const int tid = opq(tid0), lane = tid & 63; (void)tid; (void)lane; CArgs* A = opq_args(); const int G = opqs(G0), bx = opqs(bx0), gw = opqs(gw0), NGW = G * NWAVES; (void)bx; (void)gw; (void)NGW;
            const float* gq = (const float*)A->in[17] + l * 192; const float* gk = (const float*)A->in[18] + l * 192;
            const int half = lane >> 5, j = lane & 31; const bool act = j < 24; const int jj = act ? j : 0;
            const bool dry = (NREP(4) == 2) && (rep_ == 0);
            for (int m = gw; m < MT; m += NGW) {
                u32x4 qraw[4], kraw[4];
                const bf16_t* qrow = QM + (size_t)m * 1536 + half * 192 + 8 * jj; const bf16_t* kvrow = KV + (size_t)m * 2048 + half * 256 + 8 * (jj < 8 ? 0 : jj - 8);
                const u32x4 kpe = *(const u32x4*)(H + (size_t)m * NINP + C_KPE + 8 * (jj & 7));
#pragma unroll
                for (int hp = 0; hp < 4; ++hp) { qraw[hp] = *(const u32x4*)(qrow + hp * 384); kraw[hp] = *(const u32x4*)(kvrow + hp * 512); }
                float cs[8], sn[8];
                { const f32x4 c0 = *(const f32x4*)(cosC + m * 32 + 8 * (jj & 3)), c1 = *(const f32x4*)(cosC + m * 32 + 8 * (jj & 3) + 4), s0_ = *(const f32x4*)(sinC + m * 32 + 8 * (jj & 3)), s1_ = *(const f32x4*)(sinC + m * 32 + 8 * (jj & 3) + 4);
#pragma unroll
                  for (int e = 0; e < 4; ++e) { cs[e] = c0[e]; cs[4 + e] = c1[e]; sn[e] = s0_[e]; sn[4 + e] = s1_[e]; } }
#pragma unroll
                for (int hp = 0; hp < 4; ++hp) {
#pragma unroll
                    for (int qk = 0; qk < 2; ++qk) {
                        float v[8]; unpack8(qk == 0 ? qraw[hp] : (j < 8 ? kpe : kraw[hp]), v);
                        if (!act) {
#pragma unroll
                            for (int e = 0; e < 8; ++e) v[e] = 0.f; }
                        float ss = 0.f;
#pragma unroll
                        for (int e = 0; e < 8; ++e) ss += v[e] * v[e];
#pragma unroll
                        for (int o = 1; o < 32; o <<= 1) ss += __shfl_xor(ss, o);
                        const float rs = rsqrtf(ss * (1.f / 192.f) + EPS);
                        const float* gg = (qk ? gk : gq) + 8 * jj;
#pragma unroll
                        for (int e = 0; e < 8; ++e) v[e] = v[e] * rs * gg[e];
                        float pr[8];
#pragma unroll
                        for (int e = 0; e < 8; ++e) pr[e] = __shfl_xor(v[e], 4);
                        if (j < 8) {
#pragma unroll
                            for (int e = 0; e < 8; ++e) v[e] = (j < 4) ? v[e] * cs[e] - pr[e] * sn[e] : v[e] * cs[e] + pr[e] * sn[e]; }
                        if (qk == 0) {
#pragma unroll
                            for (int e = 0; e < 8; ++e) v[e] *= CM; }
                        if (act) { bf16_t* dst = (dry ? (bf16_t*)TMP + (size_t)qk * MT * 1536 : (qk == 0 ? QM : KM)) + (size_t)m * 1536 + (2 * hp + half) * 192 + 8 * j; *(u32x4*)dst = pack8(v); }
                    }
                }
            }
            for (int it = gw; it < 2048; it += NGW) {
                const int cg = it & 3, k = (it >> 2) & 127, b = (it >> 9) & 1, z = it >> 10, c = 256 * cg + 4 * lane;
                const unsigned* ap = LAB + ((size_t)z * MT + b * SEQ + 32 * k) * 1024 + c;
                f32x4 P = {1.f, 1.f, 1.f, 1.f}, Hh = {0.f, 0.f, 0.f, 0.f};
#pragma unroll 8
                for (int s = 0; s < 32; ++s) { const int t = z ? 31 - s : s; const u32x4 w = *(const u32x4*)(ap + (size_t)t * 1024);
                    const f32x4 a = {1.f - bf_lo(w.x), 1.f - bf_lo(w.y), 1.f - bf_lo(w.z), 1.f - bf_lo(w.w)}, x = {bf_hi(w.x), bf_hi(w.y), bf_hi(w.z), bf_hi(w.w)}; Hh = a * Hh + x; P = P * a; }
                *(f32x4*)(AGP + ((size_t)(z * 2 + b) * 128 + k) * 1024 + c) = P; *(f32x4*)(AGH + ((size_t)(z * 2 + b) * 128 + k) * 1024 + c) = Hh;
            }
            SEAM(s0 + 4);
        }
        if (EN(5) && IN(s0 + 5)) for (int rep_ = 0; rep_ < NREP(5); ++rep_) { const int tid = opq(tid0), lane = tid & 63; (void)tid; (void)lane; CArgs* A = opq_args(); const int G = opqs(G0), bx = opqs(bx0), gw = opqs(gw0), NGW = G * NWAVES; (void)bx; (void)gw; (void)NGW;
            const int r32 = lane & 31, hh = lane >> 5;
            float negA, negC, lam;
            { const float* gq = (const float*)A->in[4] + l * 64; const float* gk = (const float*)A->in[5] + l * 64;
              const float mq = wave_max(fabsf(gq[lane])), mk = wave_max(fabsf(gk[lane]));
              negA = -(8.f * mq * mk * LOG2E * 1.01f);
              const float* gq2 = (const float*)A->in[17] + l * 192; const float* gk2 = (const float*)A->in[18] + l * 192;
              const float mq2 = wave_max(fmaxf(fmaxf(fabsf(gq2[lane]), fabsf(gq2[64 + lane])), fabsf(gq2[128 + lane])));
              const float mk2 = wave_max(fmaxf(fmaxf(fabsf(gk2[lane]), fabsf(gk2[64 + lane])), fabsf(gk2[128 + lane])));
              negC = -(13.856406460551018f * mq2 * mk2 * LOG2E * 1.01f);
              const float* lp = (const float*)A->in[6] + l * 256;
              const float s1 = wave_sum(lp[lane] * lp[64 + lane]), s2 = wave_sum(lp[128 + lane] * lp[192 + lane]);
              lam = expf(s1) - expf(s2) + (0.8f - 0.6f * expf(-0.3f * (float)l)); }
            const int cls = (bx >> 3) & 3;
            if (cls == 0) { asm volatile("s_waitcnt vmcnt(0) lgkmcnt(0)" ::: "memory"); __syncthreads(); { const int tidc = opq(tid0); CArgs* Ac = opq_args(); conv_layer(Ac, lds, wave, l, 1, tidc, tidc & 63, opqs(G0), opqs(bx0), opqs(gw0), opqs(G0) * NWAVES); if (l + 1 < DEPTH) conv_layer(Ac, lds, wave, l + 1, 0, tidc, tidc & 63, opqs(G0), opqs(bx0), opqs(gw0), opqs(G0) * NWAVES); } asm volatile("s_waitcnt vmcnt(0) lgkmcnt(0)" ::: "memory"); __syncthreads(); }
            for (int u = bx; u < 256; u += G) {
                const int jj = u >> 3, bh = 2 * (u & 7) + (jj >> 4), qb = jj & 15, b = bh >> 3, h = bh & 7;
                const size_t row0 = (size_t)b * SEQ + qb * 256, krow0 = (size_t)b * SEQ;
                f32x16 o[4];
                if (P5EN(0)) for (int n4_ = 0; n4_ < ((P5DUP & 1) ? 4 : 2); ++n4_) { const int n = n4_ & 1;
                    if (n4_ == 1) { if (cls == 1) { asm volatile("s_waitcnt vmcnt(0) lgkmcnt(0)" ::: "memory"); __syncthreads(); { const int tidc = opq(tid0); CArgs* Ac = opq_args(); conv_layer(Ac, lds, wave, l, 1, tidc, tidc & 63, opqs(G0), opqs(bx0), opqs(gw0), opqs(G0) * NWAVES); if (l + 1 < DEPTH) conv_layer(Ac, lds, wave, l + 1, 0, tidc, tidc & 63, opqs(G0), opqs(bx0), opqs(gw0), opqs(G0) * NWAVES); } asm volatile("s_waitcnt vmcnt(0) lgkmcnt(0)" ::: "memory"); __syncthreads(); } }
                    att::attn_body_dma<1>(H + row0 * NINP + C_AQ + h * 128 + n * 64, NINP, H + krow0 * NINP + C_AK + h * 128 + n * 64, NINP, H + krow0 * NINP + C_AV + h * 128, NINP, negA, (LAS char*)lds, o);
                    { const int le = opq(lane), r32e = le & 31, hhe = le >> 5;
                      float* dbase = DBUF + (row0 + wave * 32 + 4 * hhe) * 1024 + h * 128 + r32e;
                      if (n == 0) {
#pragma unroll
                          for (int r = 0; r < 16; ++r) { float* dp = dbase + ((r & 3) + 8 * (r >> 2)) * 1024;
#pragma unroll
                              for (int d0 = 0; d0 < 4; ++d0) dp[d0 * 32] = o[d0][r]; }
                      } else {
                          const float* sg = (const float*)A->in[7] + l * 128 + r32e; const float omli = 1.f - (0.8f - 0.6f * expf(-0.3f * (float)l));
                          const float g0 = sg[0] * omli, g1 = sg[32] * omli, g2 = sg[64] * omli, g3 = sg[96] * omli;
                          bf16_t* obase = OCAT + (row0 + wave * 32 + 4 * hhe) * 3072 + h * 128 + r32e;
#pragma unroll
                          for (int r = 0; r < 16; ++r) { const float* dp = dbase + ((r & 3) + 8 * (r >> 2)) * 1024;
                              const float e0 = dp[0] - lam * o[0][r], e1 = dp[32] - lam * o[1][r], e2 = dp[64] - lam * o[2][r], e3 = dp[96] - lam * o[3][r];
                              float ss = (e0 * e0 + e1 * e1) + (e2 * e2 + e3 * e3);
#pragma unroll
                              for (int of = 1; of < 32; of <<= 1) ss += __shfl_xor(ss, of);
                              const float rs = rsqrtf(ss * (1.f / 128.f) + EPS);
                              bf16_t* op = obase + ((r & 3) + 8 * (r >> 2)) * 3072;
                              op[0] = (bf16_t)f2bf(e0 * rs * g0); op[32] = (bf16_t)f2bf(e1 * rs * g1); op[64] = (bf16_t)f2bf(e2 * rs * g2); op[96] = (bf16_t)f2bf(e3 * rs * g3); }
                      } }
                }
                if (cls == 2) { asm volatile("s_waitcnt vmcnt(0) lgkmcnt(0)" ::: "memory"); __syncthreads(); { const int tidc = opq(tid0); CArgs* Ac = opq_args(); conv_layer(Ac, lds, wave, l, 1, tidc, tidc & 63, opqs(G0), opqs(bx0), opqs(gw0), opqs(G0) * NWAVES); if (l + 1 < DEPTH) conv_layer(Ac, lds, wave, l + 1, 0, tidc, tidc & 63, opqs(G0), opqs(bx0), opqs(gw0), opqs(G0) * NWAVES); } asm volatile("s_waitcnt vmcnt(0) lgkmcnt(0)" ::: "memory"); __syncthreads(); }
                for (int r5_ = 0; r5_ < ((P5DUP & 2) ? 2 : 1); ++r5_) {
                if (P5EN(1)) att::attn_body_dma<3>(QM + row0 * 1536 + h * 192, 1536, KM + krow0 * 1536 + h * 192, 1536, KV + krow0 * 2048 + h * 256 + 128, 2048, negC, (LAS char*)lds, o);
                if (P5EN(1)) { const int le = opq(lane), r32e = le & 31, hhe = le >> 5;
                  bf16_t* obase = OCAT + (row0 + wave * 32 + 4 * hhe) * 3072 + 2048 + h * 128 + r32e;
#pragma unroll
                  for (int r = 0; r < 16; ++r) { bf16_t* op = obase + ((r & 3) + 8 * (r >> 2)) * 3072;
#pragma unroll
                      for (int d0 = 0; d0 < 4; ++d0) op[d0 * 32] = (bf16_t)f2bf(o[d0][r]); } }
                }
            }
            if (cls == 3) { asm volatile("s_waitcnt vmcnt(0) lgkmcnt(0)" ::: "memory"); __syncthreads(); { const int tidc = opq(tid0); CArgs* Ac = opq_args(); conv_layer(Ac, lds, wave, l, 1, tidc, tidc & 63, opqs(G0), opqs(bx0), opqs(gw0), opqs(G0) * NWAVES); if (l + 1 < DEPTH) conv_layer(Ac, lds, wave, l + 1, 0, tidc, tidc & 63, opqs(G0), opqs(bx0), opqs(gw0), opqs(G0) * NWAVES); } asm volatile("s_waitcnt vmcnt(0) lgkmcnt(0)" ::: "memory"); __syncthreads(); }
            for (int r6_ = 0; r6_ < ((P5DUP & 4) ? 2 : 1); ++r6_)
            for (int it = gw; it < 4096; it += NGW) {
                const int cgp = it & 15, k = (it >> 4) & 127, b = it >> 11, c = 64 * cgp + lane;
                float cf = 0.f, cbk = 0.f;
                { const float* Pf = AGP + ((size_t)(0 * 2 + b) * 128) * 1024 + c; const float* Hf = AGH + ((size_t)(0 * 2 + b) * 128) * 1024 + c;
                  for (int j0 = 0; j0 < k; j0 += 32) {
                      float pp[32], hh[32];
#pragma unroll
                      for (int i = 0; i < 32; ++i) { const int j = (j0 + i < k) ? j0 + i : k - 1; pp[i] = Pf[(size_t)j * 1024]; hh[i] = Hf[(size_t)j * 1024]; }
#pragma unroll
                      for (int i = 0; i < 32; ++i) if (j0 + i < k) cf = pp[i] * cf + hh[i];
                  }
                  const float* Pb = AGP + ((size_t)(1 * 2 + b) * 128) * 1024 + c; const float* Hb = AGH + ((size_t)(1 * 2 + b) * 128) * 1024 + c;
                  for (int j0 = 127; j0 > k; j0 -= 32) {
                      float pp[32], hh[32];
#pragma unroll
                      for (int i = 0; i < 32; ++i) { const int j = (j0 - i > k) ? j0 - i : k + 1; pp[i] = Pb[(size_t)j * 1024]; hh[i] = Hb[(size_t)j * 1024]; }
#pragma unroll
                      for (int i = 0; i < 32; ++i) if (j0 - i > k) cbk = pp[i] * cbk + hh[i];
                  } }
                const size_t m0 = (size_t)b * SEQ + 32 * k;
                float hb[32]; float hcur = cbk;
#pragma unroll
                for (int s = 31; s >= 0; --s) { const unsigned w = LAB[((size_t)MT + m0 + s) * 1024 + c]; hcur = (1.f - bf_lo(w)) * hcur + bf_hi(w); hb[s] = hcur; }
                hcur = cf;
#pragma unroll
                for (int hf = 0; hf < 2; ++hf) {
                    float fa[16], fx[16], fg[16];
#pragma unroll
                    for (int s = 0; s < 16; ++s) { const size_t mm = m0 + 16 * hf + s; { const unsigned w = LAB[mm * 1024 + c]; fa[s] = 1.f - bf_lo(w); fx[s] = bf_hi(w); } fg[s] = bf2f(H[mm * NINP + C_BG + c]); }
#pragma unroll
                    for (int s = 0; s < 16; ++s) { hcur = fa[s] * hcur + fx[s];
                        OCAT[(m0 + 16 * hf + s) * 3072 + 1024 + c] = (bf16_t)f2bf((hcur + hb[16 * hf + s]) * gelu_tanh(fg[s])); }
                }
            }

            SEAM(s0 + 5);
        }
        if (EN(6) && IN(s0 + 6)) for (int rep_ = 0; rep_ < NREP(6); ++rep_) { const int tid = opq(tid0), lane = tid & 63; (void)tid; (void)lane; CArgs* A = opq_args(); const int G = opqs(G0), bx = opqs(bx0), gw = opqs(gw0), NGW = G * NWAVES; (void)bx; (void)gw; (void)NGW;
        }
        if (EN(7) && IN(s0 + 7)) for (int rep_ = 0; rep_ < NREP(7); ++rep_) { const int tid = opq(tid0), lane = tid & 63; (void)tid; (void)lane; CArgs* A = opq_args(); const int G = opqs(G0), bx = opqs(bx0), gw = opqs(gw0), NGW = G * NWAVES; (void)bx; (void)gw; (void)NGW;
            pg8::Gemm g{OCAT, (const bf16_t*)(wl + WL_BO), 3072, 3072, 1024}; pg8::SchedBo S; S.init(MT / 256, DM / 256, G, bx);
            pg8::EpiBo E{GATES, YSUM, F8O(l) ? 1 : 0};
            pg8::gemm_phase(lds, g, S, E);
            SEAM(s0 + 7);
        }
        if (EN(8) && IN(s0 + 8)) for (int rep_ = 0; rep_ < NREP(8); ++rep_) { const int tid = opq(tid0), lane = tid & 63; (void)tid; (void)lane; CArgs* A = opq_args(); const int G = opqs(G0), bx = opqs(bx0), gw = opqs(gw0), NGW = G * NWAVES; (void)bx; (void)gw; (void)NGW;
            pg8::Gemm g{YSUM, (const bf16_t*)(wl + WL_OUT), DM, DM, DM}; pg8::SchedPlain S; S.init(MT / 256, DM / 256, G, bx);
            if (F8O(l)) { pg8::EpiRes E{xcur, ((NREP(8) == 2) && (rep_ == 0)) ? TMP : out, W8_INV}; pg8::gemm_phase<pg8::EpiRes, pg8::SchedPlain, 1>(lds, g, S, E); }
            else { pg8::EpiRes E{xcur, ((NREP(8) == 2) && (rep_ == 0)) ? TMP : out, 1.f}; pg8::gemm_phase(lds, g, S, E); }
            SEAM(s0 + 8);
        }
        if (EN(9) && IN(s0 + 9)) for (int rep_ = 0; rep_ < NREP(9); ++rep_) { const int tid = opq(tid0), lane = tid & 63; (void)tid; (void)lane; CArgs* A = opq_args(); const int G = opqs(G0), bx = opqs(bx0), gw = opqs(gw0), NGW = G * NWAVES; (void)bx; (void)gw; (void)NGW;
            const float* g = (const float*)A->in[23] + (size_t)l * DM;
            for (int m = gw; m < MT; m += NGW) {
                const f32x4* xr = (const f32x4*)(out + (size_t)m * DM) + lane;
                f32x4 v[16]; float ss = 0.f;
#pragma unroll
                for (int j = 0; j < 16; ++j) { v[j] = xr[64 * j]; ss += (v[j].x * v[j].x + v[j].y * v[j].y) + (v[j].z * v[j].z + v[j].w * v[j].w); }
                const float rs = rsqrtf(wave_sum(ss) * (1.f / DM) + EPS);
                const f32x4* gr = (const f32x4*)g + lane;
                if (I8U(l)) {
                    float amx = 0.f, ssy = 0.f;
#pragma unroll
                    for (int j = 0; j < 16; ++j) { const f32x4 gg = gr[64 * j]; v[j].x = v[j].x * rs * gg.x; v[j].y = v[j].y * rs * gg.y; v[j].z = v[j].z * rs * gg.z; v[j].w = v[j].w * rs * gg.w;
                        ssy += (v[j].x * v[j].x + v[j].y * v[j].y) + (v[j].z * v[j].z + v[j].w * v[j].w);
                        amx = fmaxf(fmaxf(amx, fmaxf(fabsf(v[j].x), fabsf(v[j].y))), fmaxf(fabsf(v[j].z), fabsf(v[j].w))); }
                    amx = wave_max(amx); const float clipv = fminf(amx, 4.2f * sqrtf(wave_sum(ssy) * (1.f / DM)));
                    const float sc = (clipv > 0.f) ? clipv * (1.f / 127.f) : 1.f, inv = 1.f / sc;
                    unsigned* o4 = (unsigned*)((unsigned char*)XN + (size_t)m * DM) + lane;
#pragma unroll
                    for (int j = 0; j < 16; ++j) o4[64 * j] = pk_i8x4(v[j].x * inv, v[j].y * inv, v[j].z * inv, v[j].w * inv);
                    if (lane == 0) ((float*)(ws + WS_XS))[m] = sc; }
                else if (F8U(l)) { unsigned* o4 = (unsigned*)((unsigned char*)XN + (size_t)m * DM) + lane;
#pragma unroll
                    for (int j = 0; j < 16; ++j) { const f32x4 gg = gr[64 * j]; o4[64 * j] = pk_fp8x4(v[j].x * rs * gg.x, v[j].y * rs * gg.y, v[j].z * rs * gg.z, v[j].w * rs * gg.w); } }
                else { u32x2* o8 = (u32x2*)(XN + (size_t)m * DM) + lane;
#pragma unroll
                    for (int j = 0; j < 16; ++j) { const f32x4 gg = gr[64 * j]; u32x2 w; w.x = pk2(v[j].x * rs * gg.x, v[j].y * rs * gg.y); w.y = pk2(v[j].z * rs * gg.z, v[j].w * rs * gg.w); o8[64 * j] = w; } }
            }
            SEAM(s0 + 9);
        }
        if (EN(10) && IN(s0 + 10)) for (int rep_ = 0; rep_ < NREP(10); ++rep_) { const int tid = opq(tid0), lane = tid & 63; (void)tid; (void)lane; CArgs* A = opq_args(); const int G = opqs(G0), bx = opqs(bx0), gw = opqs(gw0), NGW = G * NWAVES; (void)bx; (void)gw; (void)NGW;
            pg8::Gemm g{XN, (const bf16_t*)(wl + WL_GU), DM, DM, DM}; pg8::SchedPlain S; S.init(MT / 256, 2 * FFH / 256, G, bx);
            if (I8U(l)) { pg8::EpiSwigluI8 E{(void*)HID, (const float*)(ws + WS_XS), (const float*)(ws + WS_WSC) + 2 * l, F8L(l) ? 1 : 0}; pg8::gemm_phase<pg8::EpiSwigluI8, pg8::SchedPlain, 2>(lds, g, S, E); }
            else if (F8U(l)) { pg8::EpiSwiglu<true> E{(void*)HID, W8_INV}; pg8::gemm_phase<pg8::EpiSwiglu<true>, pg8::SchedPlain, 1>(lds, g, S, E); }
            else if (F8L(l)) { pg8::EpiSwiglu<true> E{(void*)HID, 1.f}; pg8::gemm_phase(lds, g, S, E); }
            else { pg8::EpiSwiglu<false> E{(void*)HID, 1.f}; pg8::gemm_phase(lds, g, S, E); }
            SEAM(s0 + 10);
        }
        if (EN(11) && IN(s0 + 11)) for (int rep_ = 0; rep_ < NREP(11); ++rep_) { const int tid = opq(tid0), lane = tid & 63; (void)tid; (void)lane; CArgs* A = opq_args(); const int G = opqs(G0), bx = opqs(bx0), gw = opqs(gw0), NGW = G * NWAVES; (void)bx; (void)gw; (void)NGW;
            pg8::Gemm g{HID, (const bf16_t*)(wl + WL_DN), FFH, FFH, FFH}; pg8::SchedPlain S; S.init(MT / 256, DM / 256, G, bx);
            const bool dry11 = (NREP(11) == 2) && (rep_ == 0);
            if (F8L(l)) { pg8::EpiRes E{(const float*)out, dry11 ? TMP : out, W8_INV}; pg8::gemm_phase<pg8::EpiRes, pg8::SchedPlain, 1>(lds, g, S, E); }
            else { pg8::EpiRes E{(const float*)out, dry11 ? TMP : out, 1.f}; pg8::gemm_phase<pg8::EpiRes, pg8::SchedPlain, 0>(lds, g, S, E); }
            SEAM(s0 + 11);
        }
    }
#undef IN
#undef SEAM
#undef cosA
#undef sinA
#undef cosC
#undef sinC
#undef XN
#undef H
#undef UC
#undef QM
#undef KV
#undef KM
#undef LAB
#undef AGP
#undef AGH
#undef GATES
#undef DBUF
#undef OCAT
#undef TMP
#undef YSUM
#undef HID
#undef x_in
#undef out
#undef ws
#undef wl
#undef xcur
}


#ifdef PROBE_S
__global__ void probe_dump(const unsigned char* ws_, float* outp) {
    for (size_t i = (size_t)blockIdx.x * 256 + threadIdx.x; i < (size_t)MT * DM; i += (size_t)gridDim.x * 256) {
        const size_t m = i / DM, c = i % DM; float v = 0.f;
        const bf16_t* Hh = (const bf16_t*)(ws_ + WS_H); v += bf2f(Hh[m * NINP + c]) + bf2f(Hh[m * NINP + 2816 + c]);
        v += bf2f(((const bf16_t*)(ws_ + WS_UC))[m * 1024 + (c & 1023)]);
        v += bf2f(((const bf16_t*)(ws_ + WS_QM))[m * 1536 + (c % 1536)]) + bf2f(((const bf16_t*)(ws_ + WS_KM))[m * 1536 + (c % 1536)]) + bf2f(((const bf16_t*)(ws_ + WS_KV))[m * 2048 + (c & 2047)]);
        v += bf_hi(((const unsigned*)(ws_ + WS_LAB))[m * 1024 + (c & 1023)]) + bf_hi(((const unsigned*)(ws_ + WS_LAB))[((size_t)MT + m) * 1024 + (c & 1023)]);
        v += ((const float*)(ws_ + WS_AGP))[i % (2 * 2 * 128 * 1024)] + ((const float*)(ws_ + WS_AGH))[i % (2 * 2 * 128 * 1024)];
        const bf16_t* Gg = (const bf16_t*)(ws_ + WS_GATES); v += bf2f(Gg[m * 12288 + c]) + bf2f(Gg[m * 12288 + 4096 + c]) + bf2f(Gg[m * 12288 + 8192 + c]);
#if PROBE_S >= 7
        v += ((const float*)(ws_ + WS_DBUF))[m * 1024 + (c & 1023)];
        v += bf2f(((const bf16_t*)(ws_ + WS_OCAT))[m * 3072 + 2048 + (c & 1023)]);
#endif
#if PROBE_S >= 8
        v += bf2f(((const bf16_t*)(ws_ + WS_OCAT))[m * 3072 + (c % 3072)]);
#endif
#if PROBE_S >= 9
        v += bf2f(((const bf16_t*)(ws_ + WS_YSUM))[m * DM + c]);
#endif
        outp[i] = v;
    }
}
#endif

extern "C" void kernel_launch(void* const* d_in, const int* in_sizes, int n_in, void* d_out, int out_size, void* d_ws, size_t ws_size, hipStream_t stream) {
    static int grid = 0;
    if (grid == 0) {
        if (n_in != 27 || out_size != MT * DM || ws_size < WS_END) { fprintf(stderr, "kernel_launch: shape mismatch: n_in %d out %d ws %zu (need %zu)\n", n_in, out_size, ws_size, (size_t)WS_END); grid = -1; return; }
        int dev = 0, cus = 0, per_cu = 0;
        if (hipGetDevice(&dev) != hipSuccess || hipDeviceGetAttribute(&cus, hipDeviceAttributeMultiprocessorCount, dev) != hipSuccess) { grid = -1; return; }
        if (hipFuncSetAttribute((const void*)fwd, hipFuncAttributeMaxDynamicSharedMemorySize, LDS_BYTES) != hipSuccess) { fprintf(stderr, "kernel_launch: hipFuncSetAttribute failed\n"); grid = -1; return; }
        if (hipOccupancyMaxActiveBlocksPerMultiprocessor(&per_cu, (const void*)fwd, NWAVES * 64, LDS_BYTES) != hipSuccess || per_cu < 1) { fprintf(stderr, "kernel_launch: occupancy query says %d\n", per_cu); }
        (void)hipGetLastError();
        grid = cus;
    }
    if (grid < 0) return;
    if (hipMemsetAsync((char*)d_ws + WS_CTL, 0, CTL_BYTES, stream) != hipSuccess) return;
    Args a{};
    for (int i = 0; i < 27; ++i) a.in[i] = d_in[i];
    a.out = (float*)d_out; a.ws = (unsigned char*)d_ws;
#if MK_ONE_LAUNCH
    a.step_lo = 0; a.step_hi = NSTEP;
    hipLaunchKernelGGL(fwd, dim3(grid), dim3(NWAVES * 64), LDS_BYTES, stream, a);
#else
#ifdef PROBE_S
    for (int s = 0; s < PROBE_S; ++s) { a.step_lo = s; a.step_hi = s + 1; hipLaunchKernelGGL(fwd, dim3(grid), dim3(NWAVES * 64), LDS_BYTES, stream, a); }
    hipLaunchKernelGGL(probe_dump, dim3(2048), dim3(256), 0, stream, (const unsigned char*)d_ws, (float*)d_out);
#else
    for (int s = 0; s < NSTEP; ++s) { a.step_lo = s; a.step_hi = s + 1; hipLaunchKernelGGL(fwd, dim3(grid), dim3(NWAVES * 64), LDS_BYTES, stream, a); }
#endif
#endif
    const hipError_t le = hipPeekAtLastError();
    if (le != hipSuccess) fprintf(stderr, "kernel_launch: launch failed: %s\n", hipGetErrorName(le));
}
```
